# Optimizing an MI355X kernel written in HIP

```python
import jax
import jax.numpy as jnp
from jax import lax
import numpy as np

D_MODEL = 1024
BATCH = 32
SEQ = 2048
DEPTH = 1

CHUNK = 64
A_HEADS = 8
A_HEAD_DIM = 64
KV_RANK = 128
IDX_HEADS = 8
IDX_DIM = 64
MAX_SELECTED = 256
M_HEADS = 4
M_HEAD_DIM = 128
CONV_WIDTH = 4
N_EXPERTS = 32
TOP_EXPERTS = 4
D_EXPERT = D_MODEL
SWIGLU_LIMIT = 7.0
SWIGLU_ALPHA = 1.702
EXPERT_BLOCK = 128
LN_EPS = 1e-5
DN_ALPHA = (2.0 * DEPTH) ** 0.25
DN_BETA = (8.0 * DEPTH) ** -0.25

A_WIDTH = A_HEADS * A_HEAD_DIM
M_WIDTH = M_HEADS * M_HEAD_DIM
MIX_WIDTH = A_WIDTH + M_WIDTH
IN_SIZES = (A_WIDTH, KV_RANK, IDX_HEADS * IDX_DIM, IDX_DIM, IDX_HEADS,
            M_WIDTH, M_WIDTH, M_WIDTH, M_HEADS, M_HEADS)
IN_WIDTH = sum(IN_SIZES)
IN_SPLITS = tuple(int(v) for v in np.cumsum(IN_SIZES)[:-1])

kernel_name = "hybrid_dsa_mlstm_moe_deepnorm"


def layer_norm(x, g, b):
    xf = x.astype(jnp.float32)
    mu = xf.mean(-1, keepdims=True)
    var = jnp.square(xf - mu).mean(-1, keepdims=True)
    return ((xf - mu) * lax.rsqrt(var + LN_EPS) * g + b).astype(x.dtype)


def rms_norm(x, g):
    xf = x.astype(jnp.float32)
    ms = jnp.square(xf).mean(-1, keepdims=True)
    return (xf * lax.rsqrt(ms + LN_EPS) * g).astype(x.dtype)


def alibi_slopes(n):
    return jnp.asarray(2.0 ** (-8.0 * np.arange(1, n + 1) / n), dtype=jnp.float32)


def to_chunks(t, nc):
    return jnp.moveaxis(t.reshape(t.shape[0], nc, CHUNK, *t.shape[2:]), 1, 0)


def dsa_attention(q, c_kv, q_idx, k_idx, w_idx, kv_norm_g, w_uk, w_uv):
    B, S = q.shape[:2]
    nc = S // CHUNK
    k_sel = min(MAX_SELECTED, S // 4)
    c = rms_norm(c_kv, kv_norm_g)
    q_lat = jnp.einsum('bshd,hrd->bshr', q, w_uk) * (A_HEAD_DIM ** -0.5)
    slopes = alibi_slopes(A_HEADS)
    key_chunk = jnp.arange(S) // CHUNK

    def chunk_block(args):
        ci, q_b, qi_b, wi_b = args
        qpos = ci * CHUNK + jnp.arange(CHUNK)
        rel = jax.nn.relu(jnp.einsum('bthd,bsd->bths', qi_b, k_idx))
        score = jnp.einsum('bths,bth->bts', rel, wi_b)
        score = jnp.where((key_chunk <= ci)[None, None, :], score, -jnp.inf)
        top_s, top_i = lax.top_k(score, k_sel)
        valid = jnp.isfinite(top_s)
        c_sel = jax.vmap(lambda cb, ib: cb[ib])(c, top_i)
        logits = jnp.einsum('bthr,btkr->bthk', q_b, c_sel).astype(jnp.float32)
        dist = jnp.abs(qpos[None, :, None] - top_i).astype(jnp.float32)
        logits = logits - slopes[None, None, :, None] * dist[:, :, None, :]
        logits = jnp.where(valid[:, :, None, :], logits, -jnp.inf)
        p = jax.nn.softmax(logits, axis=-1).astype(c_sel.dtype)
        return jnp.einsum('bthk,btkr->bthr', p, c_sel)

    xs = (jnp.arange(nc), to_chunks(q_lat, nc), to_chunks(q_idx, nc), to_chunks(w_idx, nc))
    o_lat = lax.map(chunk_block, xs)
    o_lat = jnp.moveaxis(o_lat, 0, 1).reshape(B, S, A_HEADS, KV_RANK)
    o = jnp.einsum('bshr,hrd->bshd', o_lat, w_uv)
    return o.reshape(B, S, A_WIDTH)


def causal_conv(u, w, b):
    y = lax.conv_general_dilated(u, w[:, None, :], window_strides=(1,),
                                 padding=[(CONV_WIDTH - 1, 0)],
                                 dimension_numbers=('NWC', 'WIO', 'NWC'),
                                 feature_group_count=u.shape[-1])
    return y + b


def mlstm(u, v, z, i_pre, f_pre, conv_w, conv_b, w_mq, w_mk, norm_g):
    B, S, _ = u.shape
    nc = S // CHUNK
    f32 = jnp.float32
    uc = jax.nn.silu(causal_conv(u, conv_w, conv_b)).reshape(B, S, M_HEADS, M_HEAD_DIM)
    q = jnp.einsum('bshd,hde->bhse', uc, w_mq).astype(f32)
    k = (jnp.einsum('bshd,hde->bhse', uc, w_mk) * (M_HEAD_DIM ** -0.5)).astype(f32)
    vh = v.reshape(B, S, M_HEADS, M_HEAD_DIM).transpose(0, 2, 1, 3).astype(f32)
    chunked = lambda t: t.reshape(B, M_HEADS, nc, CHUNK, *t.shape[3:])
    qc, kc, vc = chunked(q), chunked(k), chunked(vh)
    li = chunked(i_pre.astype(f32).transpose(0, 2, 1))
    lf = chunked(jax.nn.log_sigmoid(f_pre.astype(f32)).transpose(0, 2, 1))
    b = jnp.cumsum(lf, axis=-1)
    b_tot = b[..., -1]
    a = b_tot[..., None] - b + li
    a_max = a.max(-1)

    def step(carry, inp):
        C, n, m = carry
        kk, vv, aa, amax, btot = inp
        m_new = jnp.maximum(btot + m, amax)
        decay = jnp.exp(btot + m - m_new)
        w = jnp.exp(aa - m_new[..., None])
        C_new = decay[..., None, None] * C + jnp.einsum('bhl,bhlv,bhlk->bhvk', w, vv, kk)
        n_new = decay[..., None] * n + jnp.einsum('bhl,bhlk->bhk', w, kk)
        return (C_new, n_new, m_new), (C, n, m)

    init = (jnp.zeros((B, M_HEADS, M_HEAD_DIM, M_HEAD_DIM), f32),
            jnp.zeros((B, M_HEADS, M_HEAD_DIM), f32),
            jnp.full((B, M_HEADS), -1e30, f32))
    mv = lambda t: jnp.moveaxis(t, 2, 0)
    _, (C_prev, n_prev, m_prev) = lax.scan(step, init, (mv(kc), mv(vc), mv(a), mv(a_max), mv(b_tot)))
    C_prev = jnp.moveaxis(C_prev, 0, 2)
    n_prev = jnp.moveaxis(n_prev, 0, 2)
    m_prev = jnp.moveaxis(m_prev, 0, 2)

    g = b + m_prev[..., None]
    causal = jnp.tril(jnp.ones((CHUNK, CHUNK), bool))
    dlog = jnp.where(causal, b[..., :, None] - b[..., None, :] + li[..., None, :], -jnp.inf)
    m_t = jnp.maximum(g, dlog.max(-1))
    w_intra = jnp.exp(dlog - m_t[..., None])
    w_state = jnp.exp(g - m_t)
    s = jnp.einsum('bhcte,bhcse->bhcts', qc, kc) * w_intra
    num = (jnp.einsum('bhcts,bhcsv->bhctv', s, vc)
           + w_state[..., None] * jnp.einsum('bhcvk,bhctk->bhctv', C_prev, qc))
    den = s.sum(-1) + w_state * jnp.einsum('bhck,bhctk->bhct', n_prev, qc)
    hc = num / jnp.maximum(jnp.abs(den), jnp.exp(-m_t))[..., None]
    hc = hc.reshape(B, M_HEADS, S, M_HEAD_DIM)
    mu = hc.mean(-1, keepdims=True)
    var = jnp.square(hc - mu).mean(-1, keepdims=True)
    hc = (hc - mu) * lax.rsqrt(var + LN_EPS)
    h = hc.transpose(0, 2, 1, 3).reshape(B, S, M_WIDTH) * norm_g
    return (jax.nn.sigmoid(z.astype(f32)) * h).astype(u.dtype)


def moe(x, w_router, b_router, w_gu, b_gu, w_down, b_down):
    B, S, D = x.shape
    T = B * S
    xf = x.reshape(T, D)
    logits = (xf @ w_router + b_router).astype(jnp.float32)
    top_v, top_e = lax.top_k(logits, TOP_EXPERTS)
    gates = jax.nn.softmax(top_v, axis=-1)
    A = T * TOP_EXPERTS
    flat_e = top_e.reshape(A)
    flat_tok = jnp.arange(A, dtype=jnp.int32) // TOP_EXPERTS
    flat_g = gates.reshape(A)
    order = jnp.argsort(flat_e)
    se = flat_e[order]
    counts = jnp.bincount(flat_e, length=N_EXPERTS)
    padded = (counts + EXPERT_BLOCK - 1) // EXPERT_BLOCK * EXPERT_BLOCK
    start = jnp.cumsum(counts) - counts
    pad_end = jnp.cumsum(padded)
    pad_start = pad_end - padded
    dest = pad_start[se] + jnp.arange(A, dtype=jnp.int32) - start[se]
    P = A + N_EXPERTS * EXPERT_BLOCK
    nb = P // EXPERT_BLOCK
    row_tok = jnp.zeros((P,), jnp.int32).at[dest].set(flat_tok[order])
    row_gate = jnp.zeros((P,), jnp.float32).at[dest].set(flat_g[order])
    blk_e = jnp.minimum(jnp.searchsorted(pad_end, jnp.arange(nb) * EXPERT_BLOCK, side='right'),
                        N_EXPERTS - 1)

    def expert_block(args):
        e, tok, gt = args
        xb = xf[tok]
        gu = xb @ w_gu[e] + b_gu[e]
        gate, up = gu[:, :D_EXPERT], gu[:, D_EXPERT:]
        gate = jnp.minimum(gate, SWIGLU_LIMIT)
        up = jnp.clip(up, -SWIGLU_LIMIT, SWIGLU_LIMIT)
        h = (up + 1.0) * gate * jax.nn.sigmoid(SWIGLU_ALPHA * gate)
        y = h @ w_down[e] + b_down[e]
        return y * gt[:, None].astype(y.dtype)

    ys = lax.map(expert_block, (blk_e, row_tok.reshape(nb, EXPERT_BLOCK),
                                row_gate.reshape(nb, EXPERT_BLOCK)))
    y = jax.ops.segment_sum(ys.reshape(P, D), row_tok, num_segments=T)
    return y.reshape(B, S, D).astype(x.dtype)


def setup_inputs(seed: int = 0) -> dict:
    key = jax.random.key(seed)
    ks = jax.random.split(key, 24)
    nrm = lambda k, shape, scale: jax.random.normal(k, shape, jnp.float32) * scale
    L = DEPTH
    return {
        "x": nrm(ks[0], (BATCH, SEQ, D_MODEL), 1.0),
        "w_in": nrm(ks[1], (L, D_MODEL, IN_WIDTH), D_MODEL ** -0.5),
        "kv_norm_g": 1.0 + nrm(ks[2], (L, KV_RANK), 0.05),
        "w_uk": nrm(ks[3], (L, A_HEADS, KV_RANK, A_HEAD_DIM), KV_RANK ** -0.5),
        "w_uv": nrm(ks[4], (L, A_HEADS, KV_RANK, A_HEAD_DIM), KV_RANK ** -0.5),
        "m_conv_w": nrm(ks[5], (L, CONV_WIDTH, M_WIDTH), CONV_WIDTH ** -0.5),
        "m_conv_b": nrm(ks[6], (L, M_WIDTH), 0.01),
        "w_mq": nrm(ks[7], (L, M_HEADS, M_HEAD_DIM, M_HEAD_DIM), M_HEAD_DIM ** -0.5),
        "w_mk": nrm(ks[8], (L, M_HEADS, M_HEAD_DIM, M_HEAD_DIM), M_HEAD_DIM ** -0.5),
        "b_i": nrm(ks[9], (L, M_HEADS), 0.1),
        "b_f": jnp.linspace(3.0, 6.0, M_HEADS)[None, :] + nrm(ks[10], (L, M_HEADS), 0.1),
        "m_norm_g": 1.0 + nrm(ks[11], (L, M_WIDTH), 0.05),
        "w_out": nrm(ks[12], (L, MIX_WIDTH, D_MODEL), DN_BETA * MIX_WIDTH ** -0.5),
        "ln1_g": 1.0 + nrm(ks[13], (L, D_MODEL), 0.05),
        "ln1_b": nrm(ks[14], (L, D_MODEL), 0.01),
        "w_router": nrm(ks[15], (L, D_MODEL, N_EXPERTS), D_MODEL ** -0.5),
        "b_router": nrm(ks[16], (L, N_EXPERTS), 0.01),
        "w_gu": nrm(ks[17], (L, N_EXPERTS, D_MODEL, 2 * D_EXPERT), D_MODEL ** -0.5),
        "b_gu": nrm(ks[18], (L, N_EXPERTS, 2 * D_EXPERT), 0.01),
        "w_down": nrm(ks[19], (L, N_EXPERTS, D_EXPERT, D_MODEL), DN_BETA * D_EXPERT ** -0.5),
        "b_down": nrm(ks[20], (L, N_EXPERTS, D_MODEL), 0.01),
        "ln2_g": 1.0 + nrm(ks[21], (L, D_MODEL), 0.05),
        "ln2_b": nrm(ks[22], (L, D_MODEL), 0.01),
    }


def reference(x, w_in, kv_norm_g, w_uk, w_uv, m_conv_w, m_conv_b, w_mq, w_mk, b_i, b_f,
              m_norm_g, w_out, ln1_g, ln1_b, w_router, b_router, w_gu, b_gu, w_down, b_down,
              ln2_g, ln2_b):
    B, S, _ = x.shape
    h = x
    for l in range(DEPTH):
        proj = h @ w_in[l]
        q_a, ckv, q_i, k_i, w_i, u, v, z, i_pre, f_pre = jnp.split(proj, IN_SPLITS, axis=-1)
        a_out = dsa_attention(q_a.reshape(B, S, A_HEADS, A_HEAD_DIM), ckv,
                              q_i.reshape(B, S, IDX_HEADS, IDX_DIM), k_i, w_i,
                              kv_norm_g[l], w_uk[l], w_uv[l])
        m_out = mlstm(u, v, z, i_pre + b_i[l], f_pre + b_f[l], m_conv_w[l], m_conv_b[l],
                      w_mq[l], w_mk[l], m_norm_g[l])
        mix = jnp.concatenate([a_out, m_out], axis=-1) @ w_out[l]
        h = layer_norm(DN_ALPHA * h + mix, ln1_g[l], ln1_b[l])
        ffn = moe(h, w_router[l], b_router[l], w_gu[l], b_gu[l], w_down[l], b_down[l])
        h = layer_norm(DN_ALPHA * h + ffn, ln2_g[l], ln2_b[l])
    return h
```

```cpp
#include <hip/hip_runtime.h>
#include <hip/hip_cooperative_groups.h>
#include <cstdio>
#include <cstdint>
namespace cg = cooperative_groups;

#ifndef MK_ONE_LAUNCH
#define MK_ONE_LAUNCH 0
#endif

#define GAS __attribute__((address_space(1)))
#define LAS __attribute__((address_space(3)))
typedef unsigned short bf16_t;
typedef short bf16x8 __attribute__((ext_vector_type(8)));
typedef float f32x4 __attribute__((ext_vector_type(4)));
typedef float f32x2 __attribute__((ext_vector_type(2)));
typedef unsigned u32x4 __attribute__((ext_vector_type(4)));
typedef unsigned u32x2 __attribute__((ext_vector_type(2)));

constexpr int T = 65536, DM = 1024, NB = 32, SEQ = 2048, CHK = 64, NCH = 32;
constexpr int NPROJ = 2816;
constexpr int C_QA = 0, C_CKV = 512, C_QI = 640, C_KI = 1152, C_U = 1216, C_V = 1728, C_Z = 2240, C_WI = 2752, C_IG = 2760, C_FG = 2764;
constexpr int IN_W = 2768;
constexpr int NEXP = 32, TOPE = 4, NROUND = 4;
constexpr int RCAP = T + NEXP * 256;
constexpr float LN_EPS = 1e-5f;
constexpr float DN_ALPHA = 1.189207115002721f;
constexpr int KSEL = 256;

constexpr size_t MiB = 1u << 20;
constexpr size_t WS_CTL = 0, CTL_BYTES = 1 * MiB;
constexpr size_t WS_WIN = 1 * MiB;
constexpr size_t WS_WOUT = 7 * MiB;
constexpr size_t WS_WGU = 9 * MiB;
constexpr size_t WS_WD = 137 * MiB;
constexpr size_t WS_XB = 201 * MiB;
constexpr size_t WS_H1B = WS_XB;
constexpr size_t WS_PROJ = 329 * MiB;
constexpr size_t WS_PRE1 = WS_PROJ;
constexpr size_t WS_XG = WS_PROJ;
constexpr size_t WS_HB = WS_PROJ + 144 * MiB;
constexpr size_t WS_G32 = 681 * MiB;
constexpr size_t WS_CB = 685 * MiB;
constexpr size_t WS_MASK = 701 * MiB;
constexpr size_t WS_MIX = 717 * MiB;
constexpr size_t WS_TOPE = 845 * MiB;
constexpr size_t WS_GATE = 846 * MiB;
constexpr size_t WS_RANK = 847 * MiB;
constexpr size_t WS_RTOK = 848 * MiB;
constexpr size_t WS_RGATE = 850 * MiB;
constexpr size_t WS_END = 852 * MiB;
constexpr int CW_CNT = 64;

constexpr int RING_BYTES = 131072;
constexpr int LCTL_OFF = RING_BYTES;
constexpr int LDS_BYTES = 147456;
constexpr int NWAVES = 8, NTHR = 512;

__device__ __forceinline__ unsigned f2bf(float f) { unsigned u = __builtin_bit_cast(unsigned, f); return (u + 0x7fffu + ((u >> 16) & 1u)) >> 16; }
__device__ __forceinline__ unsigned pk2(float lo, float hi) { return f2bf(lo) | (f2bf(hi) << 16); }
__device__ __forceinline__ float bf2f(unsigned h) { return __builtin_bit_cast(float, h << 16); }
__device__ __forceinline__ float bflo(unsigned p) { return __builtin_bit_cast(float, p << 16); }
__device__ __forceinline__ float bfhi(unsigned p) { return __builtin_bit_cast(float, p & 0xffff0000u); }
__device__ __forceinline__ float wave_sum(float v) {
#pragma unroll
    for (int o = 1; o < 64; o <<= 1) v += __shfl_xor(v, o);
    return v;
}
__device__ __forceinline__ float wave_max(float v) {
#pragma unroll
    for (int o = 1; o < 64; o <<= 1) v = fmaxf(v, __shfl_xor(v, o));
    return v;
}
__device__ __forceinline__ int launder(int v) { asm volatile("" : "+v"(v)); return v; }
__device__ __forceinline__ float sigmoidf_(float x) { return 1.0f / (1.0f + __expf(-x)); }

namespace pg8 {
constexpr int BM = 256, BK = 64, HALF = 128, HTB = HALF * BK * 2, STAGE_BYTES = 8 * HTB, NXCD = 8, WGM = 8;
__host__ __device__ __forceinline__ int lds_byte(int r, int c) { const int st = (r >> 4) * 2 + (c >> 5), rr = r & 15, cc = c & 31, ob = rr * 64 + cc * 2; return st * 1024 + (ob ^ (((ob >> 9) & 1) << 5)); }
__host__ __device__ __forceinline__ void stage_rc(int b, int& R, int& C) { const int st = b / 1024, sb = b % 1024, swz = sb ^ (((sb >> 9) & 1) << 5); R = (st >> 1) * 16 + swz / 64; C = (st & 1) * 32 + (swz % 64) / 2; }
__host__ __device__ __forceinline__ int perm32(int rho) { const int n = rho >> 4, i = rho & 15; return 8 * (i >> 2) + 4 * n + (i & 3); }

struct Unit { int pm, pn, po, pe; };
struct Gemm { const bf16_t* A; const bf16_t* Bt; int lda, ldb, K; };

struct StaticOrder {
    int nM, nN, nwg, G, c;
    __device__ void init(int M, int N, int G_, int c_) { nM = M / BM; nN = N / BM; nwg = nM * nN; G = G_; c = c_; }
    __device__ bool next(int i, Unit& u) const {
        const long L = (long)i * G + c; if (L >= nwg) return false;
        int wgid = (int)L; { const int q = nwg / NXCD, r = nwg % NXCD, xcd = wgid % NXCD, off = wgid / NXCD; wgid = (xcd < r ? xcd * (q + 1) : r * (q + 1) + (xcd - r) * q) + off; }
        const int nig = WGM * nN, gid = wgid / nig, fm = gid * WGM, gsz = (nM - fm) < WGM ? (nM - fm) : WGM;
        u.pm = fm + ((wgid % nig) % gsz); u.pn = (wgid % nig) / gsz; u.po = u.pn; u.pe = 0; return true;
    }
};

__device__ __forceinline__ unsigned cvt_pk_bf16(float lo, float hi) { unsigned r; asm volatile("v_cvt_pk_bf16_f32 %0, %1, %2" : "=v"(r) : "v"(lo), "v"(hi)); return r; }

template <class Epi, class Sched>
__device__ __forceinline__ void gemm_phase(LAS unsigned char* lds, const Gemm g, const Sched& S, const Epi& E) {
    int tid = threadIdx.x; asm volatile("" : "+v"(tid));
    const int wid = __builtin_amdgcn_readfirstlane(tid >> 6), lane = tid & 63, wr = wid >> 2, wc = wid & 3, fr = lane & 15, fq = lane >> 4;
    const int K = g.K, nt = K / BK;
    unsigned voffA[2], voffB[2];
#pragma unroll
    for (int i = 0; i < 2; ++i) { int R, C; stage_rc(tid * 16 + i * 8192, R, C); const int Rb = Epi::PERM ? ((R & ~31) + perm32(R & 31)) : R;
        voffA[i] = (unsigned)(R * g.lda + C) * 2u; voffB[i] = (unsigned)(Rb * g.ldb + C) * 2u; }
    const size_t kstep = (size_t)(BK * 2);
    const size_t hstepA = (size_t)HALF * g.lda * 2, hstepB = (size_t)HALF * g.ldb * 2;
    const size_t tstepA = 2 * hstepA, tstepB = 2 * hstepB;
    const unsigned ldsw = (unsigned)wid * 1024u;
    const int aoff = lds_byte(wr * 64 + fr, fq * 8), boff = lds_byte(wc * 32 + fr, fq * 8);
#define PG8_SA(b, h) (((b) * 2 + (h)) * HTB)
#define PG8_SB(b, h) ((4 + (b) * 2 + (h)) * HTB)
#define PG8_STAGE(bufoff, gbase, voff) do { _Pragma("unroll") for (int _i = 0; _i < 2; ++_i) \
        __builtin_amdgcn_global_load_lds((const unsigned*)((const char*)(gbase) + (voff)[_i]), (LAS unsigned*)(lds + (bufoff) + ldsw + _i * 8192), 16, 0, 0); } while (0)
#define PG8_LDA(dst, b, h) do { _Pragma("unroll") for (int m = 0; m < 4; ++m) _Pragma("unroll") for (int k = 0; k < 2; ++k) dst[m][k] = *(const LAS bf16x8*)(lds + PG8_SA(b, h) + aoff + m * 2048 + k * 1024); } while (0)
#define PG8_LDB(dst, b, h) do { _Pragma("unroll") for (int n = 0; n < 2; ++n) _Pragma("unroll") for (int k = 0; k < 2; ++k) dst[n][k] = *(const LAS bf16x8*)(lds + PG8_SB(b, h) + boff + n * 2048 + k * 1024); } while (0)
#define PG8_MMA(ai, bj, At, Bt) do { __builtin_amdgcn_s_setprio(1); _Pragma("unroll") for (int m = 0; m < 4; ++m) _Pragma("unroll") for (int n = 0; n < 2; ++n) _Pragma("unroll") for (int k = 0; k < 2; ++k) \
        acc[ai][bj][m][n] = __builtin_amdgcn_mfma_f32_16x16x32_bf16(Bt[n][k], At[m][k], acc[ai][bj][m][n], 0, 0, 0); __builtin_amdgcn_s_setprio(0); } while (0)
#define PG8_WAIT_V(n) asm volatile("s_waitcnt vmcnt(" #n ")" ::: "memory")
#define PG8_WAIT_L(n) asm volatile("s_waitcnt lgkmcnt(" #n ")" ::: "memory")
#define PG8_BAR __builtin_amdgcn_s_barrier()
#define PG8_SCHED __builtin_amdgcn_sched_barrier(0)
    Unit cur, nxt; int ui = 0;
    if (!S.next(0, cur)) return;
    f32x4 acc[2][2][4][2];
#pragma unroll
    for (int a = 0; a < 2; ++a)
#pragma unroll
        for (int b = 0; b < 2; ++b)
#pragma unroll
            for (int m = 0; m < 4; ++m)
#pragma unroll
                for (int n = 0; n < 2; ++n) acc[a][b][m][n] = (f32x4){0.f, 0.f, 0.f, 0.f};
    bf16x8 At[4][2], B0[2][2], B1[2][2];
    const char* cA = (const char*)g.A + (size_t)cur.pm * tstepA; const char* cB = (const char*)g.Bt + (size_t)cur.pn * tstepB;
    PG8_STAGE(PG8_SB(0, 0), cB, voffB); PG8_STAGE(PG8_SB(0, 1), cB + hstepB, voffB); PG8_STAGE(PG8_SA(0, 0), cA, voffA); PG8_STAGE(PG8_SA(0, 1), cA + hstepA, voffA);
    if (wr == 1) PG8_BAR;
    PG8_WAIT_V(2); PG8_BAR;
    PG8_STAGE(PG8_SB(1, 0), cB + kstep, voffB); PG8_STAGE(PG8_SA(1, 0), cA + kstep, voffA); PG8_STAGE(PG8_SB(1, 1), cB + hstepB + kstep, voffB);
    PG8_WAIT_V(6); PG8_BAR;
    for (;;) {
        const bool has_next = S.next(ui + 1, nxt);
        const char* nA = has_next ? (const char*)g.A + (size_t)nxt.pm * tstepA : cA; const char* nB = has_next ? (const char*)g.Bt + (size_t)nxt.pn * tstepB : cB;
        for (int t = 0; t < nt; t += 2) {
            const bool last = (t == nt - 2);
            const char* a1 = cA + (size_t)(t + 1) * kstep;
            const char* a2 = last ? nA : cA + (size_t)(t + 2) * kstep; const char* b2 = last ? nB : cB + (size_t)(t + 2) * kstep;
            const char* a3 = a2 + kstep; const char* b3 = b2 + kstep;
            PG8_LDB(B0, 0, 0); PG8_LDB(B1, 0, 1); PG8_SCHED; PG8_LDA(At, 0, 0); PG8_STAGE(PG8_SA(1, 1), a1 + hstepA, voffA);
            PG8_WAIT_V(8); PG8_WAIT_L(0); PG8_BAR; PG8_MMA(0, 0, At, B0); PG8_MMA(0, 1, At, B1); PG8_BAR; PG8_SCHED;
            PG8_LDA(At, 0, 1); PG8_STAGE(PG8_SB(0, 0), b2, voffB); PG8_STAGE(PG8_SB(0, 1), b2 + hstepB, voffB); PG8_STAGE(PG8_SA(0, 0), a2, voffA);
            PG8_WAIT_V(8); PG8_WAIT_L(0); PG8_BAR; PG8_MMA(1, 0, At, B0); PG8_MMA(1, 1, At, B1); PG8_BAR; PG8_SCHED;
            PG8_LDB(B0, 1, 0); PG8_LDB(B1, 1, 1); PG8_SCHED; PG8_LDA(At, 1, 0); PG8_STAGE(PG8_SA(0, 1), a2 + hstepA, voffA);
            PG8_WAIT_V(8); PG8_WAIT_L(0); PG8_BAR; PG8_MMA(0, 0, At, B0); PG8_MMA(0, 1, At, B1); PG8_BAR; PG8_SCHED;
            PG8_LDA(At, 1, 1); PG8_STAGE(PG8_SB(1, 0), b3, voffB); PG8_STAGE(PG8_SB(1, 1), b3 + hstepB, voffB); PG8_STAGE(PG8_SA(1, 0), a3, voffA);
            PG8_WAIT_V(8); PG8_WAIT_L(0); PG8_BAR; PG8_MMA(1, 0, At, B0); PG8_MMA(1, 1, At, B1); PG8_BAR; PG8_SCHED;
        }
        if (wr == 0) PG8_BAR;
        E(acc, cur, wr, wc, fr, fq);
        if (!has_next) break;
#pragma unroll
        for (int a = 0; a < 2; ++a)
#pragma unroll
            for (int b = 0; b < 2; ++b)
#pragma unroll
                for (int m = 0; m < 4; ++m)
#pragma unroll
                    for (int n = 0; n < 2; ++n) acc[a][b][m][n] = (f32x4){0.f, 0.f, 0.f, 0.f};
        cur = nxt; cA = nA; cB = nB; ++ui;
        if (wr == 1) PG8_BAR;
    }
    PG8_WAIT_V(0);
    PG8_BAR;
#undef PG8_SA
#undef PG8_SB
#undef PG8_STAGE
#undef PG8_LDA
#undef PG8_LDB
#undef PG8_MMA
#undef PG8_WAIT_V
#undef PG8_WAIT_L
#undef PG8_BAR
#undef PG8_SCHED
}
}

struct Args {
    const float* in[23];
    float* out; unsigned char* ws;
    int ph_lo, ph_hi;
};
struct Frame {
    LAS unsigned char* lds;
    int tid, lane, wave, G, bid;
};
#define F_in(k) (args.in[k])
#define F_x F_in(0)
#define F_w_in F_in(1)
#define F_kv_norm_g F_in(2)
#define F_w_uk F_in(3)
#define F_w_uv F_in(4)
#define F_m_conv_w F_in(5)
#define F_m_conv_b F_in(6)
#define F_w_mq F_in(7)
#define F_w_mk F_in(8)
#define F_b_i F_in(9)
#define F_b_f F_in(10)
#define F_m_norm_g F_in(11)
#define F_w_out F_in(12)
#define F_ln1_g F_in(13)
#define F_ln1_b F_in(14)
#define F_w_router F_in(15)
#define F_b_router F_in(16)
#define F_w_gu F_in(17)
#define F_b_gu F_in(18)
#define F_w_down F_in(19)
#define F_b_down F_in(20)
#define F_ln2_g F_in(21)
#define F_ln2_b F_in(22)
#define F_out (args.out)
#define F_ctl ((unsigned*)(args.ws + WS_CTL))
#define F_WinT ((bf16_t*)(args.ws + WS_WIN))
#define F_WoutT ((bf16_t*)(args.ws + WS_WOUT))
#define F_WguT ((bf16_t*)(args.ws + WS_WGU))
#define F_WdT ((bf16_t*)(args.ws + WS_WD))
#define F_xb ((bf16_t*)(args.ws + WS_XB))
#define F_h1b ((bf16_t*)(args.ws + WS_H1B))
#define F_projb ((bf16_t*)(args.ws + WS_PROJ))
#define F_cb ((bf16_t*)(args.ws + WS_CB))
#define F_mix ((bf16_t*)(args.ws + WS_MIX))
#define F_xg ((bf16_t*)(args.ws + WS_XG))
#define F_hb ((bf16_t*)(args.ws + WS_HB))
#define F_g32 ((float*)(args.ws + WS_G32))
#define F_pre1 ((float*)(args.ws + WS_PRE1))
#define F_gate ((float*)(args.ws + WS_GATE))
#define F_rgate ((float*)(args.ws + WS_RGATE))
#define F_mask ((unsigned*)(args.ws + WS_MASK))
#define F_tope ((int*)(args.ws + WS_TOPE))
#define F_rank ((int*)(args.ws + WS_RANK))
#define F_rtok ((int*)(args.ws + WS_RTOK))

__device__ __forceinline__ int in_map(int n) {
    if (n < 1216) return n;
    if (n < 2752) return n + 8;
    if (n < 2760) return n - 2752 + 1216;
    if (n < 2768) return n;
    return -1;
}
template <int MODE>
__device__ __forceinline__ void transpose_item(const float* W, int K, int Norig, bf16_t* WT, LAS float* scr, int kb, int nb, int lane) {
    const int k0 = 64 * kb, n0 = 32 * nb;
    const int nn = n0 + (lane & 31);
    int oc;
    if (MODE == 0) oc = nn;
    else if (MODE == 1) oc = in_map(nn);
    else { const int pn = nn >> 8, half = (nn >> 7) & 1, i = nn & 127; oc = half * 1024 + pn * 128 + i; }
#pragma unroll 8
    for (int i = 0; i < 32; ++i) { const int kk = 2 * i + (lane >> 5); scr[kk * 33 + (lane & 31)] = (oc >= 0) ? W[(size_t)(k0 + kk) * Norig + oc] : 0.f; }
    asm volatile("s_waitcnt lgkmcnt(0)" ::: "memory");
    const int c = lane & 7;
#pragma unroll
    for (int j = 0; j < 4; ++j) { const int n = (lane >> 3) + 8 * j; const LAS float* s = scr + (8 * c) * 33 + n;
        u32x4 o; o.x = pk2(s[0 * 33], s[1 * 33]); o.y = pk2(s[2 * 33], s[3 * 33]); o.z = pk2(s[4 * 33], s[5 * 33]); o.w = pk2(s[6 * 33], s[7 * 33]);
        *(u32x4*)(WT + (size_t)(n0 + n) * K + k0 + 8 * c) = o; }
    asm volatile("s_waitcnt lgkmcnt(0)" ::: "memory");
}
__device__ __forceinline__ void p0_prologue(const Args& args, Frame& F) {
    LAS float* scr = (LAS float*)(F.lds + F.wave * 16384);
    const int gw = F.bid * NWAVES + F.wave, NGW = F.G * NWAVES;
    constexpr int I_IN = 16 * (NPROJ / 32), I_OUT = 16 * 32, I_GU = NEXP * 16 * 64, I_D = NEXP * 16 * 32;
    constexpr int NITEMS = I_IN + I_OUT + I_GU + I_D;
    for (int it = gw; it < NITEMS; it += NGW) {
        int r = it;
        if (r < I_IN) { const int nbk = NPROJ / 32; transpose_item<1>(F_w_in, DM, IN_W, F_WinT, scr, r / nbk, r % nbk, F.lane); continue; } r -= I_IN;
        if (r < I_OUT) { transpose_item<0>(F_w_out, DM, DM, F_WoutT, scr, r / 32, r % 32, F.lane); continue; } r -= I_OUT;
        if (r < I_GU) { const int e = r / (16 * 64), q = r % (16 * 64); transpose_item<2>(F_w_gu + (size_t)e * DM * 2048, DM, 2048, F_WguT + (size_t)e * 2048 * DM, scr, q / 64, q % 64, F.lane); continue; } r -= I_GU;
        { const int e = r / (16 * 32), q = r % (16 * 32); transpose_item<0>(F_w_down + (size_t)e * DM * DM, DM, DM, F_WdT + (size_t)e * DM * DM, scr, q / 32, q % 32, F.lane); }
    }
    for (int m = gw; m < T; m += NGW) {
        const f32x4* xr = (const f32x4*)(F_x + (size_t)m * DM) + F.lane;
        u32x2* o = (u32x2*)(F_xb + (size_t)m * DM) + F.lane;
#pragma unroll
        for (int j = 0; j < 4; ++j) { const f32x4 v = xr[64 * j]; u32x2 w; w.x = pk2(v.x, v.y); w.y = pk2(v.z, v.w); o[64 * j] = w; }
    }
}

struct EpiProj {
    static constexpr bool PERM = true;
    bf16_t* O; float* g32;
    __device__ __forceinline__ void operator()(const f32x4 (&acc)[2][2][4][2], const pg8::Unit& u, int wr, int wc, int fr, int fq) const {
        const int row0 = u.pm * 256 + wr * 64 + fr, col0 = u.po * 256 + wc * 32 + 8 * fq;
#pragma unroll
        for (int ai = 0; ai < 2; ++ai)
#pragma unroll
            for (int m = 0; m < 4; ++m) { const int row = row0 + ai * 128 + m * 16;
#pragma unroll
                for (int bj = 0; bj < 2; ++bj) { const f32x4 v0 = acc[ai][bj][m][0], v1 = acc[ai][bj][m][1]; const int col = col0 + bj * 128;
                    u32x4 w; w.x = pg8::cvt_pk_bf16(v0[0], v0[1]); w.y = pg8::cvt_pk_bf16(v0[2], v0[3]); w.z = pg8::cvt_pk_bf16(v1[0], v1[1]); w.w = pg8::cvt_pk_bf16(v1[2], v1[3]);
                    *(u32x4*)(O + (size_t)row * NPROJ + col) = w;
                    if (col >= C_WI && col < C_WI + 16) { float* gp = g32 + (size_t)row * 16 + (col - C_WI); *(f32x4*)gp = v0; *(f32x4*)(gp + 4) = v1; } } }
    }
};
struct EpiOut {
    static constexpr bool PERM = false;
    const float* x; float* pre;
    __device__ __forceinline__ void operator()(const f32x4 (&acc)[2][2][4][2], const pg8::Unit& u, int wr, int wc, int fr, int fq) const {
        const int row0 = u.pm * 256 + wr * 64 + fr, col0 = u.po * 256 + wc * 32 + 4 * fq;
#pragma unroll
        for (int ai = 0; ai < 2; ++ai)
#pragma unroll
            for (int m = 0; m < 4; ++m) { const size_t off = (size_t)(row0 + ai * 128 + m * 16) * DM + col0;
#pragma unroll
                for (int bj = 0; bj < 2; ++bj)
#pragma unroll
                    for (int n = 0; n < 2; ++n) { const f32x4 xv = *(const f32x4*)(x + off + bj * 128 + n * 16); *(f32x4*)(pre + off + bj * 128 + n * 16) = xv * DN_ALPHA + acc[ai][bj][m][n]; } }
    }
};
struct EpiGU {
    static constexpr bool PERM = true;
    bf16_t* H; const float* b_gu;
    __device__ __forceinline__ void operator()(const f32x4 (&acc)[2][2][4][2], const pg8::Unit& u, int wr, int wc, int fr, int fq) const {
        const int row0 = u.pm * 256 + wr * 64 + fr, hc = u.po * 128 + wc * 32 + 8 * fq;
        const float* bg = b_gu + (size_t)u.pe * 2048 + hc;
        f32x4 bgv[2], buv[2];
#pragma unroll
        for (int n = 0; n < 2; ++n) { bgv[n] = *(const f32x4*)(bg + 4 * n); buv[n] = *(const f32x4*)(bg + 1024 + 4 * n); }
#pragma unroll
        for (int ai = 0; ai < 2; ++ai)
#pragma unroll
            for (int m = 0; m < 4; ++m) { const int row = row0 + ai * 128 + m * 16; float hv[8];
#pragma unroll
                for (int n = 0; n < 2; ++n)
#pragma unroll
                    for (int i = 0; i < 4; ++i) { float gt = acc[ai][0][m][n][i] + bgv[n][i], up = acc[ai][1][m][n][i] + buv[n][i];
                        gt = fminf(gt, 7.0f); up = fminf(fmaxf(up, -7.0f), 7.0f);
                        hv[n * 4 + i] = (up + 1.0f) * gt * sigmoidf_(1.702f * gt); }
                u32x4 w; w.x = pg8::cvt_pk_bf16(hv[0], hv[1]); w.y = pg8::cvt_pk_bf16(hv[2], hv[3]); w.z = pg8::cvt_pk_bf16(hv[4], hv[5]); w.w = pg8::cvt_pk_bf16(hv[6], hv[7]);
                *(u32x4*)(H + (size_t)row * DM + hc) = w; }
    }
};
struct EpiDown {
    static constexpr bool PERM = false;
    float* Y; const float* b_down; const int* rtok; const float* rgate; int first;
    __device__ __forceinline__ void operator()(const f32x4 (&acc)[2][2][4][2], const pg8::Unit& u, int wr, int wc, int fr, int fq) const {
        const int row0 = u.pm * 256 + wr * 64 + fr, col0 = u.po * 256 + wc * 32 + 4 * fq;
        const float* bd = b_down + (size_t)u.pe * DM + col0;
#pragma unroll
        for (int ai = 0; ai < 2; ++ai)
#pragma unroll
            for (int m = 0; m < 4; ++m) { const int row = row0 + ai * 128 + m * 16; const int tok = rtok[row]; const float gt = rgate[row];
                if (tok >= 0) { float* yp = Y + (size_t)tok * DM + col0;
#pragma unroll
                    for (int bj = 0; bj < 2; ++bj)
#pragma unroll
                        for (int n = 0; n < 2; ++n) { const f32x4 bv = *(const f32x4*)(bd + bj * 128 + n * 16); f32x4 v = (acc[ai][bj][m][n] + bv) * gt;
                            if (!first) v += *(const f32x4*)(yp + bj * 128 + n * 16);
                            *(f32x4*)(yp + bj * 128 + n * 16) = v; } } }
    }
};
struct MoeOrder {
    const LAS int* offs; int npn, G, c, nunits;
    __device__ void init(const LAS int* offs_, int npn_, int G_, int c_) { offs = offs_; npn = npn_; G = G_; c = c_; nunits = (offs_[NEXP] >> 8) * npn_; }
    __device__ bool next(int i, pg8::Unit& u) const {
        const int L = i * G + c; if (L >= nunits) return false;
        const int pm = L / npn, pnl = L % npn; int e = 0;
        for (int k = 1; k < NEXP; ++k) e += (offs[k] <= pm * 256) ? 1 : 0;
        u.pm = pm; u.pn = e * npn + pnl; u.po = pnl; u.pe = e; return true;
    }
};

__device__ __forceinline__ void p2_cb(const Args& args, Frame& F) {
    const int gw = F.bid * NWAVES + F.wave, NGW = F.G * NWAVES;
    const float g0 = F_kv_norm_g[2 * F.lane], g1 = F_kv_norm_g[2 * F.lane + 1];
    for (int tok = gw; tok < T; tok += NGW) {
        const unsigned p = *(const unsigned*)(F_projb + (size_t)tok * NPROJ + C_CKV + 2 * F.lane);
        const float a = bflo(p), b = bfhi(p);
        const float ss = wave_sum(a * a + b * b);
        const float r = 1.0f / sqrtf(ss * (1.0f / 128.0f) + LN_EPS);
        *(unsigned*)(F_cb + (size_t)tok * 128 + 2 * F.lane) = pk2(a * r * g0, b * r * g1);
    }
}

__device__ __forceinline__ void p2_indexer(const Args& args, Frame& F) {
    const int lane = F.lane, wave = F.wave;
    {
        const int gw = F.bid * NWAVES + wave, NGW = F.G * NWAVES;
        for (int i = gw; i < NB * 256; i += NGW) { const int b = i >> 8, t = i & 255, ci = t >> 6; const int tok = b * SEQ + t;
            F_mask[(size_t)tok * 64 + lane] = (lane < 2 * (ci + 1)) ? 0xffffffffu : 0u; }
    }
    LAS float* qs = (LAS float*)(F.lds) + wave * 512;
    LAS float* sc = (LAS float*)(F.lds + 16384) + wave * 2048;
    for (int r = 0; r < 28; ++r) {
        const int ci = 31 - r, ntl = ci + 1;
        for (int sub = F.bid; sub < 256; sub += F.G) {
            const int b = sub >> 3, qg = sub & 7;
            const int t = ci * 64 + qg * 8 + wave; const int tok = b * SEQ + t;
            { const u32x4 p = *(const u32x4*)(F_projb + (size_t)tok * NPROJ + C_QI + 8 * lane);
              LAS float* q = qs + 8 * lane;
              q[0] = bflo(p.x); q[1] = bfhi(p.x); q[2] = bflo(p.y); q[3] = bfhi(p.y); q[4] = bflo(p.z); q[5] = bfhi(p.z); q[6] = bflo(p.w); q[7] = bfhi(p.w); }
            float wq[8];
#pragma unroll
            for (int h = 0; h < 8; ++h) wq[h] = F_g32[(size_t)tok * 16 + h];
            asm volatile("s_waitcnt lgkmcnt(0)" ::: "memory");
            for (int j = 0; j < ntl; ++j) {
                const int s = j * 64 + lane;
                const u32x4* kp = (const u32x4*)(F_projb + (size_t)(b * SEQ + s) * NPROJ + C_KI);
                float kf[64];
#pragma unroll
                for (int c = 0; c < 8; ++c) { const u32x4 p = kp[c]; kf[8 * c] = bflo(p.x); kf[8 * c + 1] = bfhi(p.x); kf[8 * c + 2] = bflo(p.y); kf[8 * c + 3] = bfhi(p.y);
                    kf[8 * c + 4] = bflo(p.z); kf[8 * c + 5] = bfhi(p.z); kf[8 * c + 6] = bflo(p.w); kf[8 * c + 7] = bfhi(p.w); }
                float score = 0.f;
#pragma unroll
                for (int h = 0; h < 8; ++h) { float d = 0.f;
#pragma unroll
                    for (int c = 0; c < 16; ++c) { const f32x4 qv = *(const LAS f32x4*)(qs + h * 64 + 4 * c); d += qv.x * kf[4 * c] + qv.y * kf[4 * c + 1] + qv.z * kf[4 * c + 2] + qv.w * kf[4 * c + 3]; }
                    score += wq[h] * fmaxf(d, 0.f); }
                sc[j * 64 + lane] = score + 0.0f;
            }
            asm volatile("s_waitcnt lgkmcnt(0)" ::: "memory");
            unsigned u[32];
#pragma unroll
            for (int j = 0; j < 32; ++j) { unsigned v = 0u; if (j < ntl) { const unsigned bts = __builtin_bit_cast(unsigned, sc[j * 64 + lane]); v = (bts & 0x80000000u) ? ~bts : (bts | 0x80000000u); } u[j] = v; }
            unsigned thr = 0u;
            for (int bit = 31; bit >= 0; --bit) {
                const unsigned cand = thr | (1u << bit); int cnt = 0;
#pragma unroll
                for (int j = 0; j < 32; ++j) cnt += __popcll(__ballot(u[j] >= cand));
                if (cnt >= KSEL) thr = cand;
            }
            int cgt = 0;
#pragma unroll
            for (int j = 0; j < 32; ++j) cgt += __popcll(__ballot(u[j] > thr));
            const int need = KSEL - cgt;
            int eqbase = 0;
            const unsigned long long ltmask = (1ull << lane) - 1ull;
#pragma unroll
            for (int j = 0; j < 32; ++j) {
                const unsigned long long eqm = __ballot(u[j] == thr);
                const int rk = eqbase + __popcll(eqm & ltmask);
                const bool sel = (u[j] > thr) || (u[j] == thr && rk < need);
                const unsigned long long sm = __ballot(sel);
                eqbase += __popcll(eqm);
                if (lane == 0) { F_mask[(size_t)tok * 64 + 2 * j] = (unsigned)sm; F_mask[(size_t)tok * 64 + 2 * j + 1] = (unsigned)(sm >> 32); }
            }
        }
    }
}

__device__ __forceinline__ void p2_mlstm(const Args& args, Frame& F) {
    const int tid = F.tid, lane = F.lane, wave = F.wave;
    LAS float* ucL = (LAS float*)(F.lds);
    LAS float* qL = (LAS float*)(F.lds + 32768);
    LAS float* kL = (LAS float*)(F.lds + 65536);
    LAS float* vL = (LAS float*)(F.lds + 98304);
    LAS float* gL = (LAS float*)(F.lds + LCTL_OFF + 4096);
    for (int item = F.bid; item < NB * 4; item += F.G) {
        const int b = item >> 2, h = item & 3;
        const int v = tid >> 2, kq = tid & 3;
        float C[32], nst[32];
#pragma unroll
        for (int j = 0; j < 32; ++j) { C[j] = 0.f; nst[j] = 0.f; }
        const float bi = F_b_i[h], bfv = F_b_f[h];
        for (int c = 0; c < NCH; ++c) {
            const int tok0 = b * SEQ + c * CHK;
            __syncthreads();
            for (int idx = tid; idx < 64 * 128; idx += NTHR) { const int t = idx >> 7, d = idx & 127; const int ch = h * 128 + d;
                float y = F_m_conv_b[ch];
#pragma unroll
                for (int j = 0; j < 4; ++j) { const int tt = c * CHK + t - 3 + j; if (tt >= 0) y += F_m_conv_w[j * 512 + ch] * bf2f(F_projb[(size_t)(b * SEQ + tt) * NPROJ + C_U + ch]); }
                ucL[idx] = y * sigmoidf_(y);
                vL[idx] = bf2f(F_projb[(size_t)(tok0 + t) * NPROJ + C_V + ch]); }
            if (tid < 64) { const float ip = F_g32[(size_t)(tok0 + tid) * 16 + 8 + h] + bi, fp = F_g32[(size_t)(tok0 + tid) * 16 + 12 + h] + bfv;
                gL[tid] = __expf(ip); gL[64 + tid] = sigmoidf_(fp); }
            __syncthreads();
            { const int e = tid & 127, tg = tid >> 7; float aq[16], ak[16];
#pragma unroll
              for (int i = 0; i < 16; ++i) { aq[i] = 0.f; ak[i] = 0.f; }
              const float* wq = F_w_mq + (size_t)h * 128 * 128 + e; const float* wk = F_w_mk + (size_t)h * 128 * 128 + e;
              for (int d = 0; d < 128; ++d) { const float a = wq[d * 128], bb = wk[d * 128];
#pragma unroll
                  for (int i = 0; i < 16; ++i) { const float uu = ucL[(tg * 16 + i) * 128 + d]; aq[i] += uu * a; ak[i] += uu * bb; } }
#pragma unroll
              for (int i = 0; i < 16; ++i) { qL[(tg * 16 + i) * 128 + e] = aq[i]; kL[(tg * 16 + i) * 128 + e] = ak[i] * 0.08838834764831845f; } }
            __syncthreads();
            for (int t = 0; t < 64; ++t) {
                const float f = gL[64 + t], ii = gL[t], vv = vL[t * 128 + v] * ii;
                float num = 0.f, den = 0.f;
#pragma unroll
                for (int j4 = 0; j4 < 8; ++j4) { const f32x4 kk = *(const LAS f32x4*)(kL + t * 128 + j4 * 16 + kq * 4); const f32x4 qq = *(const LAS f32x4*)(qL + t * 128 + j4 * 16 + kq * 4);
#pragma unroll
                    for (int i = 0; i < 4; ++i) { const int j = j4 * 4 + i; C[j] = f * C[j] + vv * kk[i]; nst[j] = f * nst[j] + ii * kk[i]; num += C[j] * qq[i]; den += nst[j] * qq[i]; } }
                num += __shfl_xor(num, 1); num += __shfl_xor(num, 2);
                den += __shfl_xor(den, 1); den += __shfl_xor(den, 2);
                if (kq == 0) ucL[t * 128 + v] = num / fmaxf(fabsf(den), 1.0f);
            }
            __syncthreads();
            for (int t = wave; t < 64; t += 8) { const float a0 = ucL[t * 128 + 2 * lane], a1 = ucL[t * 128 + 2 * lane + 1];
                const float mu = wave_sum(a0 + a1) * (1.0f / 128.0f); const float d0 = a0 - mu, d1 = a1 - mu;
                const float var = wave_sum(d0 * d0 + d1 * d1) * (1.0f / 128.0f); const float rs = 1.0f / sqrtf(var + LN_EPS);
                const int ch = h * 128 + 2 * lane; const unsigned zp = *(const unsigned*)(F_projb + (size_t)(tok0 + t) * NPROJ + C_Z + ch);
                const float o0 = sigmoidf_(bflo(zp)) * d0 * rs * F_m_norm_g[ch], o1 = sigmoidf_(bfhi(zp)) * d1 * rs * F_m_norm_g[ch + 1];
                *(unsigned*)(F_mix + (size_t)(tok0 + t) * DM + 512 + ch) = pk2(o0, o1); }
        }
        __syncthreads();
    }
}

__device__ __forceinline__ void p3_attn(const Args& args, Frame& F) {
    const int tid = F.tid, lane = F.lane, wave = F.wave;
    LAS int* selL = (LAS int*)(F.lds);
    LAS int* nselL = (LAS int*)(F.lds + 1024);
    LAS float* qlat = (LAS float*)(F.lds + 2048);
    LAS float* lg = (LAS float*)(F.lds + 8192);
    LAS float* olat = (LAS float*)(F.lds + 16384);
    LAS unsigned char* csel = F.lds + 32768;
    constexpr int CROW = 272;
    for (int tok = F.bid; tok < T; tok += F.G) {
        const int b = tok >> 11, t = tok & 2047, ci = t >> 6, ntl = ci + 1;
        __syncthreads();
#pragma unroll
        for (int oo = 0; oo < 2; ++oo) { const int o = tid * 2 + oo, h = o >> 7; const float* w = F_w_uk + (size_t)o * 64; const u32x4* qp = (const u32x4*)(F_projb + (size_t)tok * NPROJ + C_QA + h * 64);
            float a = 0.f;
#pragma unroll
            for (int c = 0; c < 8; ++c) { const u32x4 p = qp[c]; const f32x4 w0 = *(const f32x4*)(w + 8 * c), w1 = *(const f32x4*)(w + 8 * c + 4);
                a += bflo(p.x) * w0.x + bfhi(p.x) * w0.y + bflo(p.y) * w0.z + bfhi(p.y) * w0.w + bflo(p.z) * w1.x + bfhi(p.z) * w1.y + bflo(p.w) * w1.z + bfhi(p.w) * w1.w; }
            qlat[o] = a * 0.125f; }
        if (wave == 0) { int base = 0;
            for (int j = 0; j < ntl; ++j) { const unsigned long long m = (unsigned long long)F_mask[(size_t)tok * 64 + 2 * j] | ((unsigned long long)F_mask[(size_t)tok * 64 + 2 * j + 1] << 32);
                if ((m >> lane) & 1ull) { const int pos = base + __popcll(m & ((1ull << lane) - 1ull)); if (pos < 256) selL[pos] = j * 64 + lane; }
                base += __popcll(m); }
            if (lane == 0) nselL[0] = base < 256 ? base : 256; }
        __syncthreads();
        const int nsel = nselL[0];
        for (int idx = tid; idx < 256 * 16; idx += NTHR) { const int j = idx >> 4, c = idx & 15;
            if (j < nsel) { const u32x4 p = *(const u32x4*)(F_cb + (size_t)(b * SEQ + selL[j]) * 128 + 8 * c); *(LAS u32x4*)(csel + j * CROW + 16 * c) = p; } }
        __syncthreads();
        { const int j = tid & 255, hg = tid >> 8; float a[4] = {0.f, 0.f, 0.f, 0.f};
          if (j < nsel) {
#pragma unroll
              for (int c = 0; c < 16; ++c) { const u32x4 p = *(const LAS u32x4*)(csel + j * CROW + 16 * c);
                  const float cv[8] = {bflo(p.x), bfhi(p.x), bflo(p.y), bfhi(p.y), bflo(p.z), bfhi(p.z), bflo(p.w), bfhi(p.w)};
#pragma unroll
                  for (int hh = 0; hh < 4; ++hh) { const LAS float* q = qlat + (hg * 4 + hh) * 128 + 8 * c;
#pragma unroll
                      for (int i = 0; i < 8; ++i) a[hh] += q[i] * cv[i]; } }
              const float dist = fabsf((float)(t - selL[j]));
#pragma unroll
              for (int hh = 0; hh < 4; ++hh) { const int h = hg * 4 + hh; const float slope = exp2f(-(float)(h + 1)); lg[h * 256 + j] = a[hh] - slope * dist; }
          } else {
#pragma unroll
              for (int hh = 0; hh < 4; ++hh) lg[(hg * 4 + hh) * 256 + j] = -INFINITY;
          } }
        __syncthreads();
        { float v[4]; float mx = -INFINITY;
#pragma unroll
          for (int i = 0; i < 4; ++i) { v[i] = lg[wave * 256 + lane + 64 * i]; mx = fmaxf(mx, v[i]); }
          mx = wave_max(mx); float s = 0.f;
#pragma unroll
          for (int i = 0; i < 4; ++i) { v[i] = __expf(v[i] - mx); s += v[i]; }
          s = wave_sum(s); const float inv = 1.0f / s;
#pragma unroll
          for (int i = 0; i < 4; ++i) lg[wave * 256 + lane + 64 * i] = v[i] * inv; }
        __syncthreads();
        { const int r = tid & 127, hg = tid >> 7; float a0 = 0.f, a1 = 0.f;
          for (int j = 0; j < nsel; ++j) { const float cv = bf2f(*(const LAS bf16_t*)(csel + j * CROW + 2 * r)); a0 += lg[(hg * 2) * 256 + j] * cv; a1 += lg[(hg * 2 + 1) * 256 + j] * cv; }
          olat[(hg * 2) * 128 + r] = a0; olat[(hg * 2 + 1) * 128 + r] = a1; }
        __syncthreads();
        { const int h = tid >> 6, d = tid & 63; const float* w = F_w_uv + (size_t)h * 128 * 64 + d; float a = 0.f;
#pragma unroll 8
          for (int r = 0; r < 128; ++r) a += olat[h * 128 + r] * w[r * 64];
          F_mix[(size_t)tok * DM + tid] = (bf16_t)f2bf(a); }
    }
}

__device__ __forceinline__ void p5_ln1_router(const Args& args, Frame& F) {
    const int lane = F.lane;
    const int gtid = F.bid * NTHR + F.tid, NT = F.G * NTHR;
    for (int i = gtid; i < NROUND * RCAP; i += NT) F_rtok[i] = -1;
    const int gw = F.bid * NWAVES + F.wave, NGW = F.G * NWAVES;
    f32x4 gv[4], bv[4];
#pragma unroll
    for (int j = 0; j < 4; ++j) { gv[j] = *((const f32x4*)F_ln1_g + lane + 64 * j); bv[j] = *((const f32x4*)F_ln1_b + lane + 64 * j); }
    for (int tok = gw; tok < T; tok += NGW) {
        const f32x4* pr = (const f32x4*)(F_pre1 + (size_t)tok * DM) + lane;
        f32x4 v[4]; float s = 0.f;
#pragma unroll
        for (int j = 0; j < 4; ++j) { v[j] = pr[64 * j]; s += (v[j].x + v[j].y) + (v[j].z + v[j].w); }
        const float mean = wave_sum(s) * (1.0f / DM); float s2 = 0.f;
#pragma unroll
        for (int j = 0; j < 4; ++j) { v[j] = v[j] - mean; s2 += (v[j].x * v[j].x + v[j].y * v[j].y) + (v[j].z * v[j].z + v[j].w * v[j].w); }
        const float rstd = 1.0f / sqrtf(wave_sum(s2) * (1.0f / DM) + LN_EPS);
        u32x2* o = (u32x2*)(F_h1b + (size_t)tok * DM) + lane;
#pragma unroll
        for (int j = 0; j < 4; ++j) { v[j] = v[j] * rstd * gv[j] + bv[j]; u32x2 w; w.x = pk2(v[j].x, v[j].y); w.y = pk2(v[j].z, v[j].w); o[64 * j] = w; }
        float lgt[32];
#pragma unroll
        for (int e = 0; e < 32; ++e) lgt[e] = 0.f;
#pragma unroll
        for (int j = 0; j < 4; ++j)
#pragma unroll
            for (int i = 0; i < 4; ++i) { const int d = 256 * j + 4 * lane + i; const f32x4* wr = (const f32x4*)(F_w_router + (size_t)d * 32); const float hv = v[j][i];
#pragma unroll
                for (int q = 0; q < 8; ++q) { const f32x4 w = wr[q]; lgt[4 * q] += hv * w.x; lgt[4 * q + 1] += hv * w.y; lgt[4 * q + 2] += hv * w.z; lgt[4 * q + 3] += hv * w.w; } }
#pragma unroll
        for (int e = 0; e < 32; ++e) lgt[e] = wave_sum(lgt[e]) + F_b_router[e];
        int te[4]; float tv[4];
#pragma unroll
        for (int k = 0; k < 4; ++k) { float best = -INFINITY; int bi = 0;
#pragma unroll
            for (int e = 0; e < 32; ++e) { const bool taken = (k > 0 && te[0] == e) || (k > 1 && te[1] == e) || (k > 2 && te[2] == e); if (!taken && lgt[e] > best) { best = lgt[e]; bi = e; } }
            te[k] = bi; tv[k] = best; }
        float es[4], sum = 0.f;
#pragma unroll
        for (int k = 0; k < 4; ++k) { es[k] = __expf(tv[k] - tv[0]); sum += es[k]; }
        if (lane < 4) { int e = te[0]; float gt = es[0]; if (lane == 1) { e = te[1]; gt = es[1]; } if (lane == 2) { e = te[2]; gt = es[2]; } if (lane == 3) { e = te[3]; gt = es[3]; }
            const int rk = (int)atomicAdd(F_ctl + CW_CNT + lane * NEXP + e, 1u);
            F_tope[tok * 4 + lane] = e; F_gate[tok * 4 + lane] = gt / sum; F_rank[tok * 4 + lane] = rk; }
    }
}
__device__ __forceinline__ void moe_offsets(const Args& args, Frame& F, LAS int* offs) {
    __syncthreads();
    if (F.tid < NROUND) { int acc = 0; for (int e = 0; e < NEXP; ++e) { offs[F.tid * 33 + e] = acc; const int c = (int)__hip_atomic_load(F_ctl + CW_CNT + F.tid * NEXP + e, __ATOMIC_RELAXED, __HIP_MEMORY_SCOPE_AGENT); acc += (c + 255) & ~255; } offs[F.tid * 33 + NEXP] = acc; }
    __syncthreads();
}
__device__ __forceinline__ void p6_fill(const Args& args, Frame& F, LAS int* offs) {
    const int gtid = F.bid * NTHR + F.tid, NT = F.G * NTHR;
    for (int i = gtid; i < T * 4; i += NT) { const int j = i & 3, tok = i >> 2; const int e = F_tope[i]; const int row = offs[j * 33 + e] + F_rank[i];
        F_rtok[j * RCAP + row] = tok; F_rgate[j * RCAP + row] = F_gate[i]; }
}
__device__ __forceinline__ void p7_gather(const Args& args, Frame& F, LAS int* offs, int rnd) {
    const int gw = F.bid * NWAVES + F.wave, NGW = F.G * NWAVES; const int nrows = offs[rnd * 33 + NEXP];
    for (int r = gw; r < nrows; r += NGW) { int tok = F_rtok[rnd * RCAP + r]; if (tok < 0) tok = 0;
        const u32x4* s = (const u32x4*)(F_h1b + (size_t)tok * DM) + F.lane; u32x4* d = (u32x4*)(F_xg + (size_t)r * DM) + F.lane;
        d[0] = s[0]; d[64] = s[64]; }
}
__device__ __forceinline__ void p9_final(const Args& args, Frame& F) {
    const int lane = F.lane; const int gw = F.bid * NWAVES + F.wave, NGW = F.G * NWAVES;
    f32x4 gv[4], bv[4];
#pragma unroll
    for (int j = 0; j < 4; ++j) { gv[j] = *((const f32x4*)F_ln2_g + lane + 64 * j); bv[j] = *((const f32x4*)F_ln2_b + lane + 64 * j); }
    for (int tok = gw; tok < T; tok += NGW) {
        f32x4* yr = (f32x4*)(F_out + (size_t)tok * DM) + lane; const u32x2* hr = (const u32x2*)(F_h1b + (size_t)tok * DM) + lane;
        f32x4 v[4]; float s = 0.f;
#pragma unroll
        for (int j = 0; j < 4; ++j) { const f32x4 y = yr[64 * j]; const u32x2 hp = hr[64 * j]; v[j].x = DN_ALPHA * bflo(hp.x) + y.x; v[j].y = DN_ALPHA * bfhi(hp.x) + y.y; v[j].z = DN_ALPHA * bflo(hp.y) + y.z; v[j].w = DN_ALPHA * bfhi(hp.y) + y.w;
            s += (v[j].x + v[j].y) + (v[j].z + v[j].w); }
        const float mean = wave_sum(s) * (1.0f / DM); float s2 = 0.f;
#pragma unroll
        for (int j = 0; j < 4; ++j) { v[j] = v[j] - mean; s2 += (v[j].x * v[j].x + v[j].y * v[j].y) + (v[j].z * v[j].z + v[j].w * v[j].w); }
        const float rstd = 1.0f / sqrtf(wave_sum(s2) * (1.0f / DM) + LN_EPS);
#pragma unroll
        for (int j = 0; j < 4; ++j) yr[64 * j] = v[j] * rstd * gv[j] + bv[j];
    }
}

constexpr int PH_P0 = 0, PH_P1 = 1, PH_P2 = 2, PH_P3 = 3, PH_P4 = 4, PH_P5 = 5, PH_P6 = 6, PH_MOE = 7, PH_FINAL = PH_MOE + 3 * NROUND, N_PHASES = PH_FINAL + 1;

template <unsigned MASK>
__global__ void __launch_bounds__(NTHR, 2) mk_fwd(Args args) {
    extern __shared__ __attribute__((aligned(16))) unsigned char lds_raw[];
    cg::grid_group grid = cg::this_grid();
    Frame F;
    F.lds = (LAS unsigned char*)lds_raw;
    F.tid = threadIdx.x; F.lane = F.tid & 63; F.wave = __builtin_amdgcn_readfirstlane(F.tid >> 6); F.G = gridDim.x; F.bid = blockIdx.x;
    LAS int* offs = (LAS int*)(F.lds + LCTL_OFF);
    const int lo = args.ph_lo, hi = args.ph_hi;
#define PH_BIT(k) ((k) < PH_MOE ? (k) : ((k) == PH_FINAL ? 10 : 7 + (((k) - PH_MOE) % 3)))
#define IN(k) (((MASK >> PH_BIT(k)) & 1u) && lo <= (k) && (k) < hi)
#define SEAM(k) do { if (IN(k) && IN((k) + 1)) grid.sync(); F.tid = launder(threadIdx.x); F.lane = F.tid & 63; F.wave = __builtin_amdgcn_readfirstlane(F.tid >> 6); } while (0)

    if (IN(PH_P0)) { p0_prologue(args, F); } SEAM(PH_P0);
    if (IN(PH_P1)) { pg8::Gemm g{F_xb, F_WinT, DM, DM, DM}; pg8::StaticOrder S; S.init(T, NPROJ, F.G, F.bid); EpiProj E{F_projb, F_g32};
        pg8::gemm_phase<EpiProj, pg8::StaticOrder>(F.lds, g, S, E); } SEAM(PH_P1);
    if (IN(PH_P2)) { p2_cb(args, F); p2_indexer(args, F); __syncthreads(); p2_mlstm(args, F); } SEAM(PH_P2);
    if (IN(PH_P3)) { p3_attn(args, F); } SEAM(PH_P3);
    if (IN(PH_P4)) { pg8::Gemm g{F_mix, F_WoutT, DM, DM, DM}; pg8::StaticOrder S; S.init(T, DM, F.G, F.bid); EpiOut E{F_x, F_pre1};
        pg8::gemm_phase<EpiOut, pg8::StaticOrder>(F.lds, g, S, E); } SEAM(PH_P4);
    if (IN(PH_P5)) { p5_ln1_router(args, F); } SEAM(PH_P5);
    if (IN(PH_P6)) { moe_offsets(args, F, offs); p6_fill(args, F, offs); } SEAM(PH_P6);
#define INM(j) (((MASK >> (7 + (j))) & 1u) && lo <= pa + (j) && pa + (j) < hi)
#define SEAMM(j) do { if (lo <= pa + (j) && pa + (j) + 1 < hi) grid.sync(); F.tid = launder(threadIdx.x); F.lane = F.tid & 63; F.wave = __builtin_amdgcn_readfirstlane(F.tid >> 6); } while (0)
#pragma unroll 1
    for (int rnd = 0; rnd < NROUND; ++rnd) {
        const int pa = PH_MOE + 3 * rnd;
        if (INM(0)) { moe_offsets(args, F, offs); p7_gather(args, F, offs, rnd); } SEAMM(0);
        if (INM(1)) { moe_offsets(args, F, offs); pg8::Gemm g{F_xg, F_WguT, DM, DM, DM}; MoeOrder S; S.init(offs + rnd * 33, 8, F.G, F.bid); EpiGU E{F_hb, F_b_gu};
            pg8::gemm_phase<EpiGU, MoeOrder>(F.lds, g, S, E); } SEAMM(1);
        if (INM(2)) { moe_offsets(args, F, offs); pg8::Gemm g{F_hb, F_WdT, DM, DM, DM}; MoeOrder S; S.init(offs + rnd * 33, 4, F.G, F.bid);
            EpiDown E{F_out, F_b_down, F_rtok + rnd * RCAP, F_rgate + rnd * RCAP, rnd == 0 ? 1 : 0};
            pg8::gemm_phase<EpiDown, MoeOrder>(F.lds, g, S, E); } SEAMM(2);
    }
    if (IN(PH_FINAL)) { p9_final(args, F); }
#undef IN
#undef SEAM
}

extern "C" void kernel_launch(void* const* d_in, const int* in_sizes, int n_in, void* d_out, int out_size, void* d_ws, size_t ws_size, hipStream_t stream) {
    static int grid = 0;
#if MK_ONE_LAUNCH
    void* kfn[1] = {(void*)mk_fwd<0x7ffu>};
    constexpr int NKFN = 1;
#else
    void* kfn[11] = {(void*)mk_fwd<1u << 0>, (void*)mk_fwd<1u << 1>, (void*)mk_fwd<1u << 2>, (void*)mk_fwd<1u << 3>, (void*)mk_fwd<1u << 4>, (void*)mk_fwd<1u << 5>,
                     (void*)mk_fwd<1u << 6>, (void*)mk_fwd<1u << 7>, (void*)mk_fwd<1u << 8>, (void*)mk_fwd<1u << 9>, (void*)mk_fwd<1u << 10>};
    constexpr int NKFN = 11;
#endif
    if (grid == 0) {
        if (n_in != 23 || out_size != T * DM || ws_size < WS_END) { fprintf(stderr, "kernel_launch: unexpected shapes (n_in %d, out %d, ws %zu, need %zu)\n", n_in, out_size, ws_size, (size_t)WS_END); grid = -1; return; }
        int dev = 0, cus = 0, per_cu = 0;
        hipGetDevice(&dev); hipDeviceGetAttribute(&cus, hipDeviceAttributeMultiprocessorCount, dev);
        for (int k = 0; k < NKFN; ++k) {
            if (hipFuncSetAttribute((const void*)kfn[k], hipFuncAttributeMaxDynamicSharedMemorySize, LDS_BYTES) != hipSuccess) { fprintf(stderr, "kernel_launch: hipFuncSetAttribute failed\n"); grid = -1; return; }
            int pc = 0;
            if (hipOccupancyMaxActiveBlocksPerMultiprocessor(&pc, (const void*)kfn[k], NTHR, LDS_BYTES) != hipSuccess || pc < 1) { fprintf(stderr, "kernel_launch: occupancy query says %d for kernel %d\n", pc, k); grid = -1; return; }
            per_cu = pc;
        }
        (void)hipGetLastError();
        grid = cus * 1;
        fprintf(stderr, "kernel_launch: cus %d per_cu %d grid %d\n", cus, per_cu, grid);
    }
    if (grid < 0) return;
    hipMemsetAsync((char*)d_ws + WS_CTL, 0, CTL_BYTES, stream);
    Args a{};
    for (int i = 0; i < 23; ++i) a.in[i] = (const float*)d_in[i];
    a.out = (float*)d_out; a.ws = (unsigned char*)d_ws;
#if MK_ONE_LAUNCH
    a.ph_lo = 0; a.ph_hi = N_PHASES;
    { void* kargs[] = {&a}; hipError_t e = hipLaunchCooperativeKernel((void*)mk_fwd<0x7ffu>, dim3(grid), dim3(NTHR), kargs, LDS_BYTES, stream);
      if (e != hipSuccess) fprintf(stderr, "cooperative launch failed: %s\n", hipGetErrorString(e)); }
#else
    for (int p = 0; p < N_PHASES; ++p) {
        a.ph_lo = p; a.ph_hi = p + 1;
        void* kargs[] = {&a}; hipError_t e = hipLaunchCooperativeKernel(kfn[PH_BIT(p)], dim3(grid), dim3(NTHR), kargs, LDS_BYTES, stream);
        if (e != hipSuccess) { fprintf(stderr, "cooperative launch %d failed: %s\n", p, hipGetErrorString(e)); break; }
    }
#endif
}
```

```cpp
#include <hip/hip_runtime.h>
#include <hip/hip_cooperative_groups.h>
#include <cstdio>
#include <cstdint>
namespace cg = cooperative_groups;

#ifndef MK_ONE_LAUNCH
#define MK_ONE_LAUNCH 0
#endif

#define GAS __attribute__((address_space(1)))
#define LAS __attribute__((address_space(3)))
typedef unsigned short bf16_t;
typedef short bf16x8 __attribute__((ext_vector_type(8)));
typedef float f32x4 __attribute__((ext_vector_type(4)));
typedef float f32x2 __attribute__((ext_vector_type(2)));
typedef unsigned u32x4 __attribute__((ext_vector_type(4)));
typedef unsigned u32x2 __attribute__((ext_vector_type(2)));

constexpr int T = 65536, DM = 1024, NB = 32, SEQ = 2048, CHK = 64, NCH = 32;
constexpr int NPROJ = 2816;
constexpr int C_QA = 0, C_CKV = 512, C_QI = 640, C_KI = 1152, C_U = 1216, C_V = 1728, C_Z = 2240, C_WI = 2752, C_IG = 2760, C_FG = 2764;
constexpr int IN_W = 2768;
constexpr int NEXP = 32, TOPE = 4, NROUND = 4;
constexpr int RCAP = T + NEXP * 256;
constexpr float LN_EPS = 1e-5f;
constexpr float DN_ALPHA = 1.189207115002721f;
constexpr int KSEL = 256;

constexpr size_t MiB = 1u << 20;
constexpr size_t WS_CTL = 0, CTL_BYTES = 1 * MiB;
constexpr size_t WS_WIN = 1 * MiB;
constexpr size_t WS_WOUT = 7 * MiB;
constexpr size_t WS_WGU = 9 * MiB;
constexpr size_t WS_WD = 137 * MiB;
constexpr size_t WS_XB = 201 * MiB;
constexpr size_t WS_H1B = WS_XB;
constexpr size_t WS_PROJ = 329 * MiB;
constexpr size_t WS_PRE1 = WS_PROJ;
constexpr size_t WS_XG = WS_PROJ;
constexpr size_t WS_HB = WS_PROJ + 144 * MiB;
constexpr size_t WS_G32 = 681 * MiB;
constexpr size_t WS_CB = 685 * MiB;
constexpr size_t WS_MASK = 701 * MiB;
constexpr size_t WS_MIX = 717 * MiB;
constexpr size_t WS_TOPE = 845 * MiB;
constexpr size_t WS_GATE = 846 * MiB;
constexpr size_t WS_RANK = 847 * MiB;
constexpr size_t WS_RTOK = 848 * MiB;
constexpr size_t WS_RGATE = 850 * MiB;
constexpr size_t WS_WUKB = 852 * MiB;
constexpr size_t WS_WUVF = 853 * MiB;
constexpr size_t WS_END = 854 * MiB;
constexpr int CW_CNT = 64;

constexpr int RING_BYTES = 131072;
constexpr int LCTL_OFF = RING_BYTES;
constexpr int LDS_BYTES = 147456;
constexpr int NWAVES = 8, NTHR = 512;

__device__ __forceinline__ unsigned f2bf(float f) { unsigned u = __builtin_bit_cast(unsigned, f); return (u + 0x7fffu + ((u >> 16) & 1u)) >> 16; }
__device__ __forceinline__ unsigned pk2(float lo, float hi) { return f2bf(lo) | (f2bf(hi) << 16); }
typedef __bf16 bf16v2_t __attribute__((ext_vector_type(2)));
__device__ __forceinline__ unsigned cvtpk_c(float lo, float hi) { bf16v2_t v = {(__bf16)lo, (__bf16)hi}; return __builtin_bit_cast(unsigned, v); }
__device__ __forceinline__ float bf2f(unsigned h) { return __builtin_bit_cast(float, h << 16); }
__device__ __forceinline__ float bflo(unsigned p) { return __builtin_bit_cast(float, p << 16); }
__device__ __forceinline__ float bfhi(unsigned p) { return __builtin_bit_cast(float, p & 0xffff0000u); }
__device__ __forceinline__ float wave_sum(float v) {
#pragma unroll
    for (int o = 1; o < 64; o <<= 1) v += __shfl_xor(v, o);
    return v;
}
__device__ __forceinline__ float wave_max(float v) {
#pragma unroll
    for (int o = 1; o < 64; o <<= 1) v = fmaxf(v, __shfl_xor(v, o));
    return v;
}
__device__ __forceinline__ int launder(int v) { asm volatile("" : "+v"(v)); return v; }
__device__ __forceinline__ float sigmoidf_(float x) { return 1.0f / (1.0f + __expf(-x)); }

namespace pg8 {
constexpr int BM = 256, BK = 64, HALF = 128, HTB = HALF * BK * 2, STAGE_BYTES = 8 * HTB, NXCD = 8, WGM = 8;
__host__ __device__ __forceinline__ int lds_byte(int r, int c) { const int st = (r >> 4) * 2 + (c >> 5), rr = r & 15, cc = c & 31, ob = rr * 64 + cc * 2; return st * 1024 + (ob ^ (((ob >> 9) & 1) << 5)); }
__host__ __device__ __forceinline__ void stage_rc(int b, int& R, int& C) { const int st = b / 1024, sb = b % 1024, swz = sb ^ (((sb >> 9) & 1) << 5); R = (st >> 1) * 16 + swz / 64; C = (st & 1) * 32 + (swz % 64) / 2; }
__host__ __device__ __forceinline__ int perm32(int rho) { const int n = rho >> 4, i = rho & 15; return 8 * (i >> 2) + 4 * n + (i & 3); }

struct Unit { int pm, pn, po, pe; };
struct Gemm { const bf16_t* A; const bf16_t* Bt; int lda, ldb, K; };

struct StaticOrder {
    int nM, nN, nwg, G, c;
    __device__ void init(int M, int N, int G_, int c_) { nM = M / BM; nN = N / BM; nwg = nM * nN; G = G_; c = c_; }
    __device__ bool next(int i, Unit& u) const {
        const long L = (long)i * G + c; if (L >= nwg) return false;
        int wgid = (int)L; { const int q = nwg / NXCD, r = nwg % NXCD, xcd = wgid % NXCD, off = wgid / NXCD; wgid = (xcd < r ? xcd * (q + 1) : r * (q + 1) + (xcd - r) * q) + off; }
        const int nig = WGM * nN, gid = wgid / nig, fm = gid * WGM, gsz = (nM - fm) < WGM ? (nM - fm) : WGM;
        u.pm = fm + ((wgid % nig) % gsz); u.pn = (wgid % nig) / gsz; u.po = u.pn; u.pe = 0; return true;
    }
};

__device__ __forceinline__ unsigned cvt_pk_bf16(float lo, float hi) { return cvtpk_c(lo, hi); }

template <class Epi, class Sched>
__device__ __forceinline__ void gemm_phase(LAS unsigned char* lds, const Gemm g, const Sched& S, const Epi& E) {
    int tid = threadIdx.x; asm volatile("" : "+v"(tid));
    const int wid = __builtin_amdgcn_readfirstlane(tid >> 6), lane = tid & 63, wr = wid >> 2, wc = wid & 3, fr = lane & 15, fq = lane >> 4;
    const int K = g.K, nt = K / BK;
    unsigned voffA[2], voffB[2];
#pragma unroll
    for (int i = 0; i < 2; ++i) { int R, C; stage_rc(tid * 16 + i * 8192, R, C); const int Rb = Epi::PERM ? ((R & ~31) + perm32(R & 31)) : R;
        voffA[i] = (unsigned)(R * g.lda + C) * 2u; voffB[i] = (unsigned)(Rb * g.ldb + C) * 2u; }
    const size_t kstep = (size_t)(BK * 2);
    const size_t hstepA = (size_t)HALF * g.lda * 2, hstepB = (size_t)HALF * g.ldb * 2;
    const size_t tstepA = 2 * hstepA, tstepB = 2 * hstepB;
    const unsigned ldsw = (unsigned)wid * 1024u;
    const int aoff = lds_byte(wr * 64 + fr, fq * 8), boff = lds_byte(wc * 32 + fr, fq * 8);
#define PG8_SA(b, h) (((b) * 2 + (h)) * HTB)
#define PG8_SB(b, h) ((4 + (b) * 2 + (h)) * HTB)
#define PG8_STAGE(bufoff, gbase, voff) do { _Pragma("unroll") for (int _i = 0; _i < 2; ++_i) \
        __builtin_amdgcn_global_load_lds((const unsigned*)((const char*)(gbase) + (voff)[_i]), (LAS unsigned*)(lds + (bufoff) + ldsw + _i * 8192), 16, 0, 0); } while (0)
#define PG8_LDA(dst, b, h) do { _Pragma("unroll") for (int m = 0; m < 4; ++m) _Pragma("unroll") for (int k = 0; k < 2; ++k) dst[m][k] = *(const LAS bf16x8*)(lds + PG8_SA(b, h) + aoff + m * 2048 + k * 1024); } while (0)
#define PG8_LDB(dst, b, h) do { _Pragma("unroll") for (int n = 0; n < 2; ++n) _Pragma("unroll") for (int k = 0; k < 2; ++k) dst[n][k] = *(const LAS bf16x8*)(lds + PG8_SB(b, h) + boff + n * 2048 + k * 1024); } while (0)
#define PG8_MMA(ai, bj, At, Bt) do { __builtin_amdgcn_s_setprio(1); _Pragma("unroll") for (int m = 0; m < 4; ++m) _Pragma("unroll") for (int n = 0; n < 2; ++n) _Pragma("unroll") for (int k = 0; k < 2; ++k) \
        acc[ai][bj][m][n] = __builtin_amdgcn_mfma_f32_16x16x32_bf16(Bt[n][k], At[m][k], acc[ai][bj][m][n], 0, 0, 0); __builtin_amdgcn_s_setprio(0); } while (0)
#define PG8_WAIT_V(n) asm volatile("s_waitcnt vmcnt(" #n ")" ::: "memory")
#define PG8_WAIT_L(n) asm volatile("s_waitcnt lgkmcnt(" #n ")" ::: "memory")
#define PG8_BAR __builtin_amdgcn_s_barrier()
#define PG8_SCHED __builtin_amdgcn_sched_barrier(0)
    Unit cur, nxt; int ui = 0;
    if (!S.next(0, cur)) return;
    f32x4 acc[2][2][4][2];
#pragma unroll
    for (int a = 0; a < 2; ++a)
#pragma unroll
        for (int b = 0; b < 2; ++b)
#pragma unroll
            for (int m = 0; m < 4; ++m)
#pragma unroll
                for (int n = 0; n < 2; ++n) acc[a][b][m][n] = (f32x4){0.f, 0.f, 0.f, 0.f};
    bf16x8 At[4][2], B0[2][2], B1[2][2];
    const char* cA = (const char*)g.A + (size_t)cur.pm * tstepA; const char* cB = (const char*)g.Bt + (size_t)cur.pn * tstepB;
    PG8_STAGE(PG8_SB(0, 0), cB, voffB); PG8_STAGE(PG8_SB(0, 1), cB + hstepB, voffB); PG8_STAGE(PG8_SA(0, 0), cA, voffA); PG8_STAGE(PG8_SA(0, 1), cA + hstepA, voffA);
    if (wr == 1) PG8_BAR;
    PG8_WAIT_V(2); PG8_BAR;
    PG8_STAGE(PG8_SB(1, 0), cB + kstep, voffB); PG8_STAGE(PG8_SA(1, 0), cA + kstep, voffA); PG8_STAGE(PG8_SB(1, 1), cB + hstepB + kstep, voffB);
    PG8_WAIT_V(6); PG8_BAR;
    for (;;) {
        const bool has_next = S.next(ui + 1, nxt);
        const char* nA = has_next ? (const char*)g.A + (size_t)nxt.pm * tstepA : cA; const char* nB = has_next ? (const char*)g.Bt + (size_t)nxt.pn * tstepB : cB;
        for (int t = 0; t < nt; t += 2) {
            const bool last = (t == nt - 2);
            const char* a1 = cA + (size_t)(t + 1) * kstep;
            const char* a2 = last ? nA : cA + (size_t)(t + 2) * kstep; const char* b2 = last ? nB : cB + (size_t)(t + 2) * kstep;
            const char* a3 = a2 + kstep; const char* b3 = b2 + kstep;
            PG8_LDB(B0, 0, 0); PG8_LDB(B1, 0, 1); PG8_SCHED; PG8_LDA(At, 0, 0); PG8_STAGE(PG8_SA(1, 1), a1 + hstepA, voffA);
            PG8_WAIT_V(8); PG8_WAIT_L(0); PG8_BAR; PG8_MMA(0, 0, At, B0); PG8_MMA(0, 1, At, B1); PG8_BAR; PG8_SCHED;
            PG8_LDA(At, 0, 1); PG8_STAGE(PG8_SB(0, 0), b2, voffB); PG8_STAGE(PG8_SB(0, 1), b2 + hstepB, voffB); PG8_STAGE(PG8_SA(0, 0), a2, voffA);
            PG8_WAIT_V(8); PG8_WAIT_L(0); PG8_BAR; PG8_MMA(1, 0, At, B0); PG8_MMA(1, 1, At, B1); PG8_BAR; PG8_SCHED;
            PG8_LDB(B0, 1, 0); PG8_LDB(B1, 1, 1); PG8_SCHED; PG8_LDA(At, 1, 0); PG8_STAGE(PG8_SA(0, 1), a2 + hstepA, voffA);
            PG8_WAIT_V(8); PG8_WAIT_L(0); PG8_BAR; PG8_MMA(0, 0, At, B0); PG8_MMA(0, 1, At, B1); PG8_BAR; PG8_SCHED;
            PG8_LDA(At, 1, 1); PG8_STAGE(PG8_SB(1, 0), b3, voffB); PG8_STAGE(PG8_SB(1, 1), b3 + hstepB, voffB); PG8_STAGE(PG8_SA(1, 0), a3, voffA);
            PG8_WAIT_V(8); PG8_WAIT_L(0); PG8_BAR; PG8_MMA(1, 0, At, B0); PG8_MMA(1, 1, At, B1); PG8_BAR; PG8_SCHED;
        }
        if (wr == 0) PG8_BAR;
        E(acc, cur, wr, wc, fr, fq);
        if (!has_next) break;
#pragma unroll
        for (int a = 0; a < 2; ++a)
#pragma unroll
            for (int b = 0; b < 2; ++b)
#pragma unroll
                for (int m = 0; m < 4; ++m)
#pragma unroll
                    for (int n = 0; n < 2; ++n) acc[a][b][m][n] = (f32x4){0.f, 0.f, 0.f, 0.f};
        cur = nxt; cA = nA; cB = nB; ++ui;
        if (wr == 1) PG8_BAR;
    }
    PG8_WAIT_V(0);
    PG8_BAR;
#undef PG8_SA
#undef PG8_SB
#undef PG8_STAGE
#undef PG8_LDA
#undef PG8_LDB
#undef PG8_MMA
#undef PG8_WAIT_V
#undef PG8_WAIT_L
#undef PG8_BAR
#undef PG8_SCHED
}
}

struct Args {
    const float* in[23];
    float* out; unsigned char* ws;
    int ph_lo, ph_hi;
};
struct Frame {
    LAS unsigned char* lds;
    int tid, lane, wave, G, bid;
};
#define F_in(k) (args.in[k])
#define F_x F_in(0)
#define F_w_in F_in(1)
#define F_kv_norm_g F_in(2)
#define F_w_uk F_in(3)
#define F_w_uv F_in(4)
#define F_m_conv_w F_in(5)
#define F_m_conv_b F_in(6)
#define F_w_mq F_in(7)
#define F_w_mk F_in(8)
#define F_b_i F_in(9)
#define F_b_f F_in(10)
#define F_m_norm_g F_in(11)
#define F_w_out F_in(12)
#define F_ln1_g F_in(13)
#define F_ln1_b F_in(14)
#define F_w_router F_in(15)
#define F_b_router F_in(16)
#define F_w_gu F_in(17)
#define F_b_gu F_in(18)
#define F_w_down F_in(19)
#define F_b_down F_in(20)
#define F_ln2_g F_in(21)
#define F_ln2_b F_in(22)
#define F_out (args.out)
#define F_ctl ((unsigned*)(args.ws + WS_CTL))
#define F_WinT ((bf16_t*)(args.ws + WS_WIN))
#define F_WoutT ((bf16_t*)(args.ws + WS_WOUT))
#define F_WguT ((bf16_t*)(args.ws + WS_WGU))
#define F_WdT ((bf16_t*)(args.ws + WS_WD))
#define F_xb ((bf16_t*)(args.ws + WS_XB))
#define F_h1b ((bf16_t*)(args.ws + WS_H1B))
#define F_projb ((bf16_t*)(args.ws + WS_PROJ))
#define F_cb ((bf16_t*)(args.ws + WS_CB))
#define F_mix ((bf16_t*)(args.ws + WS_MIX))
#define F_xg ((bf16_t*)(args.ws + WS_XG))
#define F_hb ((bf16_t*)(args.ws + WS_HB))
#define F_g32 ((float*)(args.ws + WS_G32))
#define F_pre1 ((float*)(args.ws + WS_PRE1))
#define F_gate ((float*)(args.ws + WS_GATE))
#define F_rgate ((float*)(args.ws + WS_RGATE))
#define F_mask ((unsigned*)(args.ws + WS_MASK))
#define F_tope ((int*)(args.ws + WS_TOPE))
#define F_rank ((int*)(args.ws + WS_RANK))
#define F_rtok ((int*)(args.ws + WS_RTOK))
#define F_wukb ((bf16_t*)(args.ws + WS_WUKB))
#define F_wuvf ((bf16_t*)(args.ws + WS_WUVF))

__device__ __forceinline__ int in_map(int n) {
    if (n < 1216) return n;
    if (n < 2752) return n + 8;
    if (n < 2760) return n - 2752 + 1216;
    if (n < 2768) return n;
    return -1;
}
template <int MODE>
__device__ __forceinline__ void transpose_item(const float* W, int K, int Norig, bf16_t* WT, LAS float* scr, int kb, int nb, int lane) {
    const int k0 = 64 * kb, n0 = 32 * nb;
    const int nn = n0 + (lane & 31);
    int oc;
    if (MODE == 0) oc = nn;
    else if (MODE == 1) oc = in_map(nn);
    else { const int pn = nn >> 8, half = (nn >> 7) & 1, i = nn & 127; oc = half * 1024 + pn * 128 + i; }
#pragma unroll 8
    for (int i = 0; i < 32; ++i) { const int kk = 2 * i + (lane >> 5); scr[kk * 33 + (lane & 31)] = (oc >= 0) ? W[(size_t)(k0 + kk) * Norig + oc] : 0.f; }
    asm volatile("s_waitcnt lgkmcnt(0)" ::: "memory");
    const int c = lane & 7;
#pragma unroll
    for (int j = 0; j < 4; ++j) { const int n = (lane >> 3) + 8 * j; const LAS float* s = scr + (8 * c) * 33 + n;
        u32x4 o; o.x = pk2(s[0 * 33], s[1 * 33]); o.y = pk2(s[2 * 33], s[3 * 33]); o.z = pk2(s[4 * 33], s[5 * 33]); o.w = pk2(s[6 * 33], s[7 * 33]);
        *(u32x4*)(WT + (size_t)(n0 + n) * K + k0 + 8 * c) = o; }
    asm volatile("s_waitcnt lgkmcnt(0)" ::: "memory");
}
__device__ __forceinline__ void p0_prologue(const Args& args, Frame& F) {
    LAS float* scr = (LAS float*)(F.lds + F.wave * 16384);
    const int gw = F.bid * NWAVES + F.wave, NGW = F.G * NWAVES;
    constexpr int I_IN = 16 * (NPROJ / 32), I_OUT = 16 * 32, I_GU = NEXP * 16 * 64, I_D = NEXP * 16 * 32;
    constexpr int NITEMS = I_IN + I_OUT + I_GU + I_D;
    for (int it = gw; it < NITEMS; it += NGW) {
        int r = it;
        if (r < I_IN) { const int nbk = NPROJ / 32; transpose_item<1>(F_w_in, DM, IN_W, F_WinT, scr, r / nbk, r % nbk, F.lane); continue; } r -= I_IN;
        if (r < I_OUT) { transpose_item<0>(F_w_out, DM, DM, F_WoutT, scr, r / 32, r % 32, F.lane); continue; } r -= I_OUT;
        if (r < I_GU) { const int e = r / (16 * 64), q = r % (16 * 64); transpose_item<2>(F_w_gu + (size_t)e * DM * 2048, DM, 2048, F_WguT + (size_t)e * 2048 * DM, scr, q / 64, q % 64, F.lane); continue; } r -= I_GU;
        { const int e = r / (16 * 32), q = r % (16 * 32); transpose_item<0>(F_w_down + (size_t)e * DM * DM, DM, DM, F_WdT + (size_t)e * DM * DM, scr, q / 32, q % 32, F.lane); }
    }
    { const int gtid = F.bid * NTHR + F.tid, NT_ = F.G * NTHR;
      for (int i = gtid; i < 8 * 128 * 64; i += NT_) F_wukb[i] = (bf16_t)f2bf(F_w_uk[i] * 0.125f);
      for (int i = gtid; i < 8 * 2 * 4 * 2 * 64 * 8; i += NT_) { const int j = i & 7, ln = (i >> 3) & 63, sx = (i >> 9) & 1, d0 = (i >> 10) & 3, dt = (i >> 12) & 1, h = i >> 13;
          const int hi = ln >> 5, r32 = ln & 31; const int lat = 32 * d0 + 16 * sx + 8 * (j >> 2) + 4 * hi + (j & 3), dd = 32 * dt + r32;
          F_wuvf[i] = (bf16_t)f2bf(F_w_uv[((size_t)h * 128 + lat) * 64 + dd]); } }
    for (int m = gw; m < T; m += NGW) {
        const f32x4* xr = (const f32x4*)(F_x + (size_t)m * DM) + F.lane;
        u32x2* o = (u32x2*)(F_xb + (size_t)m * DM) + F.lane;
#pragma unroll
        for (int j = 0; j < 4; ++j) { const f32x4 v = xr[64 * j]; u32x2 w; w.x = pk2(v.x, v.y); w.y = pk2(v.z, v.w); o[64 * j] = w; }
    }
}

struct EpiProj {
    static constexpr bool PERM = true;
    bf16_t* O; float* g32;
    __device__ __forceinline__ void operator()(const f32x4 (&acc)[2][2][4][2], const pg8::Unit& u, int wr, int wc, int fr, int fq) const {
        const int row0 = u.pm * 256 + wr * 64 + fr, col0 = u.po * 256 + wc * 32 + 8 * fq;
#pragma unroll
        for (int ai = 0; ai < 2; ++ai)
#pragma unroll
            for (int m = 0; m < 4; ++m) { const int row = row0 + ai * 128 + m * 16;
#pragma unroll
                for (int bj = 0; bj < 2; ++bj) { const f32x4 v0 = acc[ai][bj][m][0], v1 = acc[ai][bj][m][1]; const int col = col0 + bj * 128;
                    u32x4 w; w.x = pg8::cvt_pk_bf16(v0[0], v0[1]); w.y = pg8::cvt_pk_bf16(v0[2], v0[3]); w.z = pg8::cvt_pk_bf16(v1[0], v1[1]); w.w = pg8::cvt_pk_bf16(v1[2], v1[3]);
                    *(u32x4*)(O + (size_t)row * NPROJ + col) = w;
                    if (col >= C_WI && col < C_WI + 16) { float* gp = g32 + (size_t)row * 16 + (col - C_WI); *(f32x4*)gp = v0; *(f32x4*)(gp + 4) = v1; } } }
    }
};
struct EpiOut {
    static constexpr bool PERM = false;
    const float* x; float* pre;
    __device__ __forceinline__ void operator()(const f32x4 (&acc)[2][2][4][2], const pg8::Unit& u, int wr, int wc, int fr, int fq) const {
        const int row0 = u.pm * 256 + wr * 64 + fr, col0 = u.po * 256 + wc * 32 + 4 * fq;
#pragma unroll
        for (int ai = 0; ai < 2; ++ai)
#pragma unroll
            for (int m = 0; m < 4; ++m) { const size_t off = (size_t)(row0 + ai * 128 + m * 16) * DM + col0;
#pragma unroll
                for (int bj = 0; bj < 2; ++bj)
#pragma unroll
                    for (int n = 0; n < 2; ++n) { const f32x4 xv = *(const f32x4*)(x + off + bj * 128 + n * 16); *(f32x4*)(pre + off + bj * 128 + n * 16) = xv * DN_ALPHA + acc[ai][bj][m][n]; } }
    }
};
struct EpiGU {
    static constexpr bool PERM = true;
    bf16_t* H; const float* b_gu;
    __device__ __forceinline__ void operator()(const f32x4 (&acc)[2][2][4][2], const pg8::Unit& u, int wr, int wc, int fr, int fq) const {
        const int row0 = u.pm * 256 + wr * 64 + fr, hc = u.po * 128 + wc * 32 + 8 * fq;
        const float* bg = b_gu + (size_t)u.pe * 2048 + hc;
        f32x4 bgv[2], buv[2];
#pragma unroll
        for (int n = 0; n < 2; ++n) { bgv[n] = *(const f32x4*)(bg + 4 * n); buv[n] = *(const f32x4*)(bg + 1024 + 4 * n); }
#pragma unroll
        for (int ai = 0; ai < 2; ++ai)
#pragma unroll
            for (int m = 0; m < 4; ++m) { const int row = row0 + ai * 128 + m * 16; float hv[8];
#pragma unroll
                for (int n = 0; n < 2; ++n)
#pragma unroll
                    for (int i = 0; i < 4; ++i) { float gt = acc[ai][0][m][n][i] + bgv[n][i], up = acc[ai][1][m][n][i] + buv[n][i];
                        gt = fminf(gt, 7.0f); up = fminf(fmaxf(up, -7.0f), 7.0f);
                        hv[n * 4 + i] = (up + 1.0f) * gt * sigmoidf_(1.702f * gt); }
                u32x4 w; w.x = pg8::cvt_pk_bf16(hv[0], hv[1]); w.y = pg8::cvt_pk_bf16(hv[2], hv[3]); w.z = pg8::cvt_pk_bf16(hv[4], hv[5]); w.w = pg8::cvt_pk_bf16(hv[6], hv[7]);
                *(u32x4*)(H + (size_t)row * DM + hc) = w; }
    }
};
struct EpiDown {
    static constexpr bool PERM = false;
    float* Y; const float* b_down; const int* rtok; const float* rgate; int first;
    __device__ __forceinline__ void operator()(const f32x4 (&acc)[2][2][4][2], const pg8::Unit& u, int wr, int wc, int fr, int fq) const {
        const int row0 = u.pm * 256 + wr * 64 + fr, col0 = u.po * 256 + wc * 32 + 4 * fq;
        const float* bd = b_down + (size_t)u.pe * DM + col0;
#pragma unroll
        for (int ai = 0; ai < 2; ++ai)
#pragma unroll
            for (int m = 0; m < 4; ++m) { const int row = row0 + ai * 128 + m * 16; const int tok = rtok[row]; const float gt = rgate[row];
                if (tok >= 0) { float* yp = Y + (size_t)tok * DM + col0;
#pragma unroll
                    for (int bj = 0; bj < 2; ++bj)
#pragma unroll
                        for (int n = 0; n < 2; ++n) { const f32x4 bv = *(const f32x4*)(bd + bj * 128 + n * 16); f32x4 v = (acc[ai][bj][m][n] + bv) * gt;
                            if (!first) v += *(const f32x4*)(yp + bj * 128 + n * 16);
                            *(f32x4*)(yp + bj * 128 + n * 16) = v; } } }
    }
};
struct MoeOrder {
    const LAS int* offs; int npn, G, c, nunits;
    __device__ void init(const LAS int* offs_, int npn_, int G_, int c_) { offs = offs_; npn = npn_; G = G_; c = c_; nunits = (offs_[NEXP] >> 8) * npn_; }
    __device__ bool next(int i, pg8::Unit& u) const {
        const int L = i * G + c; if (L >= nunits) return false;
        const int pm = L / npn, pnl = L % npn; int e = 0;
        for (int k = 1; k < NEXP; ++k) e += (offs[k] <= pm * 256) ? 1 : 0;
        u.pm = pm; u.pn = e * npn + pnl; u.po = pnl; u.pe = e; return true;
    }
};

__device__ __forceinline__ void p2_cb(const Args& args, Frame& F) {
    const int gw = F.bid * NWAVES + F.wave, NGW = F.G * NWAVES;
    const float g0 = F_kv_norm_g[2 * F.lane], g1 = F_kv_norm_g[2 * F.lane + 1];
    for (int tok = gw; tok < T; tok += NGW) {
        const unsigned p = *(const unsigned*)(F_projb + (size_t)tok * NPROJ + C_CKV + 2 * F.lane);
        const float a = bflo(p), b = bfhi(p);
        const float ss = wave_sum(a * a + b * b);
        const float r = 1.0f / sqrtf(ss * (1.0f / 128.0f) + LN_EPS);
        *(unsigned*)(F_cb + (size_t)tok * 128 + 2 * F.lane) = pk2(a * r * g0, b * r * g1);
    }
}

__device__ __forceinline__ void p2_indexer(const Args& args, Frame& F) {
    const int lane = F.lane, wave = F.wave;
    {
        const int gw = F.bid * NWAVES + wave, NGW = F.G * NWAVES;
        for (int i = gw; i < NB * 256; i += NGW) { const int b = i >> 8, t = i & 255, ci = t >> 6; const int tok = b * SEQ + t;
            F_mask[(size_t)tok * 64 + lane] = (lane < 2 * (ci + 1)) ? 0xffffffffu : 0u; }
    }
    LAS float* qs = (LAS float*)(F.lds) + wave * 512;
    LAS float* sc = (LAS float*)(F.lds + 16384) + wave * 2048;
    for (int r = 0; r < 28; ++r) {
        const int ci = 31 - r, ntl = ci + 1;
        for (int sub = F.bid; sub < 256; sub += F.G) {
            const int b = sub >> 3, qg = sub & 7;
            const int t = ci * 64 + qg * 8 + wave; const int tok = b * SEQ + t;
            { const u32x4 p = *(const u32x4*)(F_projb + (size_t)tok * NPROJ + C_QI + 8 * lane);
              LAS float* q = qs + 8 * lane;
              q[0] = bflo(p.x); q[1] = bfhi(p.x); q[2] = bflo(p.y); q[3] = bfhi(p.y); q[4] = bflo(p.z); q[5] = bfhi(p.z); q[6] = bflo(p.w); q[7] = bfhi(p.w); }
            float wq[8];
#pragma unroll
            for (int h = 0; h < 8; ++h) wq[h] = F_g32[(size_t)tok * 16 + h];
            asm volatile("s_waitcnt lgkmcnt(0)" ::: "memory");
            for (int j = 0; j < ntl; ++j) {
                const int s = j * 64 + lane;
                const u32x4* kp = (const u32x4*)(F_projb + (size_t)(b * SEQ + s) * NPROJ + C_KI);
                float kf[64];
#pragma unroll
                for (int c = 0; c < 8; ++c) { const u32x4 p = kp[c]; kf[8 * c] = bflo(p.x); kf[8 * c + 1] = bfhi(p.x); kf[8 * c + 2] = bflo(p.y); kf[8 * c + 3] = bfhi(p.y);
                    kf[8 * c + 4] = bflo(p.z); kf[8 * c + 5] = bfhi(p.z); kf[8 * c + 6] = bflo(p.w); kf[8 * c + 7] = bfhi(p.w); }
                float score = 0.f;
#pragma unroll
                for (int h = 0; h < 8; ++h) { float d = 0.f;
#pragma unroll
                    for (int c = 0; c < 16; ++c) { const f32x4 qv = *(const LAS f32x4*)(qs + h * 64 + 4 * c); d += qv.x * kf[4 * c] + qv.y * kf[4 * c + 1] + qv.z * kf[4 * c + 2] + qv.w * kf[4 * c + 3]; }
                    score += wq[h] * fmaxf(d, 0.f); }
                sc[j * 64 + lane] = score + 0.0f;
            }
            asm volatile("s_waitcnt lgkmcnt(0)" ::: "memory");
            unsigned u[32];
#pragma unroll
            for (int j = 0; j < 32; ++j) { unsigned v = 0u; if (j < ntl) { const unsigned bts = __builtin_bit_cast(unsigned, sc[j * 64 + lane]); v = (bts & 0x80000000u) ? ~bts : (bts | 0x80000000u); } u[j] = v; }
            unsigned thr = 0u;
            for (int bit = 31; bit >= 0; --bit) {
                const unsigned cand = thr | (1u << bit); int cnt = 0;
#pragma unroll
                for (int j = 0; j < 32; ++j) cnt += __popcll(__ballot(u[j] >= cand));
                if (cnt >= KSEL) thr = cand;
            }
            int cgt = 0;
#pragma unroll
            for (int j = 0; j < 32; ++j) cgt += __popcll(__ballot(u[j] > thr));
            const int need = KSEL - cgt;
            int eqbase = 0;
            const unsigned long long ltmask = (1ull << lane) - 1ull;
#pragma unroll
            for (int j = 0; j < 32; ++j) {
                const unsigned long long eqm = __ballot(u[j] == thr);
                const int rk = eqbase + __popcll(eqm & ltmask);
                const bool sel = (u[j] > thr) || (u[j] == thr && rk < need);
                const unsigned long long sm = __ballot(sel);
                eqbase += __popcll(eqm);
                if (lane == 0) { F_mask[(size_t)tok * 64 + 2 * j] = (unsigned)sm; F_mask[(size_t)tok * 64 + 2 * j + 1] = (unsigned)(sm >> 32); }
            }
        }
    }
}

__device__ __forceinline__ void p2_mlstm(const Args& args, Frame& F) {
    const int tid = F.tid, lane = F.lane, wave = F.wave;
    LAS float* ucL = (LAS float*)(F.lds);
    LAS float* qL = (LAS float*)(F.lds + 32768);
    LAS float* kL = (LAS float*)(F.lds + 65536);
    LAS float* vL = (LAS float*)(F.lds + 98304);
    LAS float* gL = (LAS float*)(F.lds + LCTL_OFF + 4096);
    for (int item = F.bid; item < NB * 4; item += F.G) {
        const int b = item >> 2, h = item & 3;
        const int v = tid >> 2, kq = tid & 3;
        float C[32], nst[32];
#pragma unroll
        for (int j = 0; j < 32; ++j) { C[j] = 0.f; nst[j] = 0.f; }
        const float bi = F_b_i[h], bfv = F_b_f[h];
        for (int c = 0; c < NCH; ++c) {
            const int tok0 = b * SEQ + c * CHK;
            __syncthreads();
            for (int idx = tid; idx < 64 * 128; idx += NTHR) { const int t = idx >> 7, d = idx & 127; const int ch = h * 128 + d;
                float y = F_m_conv_b[ch];
#pragma unroll
                for (int j = 0; j < 4; ++j) { const int tt = c * CHK + t - 3 + j; if (tt >= 0) y += F_m_conv_w[j * 512 + ch] * bf2f(F_projb[(size_t)(b * SEQ + tt) * NPROJ + C_U + ch]); }
                ucL[idx] = y * sigmoidf_(y);
                vL[idx] = bf2f(F_projb[(size_t)(tok0 + t) * NPROJ + C_V + ch]); }
            if (tid < 64) { const float ip = F_g32[(size_t)(tok0 + tid) * 16 + 8 + h] + bi, fp = F_g32[(size_t)(tok0 + tid) * 16 + 12 + h] + bfv;
                gL[tid] = __expf(ip); gL[64 + tid] = sigmoidf_(fp); }
            __syncthreads();
            { const int e = tid & 127, tg = tid >> 7; float aq[16], ak[16];
#pragma unroll
              for (int i = 0; i < 16; ++i) { aq[i] = 0.f; ak[i] = 0.f; }
              const float* wq = F_w_mq + (size_t)h * 128 * 128 + e; const float* wk = F_w_mk + (size_t)h * 128 * 128 + e;
              for (int d = 0; d < 128; ++d) { const float a = wq[d * 128], bb = wk[d * 128];
#pragma unroll
                  for (int i = 0; i < 16; ++i) { const float uu = ucL[(tg * 16 + i) * 128 + d]; aq[i] += uu * a; ak[i] += uu * bb; } }
#pragma unroll
              for (int i = 0; i < 16; ++i) { qL[(tg * 16 + i) * 128 + e] = aq[i]; kL[(tg * 16 + i) * 128 + e] = ak[i] * 0.08838834764831845f; } }
            __syncthreads();
            for (int t = 0; t < 64; ++t) {
                const float f = gL[64 + t], ii = gL[t], vv = vL[t * 128 + v] * ii;
                float num = 0.f, den = 0.f;
#pragma unroll
                for (int j4 = 0; j4 < 8; ++j4) { const f32x4 kk = *(const LAS f32x4*)(kL + t * 128 + j4 * 16 + kq * 4); const f32x4 qq = *(const LAS f32x4*)(qL + t * 128 + j4 * 16 + kq * 4);
#pragma unroll
                    for (int i = 0; i < 4; ++i) { const int j = j4 * 4 + i; C[j] = f * C[j] + vv * kk[i]; nst[j] = f * nst[j] + ii * kk[i]; num += C[j] * qq[i]; den += nst[j] * qq[i]; } }
                num += __shfl_xor(num, 1); num += __shfl_xor(num, 2);
                den += __shfl_xor(den, 1); den += __shfl_xor(den, 2);
                if (kq == 0) ucL[t * 128 + v] = num / fmaxf(fabsf(den), 1.0f);
            }
            __syncthreads();
            for (int t = wave; t < 64; t += 8) { const float a0 = ucL[t * 128 + 2 * lane], a1 = ucL[t * 128 + 2 * lane + 1];
                const float mu = wave_sum(a0 + a1) * (1.0f / 128.0f); const float d0 = a0 - mu, d1 = a1 - mu;
                const float var = wave_sum(d0 * d0 + d1 * d1) * (1.0f / 128.0f); const float rs = 1.0f / sqrtf(var + LN_EPS);
                const int ch = h * 128 + 2 * lane; const unsigned zp = *(const unsigned*)(F_projb + (size_t)(tok0 + t) * NPROJ + C_Z + ch);
                const float o0 = sigmoidf_(bflo(zp)) * d0 * rs * F_m_norm_g[ch], o1 = sigmoidf_(bfhi(zp)) * d1 * rs * F_m_norm_g[ch + 1];
                *(unsigned*)(F_mix + (size_t)(tok0 + t) * DM + 512 + ch) = pk2(o0, o1); }
        }
        __syncthreads();
    }
}

__device__ __forceinline__ void p3_attn(const Args& args, Frame& F) {
    const int tid = F.tid, lane = F.lane, wave = F.wave;
    LAS int* selL = (LAS int*)(F.lds);
    LAS int* nselL = (LAS int*)(F.lds + 1024);
    LAS float* qlat = (LAS float*)(F.lds + 2048);
    LAS float* lg = (LAS float*)(F.lds + 8192);
    LAS float* olat = (LAS float*)(F.lds + 16384);
    LAS unsigned char* csel = F.lds + 32768;
    constexpr int CROW = 272;
    for (int tok = F.bid; tok < T; tok += F.G) {
        const int b = tok >> 11, t = tok & 2047, ci = t >> 6, ntl = ci + 1;
        __syncthreads();
#pragma unroll
        for (int oo = 0; oo < 2; ++oo) { const int o = tid * 2 + oo, h = o >> 7; const float* w = F_w_uk + (size_t)o * 64; const u32x4* qp = (const u32x4*)(F_projb + (size_t)tok * NPROJ + C_QA + h * 64);
            float a = 0.f;
#pragma unroll
            for (int c = 0; c < 8; ++c) { const u32x4 p = qp[c]; const f32x4 w0 = *(const f32x4*)(w + 8 * c), w1 = *(const f32x4*)(w + 8 * c + 4);
                a += bflo(p.x) * w0.x + bfhi(p.x) * w0.y + bflo(p.y) * w0.z + bfhi(p.y) * w0.w + bflo(p.z) * w1.x + bfhi(p.z) * w1.y + bflo(p.w) * w1.z + bfhi(p.w) * w1.w; }
            qlat[o] = a * 0.125f; }
        if (wave == 0) { int base = 0;
            for (int j = 0; j < ntl; ++j) { const unsigned long long m = (unsigned long long)F_mask[(size_t)tok * 64 + 2 * j] | ((unsigned long long)F_mask[(size_t)tok * 64 + 2 * j + 1] << 32);
                if ((m >> lane) & 1ull) { const int pos = base + __popcll(m & ((1ull << lane) - 1ull)); if (pos < 256) selL[pos] = j * 64 + lane; }
                base += __popcll(m); }
            if (lane == 0) nselL[0] = base < 256 ? base : 256; }
        __syncthreads();
        const int nsel = nselL[0];
        for (int idx = tid; idx < 256 * 16; idx += NTHR) { const int j = idx >> 4, c = idx & 15;
            if (j < nsel) { const u32x4 p = *(const u32x4*)(F_cb + (size_t)(b * SEQ + selL[j]) * 128 + 8 * c); *(LAS u32x4*)(csel + j * CROW + 16 * c) = p; } }
        __syncthreads();
        { const int j = tid & 255, hg = tid >> 8; float a[4] = {0.f, 0.f, 0.f, 0.f};
          if (j < nsel) {
#pragma unroll
              for (int c = 0; c < 16; ++c) { const u32x4 p = *(const LAS u32x4*)(csel + j * CROW + 16 * c);
                  const float cv[8] = {bflo(p.x), bfhi(p.x), bflo(p.y), bfhi(p.y), bflo(p.z), bfhi(p.z), bflo(p.w), bfhi(p.w)};
#pragma unroll
                  for (int hh = 0; hh < 4; ++hh) { const LAS float* q = qlat + (hg * 4 + hh) * 128 + 8 * c;
#pragma unroll
                      for (int i = 0; i < 8; ++i) a[hh] += q[i] * cv[i]; } }
              const float dist = fabsf((float)(t - selL[j]));
#pragma unroll
              for (int hh = 0; hh < 4; ++hh) { const int h = hg * 4 + hh; const float slope = exp2f(-(float)(h + 1)); lg[h * 256 + j] = a[hh] - slope * dist; }
          } else {
#pragma unroll
              for (int hh = 0; hh < 4; ++hh) lg[(hg * 4 + hh) * 256 + j] = -INFINITY;
          } }
        __syncthreads();
        { float v[4]; float mx = -INFINITY;
#pragma unroll
          for (int i = 0; i < 4; ++i) { v[i] = lg[wave * 256 + lane + 64 * i]; mx = fmaxf(mx, v[i]); }
          mx = wave_max(mx); float s = 0.f;
#pragma unroll
          for (int i = 0; i < 4; ++i) { v[i] = __expf(v[i] - mx); s += v[i]; }
          s = wave_sum(s); const float inv = 1.0f / s;
#pragma unroll
          for (int i = 0; i < 4; ++i) lg[wave * 256 + lane + 64 * i] = v[i] * inv; }
        __syncthreads();
        { const int r = tid & 127, hg = tid >> 7; float a0 = 0.f, a1 = 0.f;
          for (int j = 0; j < nsel; ++j) { const float cv = bf2f(*(const LAS bf16_t*)(csel + j * CROW + 2 * r)); a0 += lg[(hg * 2) * 256 + j] * cv; a1 += lg[(hg * 2 + 1) * 256 + j] * cv; }
          olat[(hg * 2) * 128 + r] = a0; olat[(hg * 2 + 1) * 128 + r] = a1; }
        __syncthreads();
        { const int h = tid >> 6, d = tid & 63; const float* w = F_w_uv + (size_t)h * 128 * 64 + d; float a = 0.f;
#pragma unroll 8
          for (int r = 0; r < 128; ++r) a += olat[h * 128 + r] * w[r * 64];
          F_mix[(size_t)tok * DM + tid] = (bf16_t)f2bf(a); }
    }
}


__device__ __forceinline__ void p2_indexer_mfma(const Args& args, Frame& F) {
    const int lane = F.lane, wave = F.wave, tid = F.tid;
    {
        const int gw = F.bid * NWAVES + wave, NGW = F.G * NWAVES;
        for (int i = gw; i < NB * 256; i += NGW) { const int b = i >> 8, t = i & 255, ci = t >> 6; const int tok = b * SEQ + t;
            F_mask[(size_t)tok * 64 + lane] = (lane < 2 * (ci + 1)) ? 0xffffffffu : 0u; }
    }
    constexpr int KROW = 144;
    LAS unsigned char* kbuf = F.lds;
    const int c16 = lane & 15, q4 = lane >> 4, half = lane >> 5;
    const int nitems = NB * 28 * 4;
    for (int item = F.bid; item < nitems; item += F.G) {
        const int r = item >> 7, q = item & 127; const int ci = 31 - r, b = q >> 2, g = q & 3; const int nch = ci + 1;
        const int tok0 = b * SEQ + ci * 64 + g * 16 + wave * 2;
        const bf16_t* kbase = F_projb + (size_t)(b * SEQ) * NPROJ + C_KI;
        const bf16_t* qp = F_projb + (size_t)(tok0 + (c16 >> 3)) * NPROJ + C_QI + (c16 & 7) * 64 + q4 * 8;
        const bf16x8 a0 = *(const bf16x8*)qp, a1 = *(const bf16x8*)(qp + 32);
        float wv[4];
#pragma unroll
        for (int i = 0; i < 4; ++i) wv[i] = F_g32[(size_t)(tok0 + (q4 >> 1)) * 16 + 4 * (q4 & 1) + i];
        __syncthreads();
        { const u32x4 k0 = *(const u32x4*)(kbase + (size_t)(tid >> 3) * NPROJ + (tid & 7) * 8); *(LAS u32x4*)(kbuf + (tid >> 3) * KROW + (tid & 7) * 16) = k0; }
        __syncthreads();
        unsigned u[64];
#pragma unroll
        for (int c = 0; c < 32; ++c) {
            u[2 * c] = 0u; u[2 * c + 1] = 0u;
            if (c < nch) {
                u32x4 kn;
                if (c + 1 < nch) kn = *(const u32x4*)(kbase + (size_t)((c + 1) * 64 + (tid >> 3)) * NPROJ + (tid & 7) * 8);
                const LAS unsigned char* kb = kbuf + (c & 1) * (64 * KROW);
#pragma unroll
                for (int pr = 0; pr < 2; ++pr) {
                    f32x4 acc0 = {0.f, 0.f, 0.f, 0.f}, acc1 = {0.f, 0.f, 0.f, 0.f};
                    const LAS unsigned char* k0p = kb + ((2 * pr) * 16 + c16) * KROW + q4 * 16;
                    const LAS unsigned char* k1p = kb + ((2 * pr + 1) * 16 + c16) * KROW + q4 * 16;
                    acc0 = __builtin_amdgcn_mfma_f32_16x16x32_bf16(a0, *(const LAS bf16x8*)k0p, acc0, 0, 0, 0);
                    acc0 = __builtin_amdgcn_mfma_f32_16x16x32_bf16(a1, *(const LAS bf16x8*)(k0p + 64), acc0, 0, 0, 0);
                    acc1 = __builtin_amdgcn_mfma_f32_16x16x32_bf16(a0, *(const LAS bf16x8*)k1p, acc1, 0, 0, 0);
                    acc1 = __builtin_amdgcn_mfma_f32_16x16x32_bf16(a1, *(const LAS bf16x8*)(k1p + 64), acc1, 0, 0, 0);
                    float p0 = 0.f, p1 = 0.f;
#pragma unroll
                    for (int i = 0; i < 4; ++i) { p0 += wv[i] * fmaxf(acc0[i], 0.f); p1 += wv[i] * fmaxf(acc1[i], 0.f); }
                    p0 += __shfl_xor(p0, 16); p1 += __shfl_xor(p1, 16);
                    const float sc = ((q4 & 1) ? p1 : p0) + 0.0f;
                    const unsigned bts = __builtin_bit_cast(unsigned, sc);
                    u[2 * c + pr] = (bts & 0x80000000u) ? ~bts : (bts | 0x80000000u);
                }
                if (c + 1 < nch) *(LAS u32x4*)(kbuf + ((c + 1) & 1) * (64 * KROW) + (tid >> 3) * KROW + (tid & 7) * 16) = kn;
                __syncthreads();
            }
        }
        unsigned thr = 0u;
        for (int bit = 31; bit >= 0; --bit) {
            const unsigned cand = thr | (1u << bit); int c0 = 0, c1 = 0;
#pragma unroll
            for (int j = 0; j < 64; ++j) { const unsigned long long m = __ballot(u[j] >= cand); c0 += __popc((unsigned)m); c1 += __popc((unsigned)(m >> 32)); }
            const int cm = half ? c1 : c0;
            if (cm >= KSEL) thr = cand;
            if (c0 == KSEL && c1 == KSEL) break;
        }
        int g0 = 0, g1 = 0;
#pragma unroll
        for (int j = 0; j < 64; ++j) { const unsigned long long m = __ballot(u[j] > thr); g0 += __popc((unsigned)m); g1 += __popc((unsigned)(m >> 32)); }
        const int need = KSEL - (half ? g1 : g0);
        int e0 = 0, e1 = 0;
        const unsigned lt32 = (1u << (lane & 31)) - 1u;
#pragma unroll
        for (int j = 0; j < 64; ++j) {
            const unsigned long long eqm = __ballot(u[j] == thr);
            const unsigned myeq = half ? (unsigned)(eqm >> 32) : (unsigned)eqm;
            const int rk = (half ? e1 : e0) + __popc(myeq & lt32);
            const bool sel = (u[j] > thr) || (u[j] == thr && rk < need);
            const unsigned long long sm = __ballot(sel);
            e0 += __popc((unsigned)eqm); e1 += __popc((unsigned)(eqm >> 32));
            if ((lane & 31) == 0) F_mask[(size_t)(tok0 + half) * 64 + j] = half ? (unsigned)(sm >> 32) : (unsigned)sm;
        }
    }
}

namespace at {
typedef short s16x4 __attribute__((ext_vector_type(4)));
typedef float f32x16 __attribute__((ext_vector_type(16)));
constexpr int SHM_V = 64 * 128 * 2, SHM_K = SHM_V;
constexpr float THRN = 8.0f;
#define AT_KSWZ(row, colB) ((row) * 256 + ((colB) ^ (((row) & 7) << 4)))
#define AT_SBAR() __builtin_amdgcn_sched_barrier(0)
__device__ __forceinline__ unsigned cvtpk(float lo, float hi) { return cvtpk_c(lo, hi); }
#define AT_PK4(P, BASE, OUT) do { unsigned a0_ = cvtpk(P[BASE + 0], P[BASE + 1]), a1_ = cvtpk(P[BASE + 2], P[BASE + 3]);   \
    unsigned b0_ = cvtpk(P[BASE + 4], P[BASE + 5]), b1_ = cvtpk(P[BASE + 6], P[BASE + 7]);                              \
    auto r0_ = __builtin_amdgcn_permlane32_swap(a0_, b0_, false, false); auto r1_ = __builtin_amdgcn_permlane32_swap(a1_, b1_, false, false); \
    u32x4 w_ = {r0_[0], r1_[0], r0_[1], r1_[1]}; OUT = *reinterpret_cast<bf16x8*>(&w_); } while (0)
__device__ __forceinline__ void mask_bias(f32x16& p0, f32x16& p1, unsigned w0, unsigned w1, float dq, float nslope, int hi) {
    const unsigned w0s = w0 >> (4 * hi), w1s = w1 >> (4 * hi);
#pragma unroll
    for (int r = 0; r < 16; ++r) { const int kb = (r & 3) + 8 * (r >> 2);
        const float v0 = fmaf(nslope, fabsf(dq - (float)kb), p0[r]), v1 = fmaf(nslope, fabsf(dq - (float)(32 + kb)), p1[r]);
        p0[r] = ((w0s >> kb) & 1u) ? v0 : -INFINITY; p1[r] = ((w1s >> kb) & 1u) ? v1 : -INFINITY; }
}
__device__ __forceinline__ void partialSM(f32x16& p0, f32x16& p1, float& m_reg, float& mn, float& alpha) {
    constexpr float C = 1.4426950408889634f;
    float pmax = p0[0];
#pragma unroll
    for (int r = 1; r < 16; ++r) pmax = fmaxf(pmax, p0[r]);
#pragma unroll
    for (int r = 0; r < 16; ++r) pmax = fmaxf(pmax, p1[r]);
    { auto rr = __builtin_amdgcn_permlane32_swap(__float_as_uint(pmax), __float_as_uint(pmax), false, false); pmax = fmaxf(__uint_as_float(rr[0]), __uint_as_float(rr[1])); }
    if (__builtin_expect(__all(pmax - m_reg <= THRN), 1)) { mn = m_reg; alpha = 1.f; }
    else { mn = fmaxf(m_reg, pmax); alpha = __builtin_amdgcn_exp2f((m_reg - mn) * C); m_reg = mn; }
    const float mnC = -mn * C;
#pragma unroll
    for (int r = 0; r < 16; ++r) p0[r] = fmaf(p0[r], C, mnC);
#pragma unroll
    for (int r = 0; r < 16; ++r) p1[r] = fmaf(p1[r], C, mnC);
#pragma unroll
    for (int r = 0; r < 16; ++r) p0[r] = __builtin_amdgcn_exp2f(p0[r]);
}
__device__ __forceinline__ void finishSM(f32x16& p0, f32x16& p1, float alpha, float& l_reg, bf16x8& pa0, bf16x8& pa1, bf16x8& pa2, bf16x8& pa3) {
#pragma unroll
    for (int r = 0; r < 16; ++r) p1[r] = __builtin_amdgcn_exp2f(p1[r]);
    float ps = 0;
#pragma unroll
    for (int r = 0; r < 16; ++r) ps += p0[r];
#pragma unroll
    for (int r = 0; r < 16; ++r) ps += p1[r];
    { auto rr = __builtin_amdgcn_permlane32_swap(__float_as_uint(ps), __float_as_uint(ps), false, false); ps = __uint_as_float(rr[0]) + __uint_as_float(rr[1]); }
    l_reg = l_reg * alpha + ps;
    AT_PK4(p0, 0, pa0); AT_PK4(p0, 8, pa1); AT_PK4(p1, 0, pa2); AT_PK4(p1, 8, pa3);
}
__device__ __forceinline__ void qkt(f32x16& p0, f32x16& p1, const LAS unsigned char* Ks, const bf16x8* qr, int r32, int hi) {
    p0 = f32x16{}; p1 = f32x16{};
#pragma unroll
    for (int d0 = 0; d0 < 8; ++d0) { const int cb = (d0 * 16 + hi * 8) * 2;
        const bf16x8 b0 = *(const LAS bf16x8*)(Ks + AT_KSWZ(r32, cb));
        const bf16x8 b1 = *(const LAS bf16x8*)(Ks + AT_KSWZ(32 + r32, cb));
        p0 = __builtin_amdgcn_mfma_f32_32x32x16_bf16(b0, qr[d0], p0, 0, 0, 0);
        p1 = __builtin_amdgcn_mfma_f32_32x32x16_bf16(b1, qr[d0], p1, 0, 0, 0); }
}
__device__ __forceinline__ int v_st(int k, int c) { const int kk = (k & ~0xC) | ((k & 4) << 1) | ((k & 8) >> 1); return ((kk >> 3) * 4 + (c >> 5)) * 512 + ((kk & 7) * 32 + (c & 31)) * 2; }
__device__ __forceinline__ int v_rd_base(int lane) { return ((lane & 3) << 3) | (((lane >> 2) & 3) << 6) | (((lane >> 4) & 1) << 5) | (((lane >> 5) & 1) << 8); }
constexpr int v_rd_off(int d0, int ks, int half) { return d0 * 512 + ks * 4096 + half * 2048; }
template <int OFF> __device__ __forceinline__ s16x4 tr_read(int vb) { s16x4 r; asm volatile("ds_read_b64_tr_b16 %0, %1 offset:%2" : "=&v"(r) : "v"(vb), "i"(OFF) : "memory"); return r; }
template <int D0> __device__ __forceinline__ void pv_one(f32x16& od, int vb, bf16x8 pa0, bf16x8 pa1, bf16x8 pa2, bf16x8 pa3) {
    const s16x4 l0 = tr_read<v_rd_off(D0, 0, 0)>(vb), h0 = tr_read<v_rd_off(D0, 0, 1)>(vb), l1 = tr_read<v_rd_off(D0, 1, 0)>(vb), h1 = tr_read<v_rd_off(D0, 1, 1)>(vb);
    const s16x4 l2 = tr_read<v_rd_off(D0, 2, 0)>(vb), h2 = tr_read<v_rd_off(D0, 2, 1)>(vb), l3 = tr_read<v_rd_off(D0, 3, 0)>(vb), h3 = tr_read<v_rd_off(D0, 3, 1)>(vb);
    asm volatile("s_waitcnt lgkmcnt(0)" ::: "memory"); AT_SBAR();
#define AT_PK(L, H) (bf16x8){L[0], L[1], L[2], L[3], H[0], H[1], H[2], H[3]}
    od = __builtin_amdgcn_mfma_f32_32x32x16_bf16(AT_PK(l0, h0), pa0, od, 0, 0, 0);
    od = __builtin_amdgcn_mfma_f32_32x32x16_bf16(AT_PK(l1, h1), pa1, od, 0, 0, 0);
    od = __builtin_amdgcn_mfma_f32_32x32x16_bf16(AT_PK(l2, h2), pa2, od, 0, 0, 0);
    od = __builtin_amdgcn_mfma_f32_32x32x16_bf16(AT_PK(l3, h3), pa3, od, 0, 0, 0);
#undef AT_PK
}
__device__ __forceinline__ void pv_d0(f32x16* o, int vb, bf16x8 pa0, bf16x8 pa1, bf16x8 pa2, bf16x8 pa3) {
    pv_one<0>(o[0], vb, pa0, pa1, pa2, pa3); pv_one<1>(o[1], vb, pa0, pa1, pa2, pa3); pv_one<2>(o[2], vb, pa0, pa1, pa2, pa3); pv_one<3>(o[3], vb, pa0, pa1, pa2, pa3);
}

__device__ __forceinline__ void unit(const bf16_t* __restrict__ projb, const bf16_t* __restrict__ cbp, const unsigned* __restrict__ maskp, const bf16_t* __restrict__ wukb,
                                     const bf16_t* __restrict__ wuvf, bf16_t* __restrict__ mix, int b, int ci, int hf, LAS unsigned char* lds) {
    int tid = threadIdx.x; asm volatile("" : "+v"(tid));
    const int wid = __builtin_amdgcn_readfirstlane(tid >> 6), lane = tid & 63, r32 = lane & 31, hi = lane >> 5;
    LAS unsigned char* V_lds = lds; LAS unsigned char* K_lds = lds + 2 * SHM_V;
    const int NT = ci + 1, NTp = (NT + 1) & ~1;
    const int tq = ci * 64 + hf * 32 + r32;
    const int tokq = b * SEQ + tq;
    const bf16_t* Kg = cbp + (size_t)b * SEQ * 128;
    const unsigned* mrow = maskp + (size_t)tokq * 64;
    const float nslope = -__builtin_amdgcn_exp2f(-(float)(wid + 1));
    bf16x8 qr[8];
    { bf16x8 qa[4];
      const bf16_t* qap = projb + (size_t)tokq * NPROJ + C_QA + wid * 64 + hi * 8;
#pragma unroll
      for (int ks = 0; ks < 4; ++ks) qa[ks] = *(const bf16x8*)(qap + 16 * ks);
      const bf16_t* wp = wukb + (size_t)wid * 128 * 64 + (size_t)r32 * 64 + hi * 8;
#pragma unroll
      for (int rt = 0; rt < 4; ++rt) { f32x16 x = f32x16{};
#pragma unroll
          for (int ks = 0; ks < 4; ++ks) { const bf16x8 wf = *(const bf16x8*)(wp + (size_t)rt * 32 * 64 + 16 * ks); x = __builtin_amdgcn_mfma_f32_32x32x16_bf16(wf, qa[ks], x, 0, 0, 0); }
          AT_PK4(x, 0, qr[2 * rt]); AT_PK4(x, 8, qr[2 * rt + 1]); } }
    float m_reg = -1e30f, l_reg = 0.f; f32x16 o[4] = {};
    const int sr = tid >> 4, sc = (tid & 15) * 8, vst0 = v_st(sr, sc), vst1 = v_st(32 + sr, sc);
    const int vb0 = (int)(uintptr_t)V_lds + v_rd_base(lane);
    struct { bf16x8 ks0, ks1; u32x2 mw; } sr_[2];
#define AT_TILE(t) ((t) < NT ? (t) : NT - 1)
#define AT_SLOAD(i, t) do { const int k0_ = AT_TILE(t) * 64; sr_[i].ks0 = *(const bf16x8*)(Kg + (size_t)(k0_ + sr) * 128 + sc); sr_[i].ks1 = *(const bf16x8*)(Kg + (size_t)(k0_ + 32 + sr) * 128 + sc); \
    sr_[i].mw = ((t) < NT) ? *(const u32x2*)(mrow + 2 * (t)) : (u32x2){0u, 0u}; } while (0)
#define AT_SWRITE(bb, i) do { *(LAS bf16x8*)(V_lds + (bb) * SHM_V + vst0) = sr_[i].ks0; *(LAS bf16x8*)(V_lds + (bb) * SHM_V + vst1) = sr_[i].ks1; const int kc_ = sc * 2; \
    *(LAS bf16x8*)(K_lds + (bb) * SHM_K + AT_KSWZ(sr, kc_)) = sr_[i].ks0; *(LAS bf16x8*)(K_lds + (bb) * SHM_K + AT_KSWZ(32 + sr, kc_)) = sr_[i].ks1; } while (0)
#define AT_SWAIT() asm volatile("s_waitcnt vmcnt(3)" ::: "memory")
#define AT_RESC(a) do { if (__any((a) < 1.f)) { _Pragma("unroll") for (int d = 0; d < 4; ++d) _Pragma("unroll") for (int r = 0; r < 16; ++r) o[d][r] *= (a); } } while (0)
#define AT_DQ(t) ((float)(tq - 64 * (t) - 4 * hi))
    f32x16 pA0, pA1, pB0, pB1; float mnA, mnB, alA, alB; bf16x8 pa0, pa1, pa2, pa3;
    u32x2 mwc;
    constexpr int SE = 0, SO = 1;
    __syncthreads();
    AT_SLOAD(SE, 0); asm volatile("s_waitcnt vmcnt(0)" ::: "memory"); AT_SWRITE(0, SE); mwc = sr_[SE].mw; __syncthreads();
    qkt(pA0, pA1, K_lds, qr, r32, hi); mask_bias(pA0, pA1, mwc.x, mwc.y, AT_DQ(0), nslope, hi); partialSM(pA0, pA1, m_reg, mnA, alA);
    AT_SLOAD(SO, 1); if (2 < NTp) AT_SLOAD(SE, 2);
    if (2 < NTp) AT_SWAIT(); else asm volatile("s_waitcnt vmcnt(0)" ::: "memory");
    AT_SWRITE(1, SO); __syncthreads();
    for (int j = 1; j + 1 < NTp; j += 2) {
        AT_SBAR(); qkt(pB0, pB1, K_lds + SHM_K, qr, r32, hi); mwc = sr_[SO].mw; mask_bias(pB0, pB1, mwc.x, mwc.y, AT_DQ(j), nslope, hi);
        finishSM(pA0, pA1, alA, l_reg, pa0, pa1, pa2, pa3); AT_SBAR();
        AT_SLOAD(SO, j + 2); AT_SBAR();
        pv_d0(o, vb0, pa0, pa1, pa2, pa3); partialSM(pB0, pB1, m_reg, mnB, alB);
        __syncthreads(); AT_SWAIT(); AT_SWRITE(0, SE);
        AT_RESC(alB); __syncthreads();
        AT_SBAR(); qkt(pA0, pA1, K_lds, qr, r32, hi); mwc = sr_[SE].mw; mask_bias(pA0, pA1, mwc.x, mwc.y, AT_DQ(j + 1), nslope, hi);
        finishSM(pB0, pB1, alB, l_reg, pa0, pa1, pa2, pa3); AT_SBAR();
        if (j + 3 < NTp) AT_SLOAD(SE, j + 3); AT_SBAR();
        pv_d0(o, vb0 + SHM_V, pa0, pa1, pa2, pa3); partialSM(pA0, pA1, m_reg, mnA, alA);
        __syncthreads(); if (j + 3 < NTp) AT_SWAIT(); else asm volatile("s_waitcnt vmcnt(0)" ::: "memory");
        AT_SWRITE(1, SO);
        AT_RESC(alA); __syncthreads();
    }
    AT_SBAR(); qkt(pB0, pB1, K_lds + SHM_K, qr, r32, hi); mwc = sr_[SO].mw; mask_bias(pB0, pB1, mwc.x, mwc.y, AT_DQ(NTp - 1), nslope, hi);
    finishSM(pA0, pA1, alA, l_reg, pa0, pa1, pa2, pa3); AT_SBAR();
    pv_d0(o, vb0, pa0, pa1, pa2, pa3); partialSM(pB0, pB1, m_reg, mnB, alB);
    AT_RESC(alB);
    finishSM(pB0, pB1, alB, l_reg, pa0, pa1, pa2, pa3); AT_SBAR();
    pv_d0(o, vb0 + SHM_V, pa0, pa1, pa2, pa3);
    const float inv = 1.0f / l_reg;
    f32x16 oa[2] = {f32x16{}, f32x16{}};
    const bf16_t* wf = wuvf + (size_t)wid * 8192 + (size_t)lane * 8;
#pragma unroll
    for (int d0 = 0; d0 < 4; ++d0)
#pragma unroll
        for (int sx = 0; sx < 2; ++sx) { u32x4 w; w.x = cvtpk(o[d0][8 * sx + 0] * inv, o[d0][8 * sx + 1] * inv); w.y = cvtpk(o[d0][8 * sx + 2] * inv, o[d0][8 * sx + 3] * inv);
            w.z = cvtpk(o[d0][8 * sx + 4] * inv, o[d0][8 * sx + 5] * inv); w.w = cvtpk(o[d0][8 * sx + 6] * inv, o[d0][8 * sx + 7] * inv);
            const bf16x8 bfrag = *reinterpret_cast<bf16x8*>(&w);
#pragma unroll
            for (int dt = 0; dt < 2; ++dt) { const bf16x8 af = *(const bf16x8*)(wf + (size_t)((dt * 4 + d0) * 2 + sx) * 512); oa[dt] = __builtin_amdgcn_mfma_f32_32x32x16_bf16(af, bfrag, oa[dt], 0, 0, 0); } }
    bf16_t* op = mix + (size_t)tokq * DM + wid * 64 + 4 * hi;
#pragma unroll
    for (int dt = 0; dt < 2; ++dt)
#pragma unroll
        for (int g = 0; g < 4; ++g) { u32x2 w; w.x = cvtpk(oa[dt][4 * g], oa[dt][4 * g + 1]); w.y = cvtpk(oa[dt][4 * g + 2], oa[dt][4 * g + 3]); *(u32x2*)(op + 32 * dt + 8 * g) = w; }
#undef AT_TILE
#undef AT_SLOAD
#undef AT_SWRITE
#undef AT_SWAIT
#undef AT_RESC
#undef AT_DQ
}
}
__device__ __forceinline__ void p3_attn_mfma(const Args& args, Frame& F) {
    for (int u = F.bid; u < 2048; u += F.G) {
        const int k = u >> 8, q = u & 255; const int b = q >> 3, hf = (q >> 2) & 1, g = q & 3; const int p = 4 * (k >> 1) + g; const int ci = (k & 1) ? p : 31 - p;
        at::unit(F_projb, F_cb, F_mask, F_wukb, F_wuvf, F_mix, b, ci, hf, F.lds);
    }
    __syncthreads();
}

__device__ __forceinline__ void p5_ln1_router(const Args& args, Frame& F) {
    const int lane = F.lane;
    const int gtid = F.bid * NTHR + F.tid, NT = F.G * NTHR;
    for (int i = gtid; i < NROUND * RCAP; i += NT) F_rtok[i] = -1;
    const int gw = F.bid * NWAVES + F.wave, NGW = F.G * NWAVES;
    f32x4 gv[4], bv[4];
#pragma unroll
    for (int j = 0; j < 4; ++j) { gv[j] = *((const f32x4*)F_ln1_g + lane + 64 * j); bv[j] = *((const f32x4*)F_ln1_b + lane + 64 * j); }
    for (int tok = gw; tok < T; tok += NGW) {
        const f32x4* pr = (const f32x4*)(F_pre1 + (size_t)tok * DM) + lane;
        f32x4 v[4]; float s = 0.f;
#pragma unroll
        for (int j = 0; j < 4; ++j) { v[j] = pr[64 * j]; s += (v[j].x + v[j].y) + (v[j].z + v[j].w); }
        const float mean = wave_sum(s) * (1.0f / DM); float s2 = 0.f;
#pragma unroll
        for (int j = 0; j < 4; ++j) { v[j] = v[j] - mean; s2 += (v[j].x * v[j].x + v[j].y * v[j].y) + (v[j].z * v[j].z + v[j].w * v[j].w); }
        const float rstd = 1.0f / sqrtf(wave_sum(s2) * (1.0f / DM) + LN_EPS);
        u32x2* o = (u32x2*)(F_h1b + (size_t)tok * DM) + lane;
#pragma unroll
        for (int j = 0; j < 4; ++j) { v[j] = v[j] * rstd * gv[j] + bv[j]; u32x2 w; w.x = pk2(v[j].x, v[j].y); w.y = pk2(v[j].z, v[j].w); o[64 * j] = w; }
        float lgt[32];
#pragma unroll
        for (int e = 0; e < 32; ++e) lgt[e] = 0.f;
#pragma unroll
        for (int j = 0; j < 4; ++j)
#pragma unroll
            for (int i = 0; i < 4; ++i) { const int d = 256 * j + 4 * lane + i; const f32x4* wr = (const f32x4*)(F_w_router + (size_t)d * 32); const float hv = v[j][i];
#pragma unroll
                for (int q = 0; q < 8; ++q) { const f32x4 w = wr[q]; lgt[4 * q] += hv * w.x; lgt[4 * q + 1] += hv * w.y; lgt[4 * q + 2] += hv * w.z; lgt[4 * q + 3] += hv * w.w; } }
#pragma unroll
        for (int e = 0; e < 32; ++e) lgt[e] = wave_sum(lgt[e]) + F_b_router[e];
        int te[4]; float tv[4];
#pragma unroll
        for (int k = 0; k < 4; ++k) { float best = -INFINITY; int bi = 0;
#pragma unroll
            for (int e = 0; e < 32; ++e) { const bool taken = (k > 0 && te[0] == e) || (k > 1 && te[1] == e) || (k > 2 && te[2] == e); if (!taken && lgt[e] > best) { best = lgt[e]; bi = e; } }
            te[k] = bi; tv[k] = best; }
        float es[4], sum = 0.f;
#pragma unroll
        for (int k = 0; k < 4; ++k) { es[k] = __expf(tv[k] - tv[0]); sum += es[k]; }
        if (lane < 4) { int e = te[0]; float gt = es[0]; if (lane == 1) { e = te[1]; gt = es[1]; } if (lane == 2) { e = te[2]; gt = es[2]; } if (lane == 3) { e = te[3]; gt = es[3]; }
            const int rk = (int)atomicAdd(F_ctl + CW_CNT + lane * NEXP + e, 1u);
            F_tope[tok * 4 + lane] = e; F_gate[tok * 4 + lane] = gt / sum; F_rank[tok * 4 + lane] = rk; }
    }
}
__device__ __forceinline__ void moe_offsets(const Args& args, Frame& F, LAS int* offs) {
    __syncthreads();
    if (F.tid < NROUND) { int acc = 0; for (int e = 0; e < NEXP; ++e) { offs[F.tid * 33 + e] = acc; const int c = (int)__hip_atomic_load(F_ctl + CW_CNT + F.tid * NEXP + e, __ATOMIC_RELAXED, __HIP_MEMORY_SCOPE_AGENT); acc += (c + 255) & ~255; } offs[F.tid * 33 + NEXP] = acc; }
    __syncthreads();
}
__device__ __forceinline__ void p6_fill(const Args& args, Frame& F, LAS int* offs) {
    const int gtid = F.bid * NTHR + F.tid, NT = F.G * NTHR;
    for (int i = gtid; i < T * 4; i += NT) { const int j = i & 3, tok = i >> 2; const int e = F_tope[i]; const int row = offs[j * 33 + e] + F_rank[i];
        F_rtok[j * RCAP + row] = tok; F_rgate[j * RCAP + row] = F_gate[i]; }
}
__device__ __forceinline__ void p7_gather(const Args& args, Frame& F, LAS int* offs, int rnd) {
    const int gw = F.bid * NWAVES + F.wave, NGW = F.G * NWAVES; const int nrows = offs[rnd * 33 + NEXP];
    for (int r = gw; r < nrows; r += NGW) { int tok = F_rtok[rnd * RCAP + r]; if (tok < 0) tok = 0;
        const u32x4* s = (const u32x4*)(F_h1b + (size_t)tok * DM) + F.lane; u32x4* d = (u32x4*)(F_xg + (size_t)r * DM) + F.lane;
        d[0] = s[0]; d[64] = s[64]; }
}
__device__ __forceinline__ void p9_final(const Args& args, Frame& F) {
    const int lane = F.lane; const int gw = F.bid * NWAVES + F.wave, NGW = F.G * NWAVES;
    f32x4 gv[4], bv[4];
#pragma unroll
    for (int j = 0; j < 4; ++j) { gv[j] = *((const f32x4*)F_ln2_g + lane + 64 * j); bv[j] = *((const f32x4*)F_ln2_b + lane + 64 * j); }
    for (int tok = gw; tok < T; tok += NGW) {
        f32x4* yr = (f32x4*)(F_out + (size_t)tok * DM) + lane; const u32x2* hr = (const u32x2*)(F_h1b + (size_t)tok * DM) + lane;
        f32x4 v[4]; float s = 0.f;
#pragma unroll
        for (int j = 0; j < 4; ++j) { const f32x4 y = yr[64 * j]; const u32x2 hp = hr[64 * j]; v[j].x = DN_ALPHA * bflo(hp.x) + y.x; v[j].y = DN_ALPHA * bfhi(hp.x) + y.y; v[j].z = DN_ALPHA * bflo(hp.y) + y.z; v[j].w = DN_ALPHA * bfhi(hp.y) + y.w;
            s += (v[j].x + v[j].y) + (v[j].z + v[j].w); }
        const float mean = wave_sum(s) * (1.0f / DM); float s2 = 0.f;
#pragma unroll
        for (int j = 0; j < 4; ++j) { v[j] = v[j] - mean; s2 += (v[j].x * v[j].x + v[j].y * v[j].y) + (v[j].z * v[j].z + v[j].w * v[j].w); }
        const float rstd = 1.0f / sqrtf(wave_sum(s2) * (1.0f / DM) + LN_EPS);
#pragma unroll
        for (int j = 0; j < 4; ++j) yr[64 * j] = v[j] * rstd * gv[j] + bv[j];
    }
}

constexpr int PH_P0 = 0, PH_P1 = 1, PH_P2 = 2, PH_P3 = 3, PH_P4 = 4, PH_P5 = 5, PH_P6 = 6, PH_MOE = 7, PH_FINAL = PH_MOE + 3 * NROUND, N_PHASES = PH_FINAL + 1;

template <unsigned MASK>
__global__ void __launch_bounds__(NTHR, 2) mk_fwd(Args args) {
    extern __shared__ __attribute__((aligned(16))) unsigned char lds_raw[];
    cg::grid_group grid = cg::this_grid();
    Frame F;
    F.lds = (LAS unsigned char*)lds_raw;
    F.tid = threadIdx.x; F.lane = F.tid & 63; F.wave = __builtin_amdgcn_readfirstlane(F.tid >> 6); F.G = gridDim.x; F.bid = blockIdx.x;
    LAS int* offs = (LAS int*)(F.lds + LCTL_OFF);
    const int lo = args.ph_lo, hi = args.ph_hi;
#define PH_BIT(k) ((k) < PH_MOE ? (k) : ((k) == PH_FINAL ? 10 : 7 + (((k) - PH_MOE) % 3)))
#define IN(k) (((MASK >> PH_BIT(k)) & 1u) && lo <= (k) && (k) < hi)
#define SEAM(k) do { if (IN(k) && IN((k) + 1)) grid.sync(); F.tid = launder(threadIdx.x); F.lane = F.tid & 63; F.wave = __builtin_amdgcn_readfirstlane(F.tid >> 6); } while (0)

    if (IN(PH_P0)) { p0_prologue(args, F); } SEAM(PH_P0);
    if (IN(PH_P1)) { pg8::Gemm g{F_xb, F_WinT, DM, DM, DM}; pg8::StaticOrder S; S.init(T, NPROJ, F.G, F.bid); EpiProj E{F_projb, F_g32};
        pg8::gemm_phase<EpiProj, pg8::StaticOrder>(F.lds, g, S, E); } SEAM(PH_P1);
    if (IN(PH_P2)) { p2_cb(args, F); p2_indexer_mfma(args, F); __syncthreads(); p2_mlstm(args, F); } SEAM(PH_P2);
    if (IN(PH_P3)) { p3_attn_mfma(args, F); } SEAM(PH_P3);
    if (IN(PH_P4)) { pg8::Gemm g{F_mix, F_WoutT, DM, DM, DM}; pg8::StaticOrder S; S.init(T, DM, F.G, F.bid); EpiOut E{F_x, F_pre1};
        pg8::gemm_phase<EpiOut, pg8::StaticOrder>(F.lds, g, S, E); } SEAM(PH_P4);
    if (IN(PH_P5)) { p5_ln1_router(args, F); } SEAM(PH_P5);
    if (IN(PH_P6)) { moe_offsets(args, F, offs); p6_fill(args, F, offs); } SEAM(PH_P6);
#define INM(j) (((MASK >> (7 + (j))) & 1u) && lo <= pa + (j) && pa + (j) < hi)
#define SEAMM(j) do { if (lo <= pa + (j) && pa + (j) + 1 < hi) grid.sync(); F.tid = launder(threadIdx.x); F.lane = F.tid & 63; F.wave = __builtin_amdgcn_readfirstlane(F.tid >> 6); } while (0)
#pragma unroll 1
    for (int rnd = 0; rnd < NROUND; ++rnd) {
        const int pa = PH_MOE + 3 * rnd;
        if (INM(0)) { moe_offsets(args, F, offs); p7_gather(args, F, offs, rnd); } SEAMM(0);
        if (INM(1)) { moe_offsets(args, F, offs); pg8::Gemm g{F_xg, F_WguT, DM, DM, DM}; MoeOrder S; S.init(offs + rnd * 33, 8, F.G, F.bid); EpiGU E{F_hb, F_b_gu};
            pg8::gemm_phase<EpiGU, MoeOrder>(F.lds, g, S, E); } SEAMM(1);
        if (INM(2)) { moe_offsets(args, F, offs); pg8::Gemm g{F_hb, F_WdT, DM, DM, DM}; MoeOrder S; S.init(offs + rnd * 33, 4, F.G, F.bid);
            EpiDown E{F_out, F_b_down, F_rtok + rnd * RCAP, F_rgate + rnd * RCAP, rnd == 0 ? 1 : 0};
            pg8::gemm_phase<EpiDown, MoeOrder>(F.lds, g, S, E); } SEAMM(2);
    }
    if (IN(PH_FINAL)) { p9_final(args, F); }
#undef IN
#undef SEAM
}

extern "C" void kernel_launch(void* const* d_in, const int* in_sizes, int n_in, void* d_out, int out_size, void* d_ws, size_t ws_size, hipStream_t stream) {
    static int grid = 0;
#if MK_ONE_LAUNCH
    void* kfn[1] = {(void*)mk_fwd<0x7ffu>};
    constexpr int NKFN = 1;
#else
    void* kfn[11] = {(void*)mk_fwd<1u << 0>, (void*)mk_fwd<1u << 1>, (void*)mk_fwd<1u << 2>, (void*)mk_fwd<1u << 3>, (void*)mk_fwd<1u << 4>, (void*)mk_fwd<1u << 5>,
                     (void*)mk_fwd<1u << 6>, (void*)mk_fwd<1u << 7>, (void*)mk_fwd<1u << 8>, (void*)mk_fwd<1u << 9>, (void*)mk_fwd<1u << 10>};
    constexpr int NKFN = 11;
#endif
    if (grid == 0) {
        if (n_in != 23 || out_size != T * DM || ws_size < WS_END) { fprintf(stderr, "kernel_launch: unexpected shapes (n_in %d, out %d, ws %zu, need %zu)\n", n_in, out_size, ws_size, (size_t)WS_END); grid = -1; return; }
        int dev = 0, cus = 0, per_cu = 0;
        hipGetDevice(&dev); hipDeviceGetAttribute(&cus, hipDeviceAttributeMultiprocessorCount, dev);
        for (int k = 0; k < NKFN; ++k) {
            if (hipFuncSetAttribute((const void*)kfn[k], hipFuncAttributeMaxDynamicSharedMemorySize, LDS_BYTES) != hipSuccess) { fprintf(stderr, "kernel_launch: hipFuncSetAttribute failed\n"); grid = -1; return; }
            int pc = 0;
            if (hipOccupancyMaxActiveBlocksPerMultiprocessor(&pc, (const void*)kfn[k], NTHR, LDS_BYTES) != hipSuccess || pc < 1) { fprintf(stderr, "kernel_launch: occupancy query says %d for kernel %d\n", pc, k); grid = -1; return; }
            per_cu = pc;
        }
        (void)hipGetLastError();
        grid = cus * 1;
        fprintf(stderr, "kernel_launch: cus %d per_cu %d grid %d\n", cus, per_cu, grid);
    }
    if (grid < 0) return;
    hipMemsetAsync((char*)d_ws + WS_CTL, 0, CTL_BYTES, stream);
    Args a{};
    for (int i = 0; i < 23; ++i) a.in[i] = (const float*)d_in[i];
    a.out = (float*)d_out; a.ws = (unsigned char*)d_ws;
#if MK_ONE_LAUNCH
    a.ph_lo = 0; a.ph_hi = N_PHASES;
    { void* kargs[] = {&a}; hipError_t e = hipLaunchCooperativeKernel((void*)mk_fwd<0x7ffu>, dim3(grid), dim3(NTHR), kargs, LDS_BYTES, stream);
      if (e != hipSuccess) fprintf(stderr, "cooperative launch failed: %s\n", hipGetErrorString(e)); }
#else
    for (int p = 0; p < N_PHASES; ++p) {
        a.ph_lo = p; a.ph_hi = p + 1;
        void* kargs[] = {&a}; hipError_t e = hipLaunchCooperativeKernel(kfn[PH_BIT(p)], dim3(grid), dim3(NTHR), kargs, LDS_BYTES, stream);
        if (e != hipSuccess) { fprintf(stderr, "cooperative launch %d failed: %s\n", p, hipGetErrorString(e)); break; }
    }
#endif
}
```

```cpp
#include <hip/hip_runtime.h>
#include <hip/hip_cooperative_groups.h>
#include <cstdio>
#include <cstdint>
namespace cg = cooperative_groups;

#ifndef MK_ONE_LAUNCH
#define MK_ONE_LAUNCH 1
#endif

#define GAS __attribute__((address_space(1)))
#define LAS __attribute__((address_space(3)))
typedef unsigned short bf16_t;
typedef short bf16x8 __attribute__((ext_vector_type(8)));
typedef float f32x4 __attribute__((ext_vector_type(4)));
typedef float f32x2 __attribute__((ext_vector_type(2)));
typedef unsigned u32x4 __attribute__((ext_vector_type(4)));
typedef unsigned u32x2 __attribute__((ext_vector_type(2)));

constexpr int T = 65536, DM = 1024, NB = 32, SEQ = 2048, CHK = 64, NCH = 32;
constexpr int NPROJ = 2816;
constexpr int C_QA = 0, C_CKV = 512, C_QI = 640, C_KI = 1152, C_U = 1216, C_V = 1728, C_Z = 2240, C_WI = 2752, C_IG = 2760, C_FG = 2764;
constexpr int IN_W = 2768;
constexpr int NEXP = 32, TOPE = 4, NROUND = 4;
constexpr int RCAP = T + NEXP * 256;
constexpr float LN_EPS = 1e-5f;
constexpr float DN_ALPHA = 1.189207115002721f;
constexpr int KSEL = 256;

constexpr size_t MiB = 1u << 20;
constexpr size_t WS_CTL = 0, CTL_BYTES = 1 * MiB;
constexpr size_t WS_WIN = 1 * MiB;
constexpr size_t WS_WOUT = 7 * MiB;
constexpr size_t WS_WGU = 9 * MiB;
constexpr size_t WS_WD = 137 * MiB;
constexpr size_t WS_XB = 201 * MiB;
constexpr size_t WS_H1B = WS_XB;
constexpr size_t WS_PROJ = 329 * MiB;
constexpr size_t WS_PRE1 = WS_PROJ;
constexpr size_t WS_XG = WS_PROJ;
constexpr size_t WS_HB = WS_PROJ + 144 * MiB;
constexpr size_t WS_G32 = 681 * MiB;
constexpr size_t WS_CB = 685 * MiB;
constexpr size_t WS_MASK = 701 * MiB;
constexpr size_t WS_MIX = 717 * MiB;
constexpr size_t WS_TOPE = 845 * MiB;
constexpr size_t WS_GATE = 846 * MiB;
constexpr size_t WS_RANK = 847 * MiB;
constexpr size_t WS_RTOK = 848 * MiB;
constexpr size_t WS_RGATE = 850 * MiB;
constexpr size_t WS_WUKB = 852 * MiB;
constexpr size_t WS_WUVF = 853 * MiB;
constexpr size_t WS_WMQT = 854 * MiB;
constexpr size_t WS_WMKT = 855 * MiB;
constexpr size_t WS_END = 856 * MiB;
constexpr int CW_CNT = 64;
constexpr int CW_Q = 256;

constexpr int RING_BYTES = 131072;
constexpr int LCTL_OFF = RING_BYTES;
constexpr int LDS_BYTES = 147456;
constexpr int NWAVES = 8, NTHR = 512;

__device__ __forceinline__ unsigned f2bf(float f) { unsigned u = __builtin_bit_cast(unsigned, f); return (u + 0x7fffu + ((u >> 16) & 1u)) >> 16; }
__device__ __forceinline__ unsigned pk2(float lo, float hi) { return f2bf(lo) | (f2bf(hi) << 16); }
typedef __bf16 bf16v2_t __attribute__((ext_vector_type(2)));
__device__ __forceinline__ unsigned cvtpk_c(float lo, float hi) { bf16v2_t v = {(__bf16)lo, (__bf16)hi}; return __builtin_bit_cast(unsigned, v); }
__device__ __forceinline__ float bf2f(unsigned h) { return __builtin_bit_cast(float, h << 16); }
__device__ __forceinline__ float bflo(unsigned p) { return __builtin_bit_cast(float, p << 16); }
__device__ __forceinline__ float bfhi(unsigned p) { return __builtin_bit_cast(float, p & 0xffff0000u); }
__device__ __forceinline__ float wave_sum(float v) {
#pragma unroll
    for (int o = 1; o < 64; o <<= 1) v += __shfl_xor(v, o);
    return v;
}
__device__ __forceinline__ float wave_max(float v) {
#pragma unroll
    for (int o = 1; o < 64; o <<= 1) v = fmaxf(v, __shfl_xor(v, o));
    return v;
}
__device__ __forceinline__ int my_lane() { return (int)__builtin_amdgcn_mbcnt_hi(~0u, __builtin_amdgcn_mbcnt_lo(~0u, 0u)); }
__device__ __forceinline__ int launder(int v) { asm volatile("" : "+v"(v)); return v; }
__device__ __forceinline__ float sigmoidf_(float x) { return 1.0f / (1.0f + __expf(-x)); }

namespace pg8 {
constexpr int BM = 256, BK = 64, HALF = 128, HTB = HALF * BK * 2, STAGE_BYTES = 8 * HTB, NXCD = 8, WGM = 8;
__host__ __device__ __forceinline__ int lds_byte(int r, int c) { const int st = (r >> 4) * 2 + (c >> 5), rr = r & 15, cc = c & 31, ob = rr * 64 + cc * 2; return st * 1024 + (ob ^ (((ob >> 9) & 1) << 5)); }
__host__ __device__ __forceinline__ void stage_rc(int b, int& R, int& C) { const int st = b / 1024, sb = b % 1024, swz = sb ^ (((sb >> 9) & 1) << 5); R = (st >> 1) * 16 + swz / 64; C = (st & 1) * 32 + (swz % 64) / 2; }
__host__ __device__ __forceinline__ int perm32(int rho) { const int n = rho >> 4, i = rho & 15; return 8 * (i >> 2) + 4 * n + (i & 3); }

struct Unit { int pm, pn, po, pe; };
struct Gemm { const bf16_t* A; const bf16_t* Bt; int lda, ldb, K; };

struct StaticOrder {
    int nM, nN, nwg, G, c;
    __device__ void init(int M, int N, int G_, int c_) { nM = M / BM; nN = N / BM; nwg = nM * nN; G = G_; c = c_; }
    __device__ bool next(int i, Unit& u) const {
        const long L = (long)i * G + c; if (L >= nwg) return false;
        int wgid = (int)L; { const int q = nwg / NXCD, r = nwg % NXCD, xcd = wgid % NXCD, off = wgid / NXCD; wgid = (xcd < r ? xcd * (q + 1) : r * (q + 1) + (xcd - r) * q) + off; }
        const int nig = WGM * nN, gid = wgid / nig, fm = gid * WGM, gsz = (nM - fm) < WGM ? (nM - fm) : WGM;
        u.pm = fm + ((wgid % nig) % gsz); u.pn = (wgid % nig) / gsz; u.po = u.pn; u.pe = 0; return true;
    }
};

__device__ __forceinline__ unsigned cvt_pk_bf16(float lo, float hi) { return cvtpk_c(lo, hi); }

template <class Epi, class Sched>
__device__ __forceinline__ void gemm_phase(LAS unsigned char* lds, const Gemm g, const Sched& S, const Epi& E, int wave_id) {
    int lane_ = my_lane(); asm volatile("" : "+v"(lane_));
    const int wid = wave_id, lane = lane_, tid = wid * 64 + lane;
    const int wr = wid >> 2, wc = wid & 3, fr = lane & 15, fq = lane >> 4;
    const int K = g.K, nt = K / BK;
    unsigned voffA[2], voffB[2];
#pragma unroll
    for (int i = 0; i < 2; ++i) { int R, C; stage_rc(tid * 16 + i * 8192, R, C); const int Rb = Epi::PERM ? ((R & ~31) + perm32(R & 31)) : R;
        voffA[i] = (unsigned)(R * g.lda + C) * 2u; voffB[i] = (unsigned)(Rb * g.ldb + C) * 2u; }
    const size_t kstep = (size_t)(BK * 2);
    const size_t hstepA = (size_t)HALF * g.lda * 2, hstepB = (size_t)HALF * g.ldb * 2;
    const size_t tstepA = 2 * hstepA, tstepB = 2 * hstepB;
    const unsigned ldsw = (unsigned)wid * 1024u;
    const int aoff = lds_byte(wr * 64 + fr, fq * 8), boff = lds_byte(wc * 32 + fr, fq * 8);
#define PG8_SA(b, h) (((b) * 2 + (h)) * HTB)
#define PG8_SB(b, h) ((4 + (b) * 2 + (h)) * HTB)
#define PG8_STAGE(bufoff, gbase, voff) do { _Pragma("unroll") for (int _i = 0; _i < 2; ++_i) \
        __builtin_amdgcn_global_load_lds((const unsigned*)((const char*)(gbase) + (voff)[_i]), (LAS unsigned*)(lds + (bufoff) + ldsw + _i * 8192), 16, 0, 0); } while (0)
#define PG8_LDA(dst, b, h) do { _Pragma("unroll") for (int m = 0; m < 4; ++m) _Pragma("unroll") for (int k = 0; k < 2; ++k) dst[m][k] = *(const LAS bf16x8*)(lds + PG8_SA(b, h) + aoff + m * 2048 + k * 1024); } while (0)
#define PG8_LDB(dst, b, h) do { _Pragma("unroll") for (int n = 0; n < 2; ++n) _Pragma("unroll") for (int k = 0; k < 2; ++k) dst[n][k] = *(const LAS bf16x8*)(lds + PG8_SB(b, h) + boff + n * 2048 + k * 1024); } while (0)
#define PG8_MMA(ai, bj, At, Bt) do { __builtin_amdgcn_s_setprio(1); _Pragma("unroll") for (int m = 0; m < 4; ++m) _Pragma("unroll") for (int n = 0; n < 2; ++n) _Pragma("unroll") for (int k = 0; k < 2; ++k) \
        acc[ai][bj][m][n] = __builtin_amdgcn_mfma_f32_16x16x32_bf16(Bt[n][k], At[m][k], acc[ai][bj][m][n], 0, 0, 0); __builtin_amdgcn_s_setprio(0); } while (0)
#define PG8_WAIT_V(n) asm volatile("s_waitcnt vmcnt(" #n ")" ::: "memory")
#define PG8_WAIT_L(n) asm volatile("s_waitcnt lgkmcnt(" #n ")" ::: "memory")
#define PG8_BAR __builtin_amdgcn_s_barrier()
#define PG8_SCHED __builtin_amdgcn_sched_barrier(0)
    Unit cur, nxt; int ui = 0;
    if (!S.next(0, cur)) return;
    f32x4 acc[2][2][4][2];
#pragma unroll
    for (int a = 0; a < 2; ++a)
#pragma unroll
        for (int b = 0; b < 2; ++b)
#pragma unroll
            for (int m = 0; m < 4; ++m)
#pragma unroll
                for (int n = 0; n < 2; ++n) acc[a][b][m][n] = (f32x4){0.f, 0.f, 0.f, 0.f};
    bf16x8 At[4][2], B0[2][2], B1[2][2];
    const char* cA = (const char*)g.A + (size_t)cur.pm * tstepA; const char* cB = (const char*)g.Bt + (size_t)cur.pn * tstepB;
    PG8_STAGE(PG8_SB(0, 0), cB, voffB); PG8_STAGE(PG8_SB(0, 1), cB + hstepB, voffB); PG8_STAGE(PG8_SA(0, 0), cA, voffA); PG8_STAGE(PG8_SA(0, 1), cA + hstepA, voffA);
    if (wr == 1) PG8_BAR;
    PG8_WAIT_V(2); PG8_BAR;
    PG8_STAGE(PG8_SB(1, 0), cB + kstep, voffB); PG8_STAGE(PG8_SA(1, 0), cA + kstep, voffA); PG8_STAGE(PG8_SB(1, 1), cB + hstepB + kstep, voffB);
    PG8_WAIT_V(6); PG8_BAR;
    for (;;) {
        const bool has_next = S.next(ui + 1, nxt);
        const char* nA = has_next ? (const char*)g.A + (size_t)nxt.pm * tstepA : cA; const char* nB = has_next ? (const char*)g.Bt + (size_t)nxt.pn * tstepB : cB;
        for (int t = 0; t < nt; t += 2) {
            const bool last = (t == nt - 2);
            const char* a1 = cA + (size_t)(t + 1) * kstep;
            const char* a2 = last ? nA : cA + (size_t)(t + 2) * kstep; const char* b2 = last ? nB : cB + (size_t)(t + 2) * kstep;
            const char* a3 = a2 + kstep; const char* b3 = b2 + kstep;
            PG8_LDB(B0, 0, 0); PG8_LDB(B1, 0, 1); PG8_SCHED; PG8_LDA(At, 0, 0); PG8_STAGE(PG8_SA(1, 1), a1 + hstepA, voffA);
            PG8_WAIT_V(8); PG8_WAIT_L(0); PG8_BAR; PG8_MMA(0, 0, At, B0); PG8_MMA(0, 1, At, B1); PG8_BAR; PG8_SCHED;
            PG8_LDA(At, 0, 1); PG8_STAGE(PG8_SB(0, 0), b2, voffB); PG8_STAGE(PG8_SB(0, 1), b2 + hstepB, voffB); PG8_STAGE(PG8_SA(0, 0), a2, voffA);
            PG8_WAIT_V(8); PG8_WAIT_L(0); PG8_BAR; PG8_MMA(1, 0, At, B0); PG8_MMA(1, 1, At, B1); PG8_BAR; PG8_SCHED;
            PG8_LDB(B0, 1, 0); PG8_LDB(B1, 1, 1); PG8_SCHED; PG8_LDA(At, 1, 0); PG8_STAGE(PG8_SA(0, 1), a2 + hstepA, voffA);
            PG8_WAIT_V(8); PG8_WAIT_L(0); PG8_BAR; PG8_MMA(0, 0, At, B0); PG8_MMA(0, 1, At, B1); PG8_BAR; PG8_SCHED;
            PG8_LDA(At, 1, 1); PG8_STAGE(PG8_SB(1, 0), b3, voffB); PG8_STAGE(PG8_SB(1, 1), b3 + hstepB, voffB); PG8_STAGE(PG8_SA(1, 0), a3, voffA);
            PG8_WAIT_V(8); PG8_WAIT_L(0); PG8_BAR; PG8_MMA(1, 0, At, B0); PG8_MMA(1, 1, At, B1); PG8_BAR; PG8_SCHED;
        }
        if (wr == 0) PG8_BAR;
        E(acc, cur, wr, wc, fr, fq);
        if (!has_next) break;
#pragma unroll
        for (int a = 0; a < 2; ++a)
#pragma unroll
            for (int b = 0; b < 2; ++b)
#pragma unroll
                for (int m = 0; m < 4; ++m)
#pragma unroll
                    for (int n = 0; n < 2; ++n) acc[a][b][m][n] = (f32x4){0.f, 0.f, 0.f, 0.f};
        cur = nxt; cA = nA; cB = nB; ++ui;
        if (wr == 1) PG8_BAR;
    }
    PG8_WAIT_V(0);
    PG8_BAR;
#undef PG8_SA
#undef PG8_SB
#undef PG8_STAGE
#undef PG8_LDA
#undef PG8_LDB
#undef PG8_MMA
#undef PG8_WAIT_V
#undef PG8_WAIT_L
#undef PG8_BAR
#undef PG8_SCHED
}
}

struct Args {
    const float* in[23];
    float* out; unsigned char* ws;
    int ph_lo, ph_hi;
};
struct Frame {
    LAS unsigned char* lds;
    int tid, lane, wave, G, bid;
};
#define F_in(k) (args.in[k])
#define F_x F_in(0)
#define F_w_in F_in(1)
#define F_kv_norm_g F_in(2)
#define F_w_uk F_in(3)
#define F_w_uv F_in(4)
#define F_m_conv_w F_in(5)
#define F_m_conv_b F_in(6)
#define F_w_mq F_in(7)
#define F_w_mk F_in(8)
#define F_b_i F_in(9)
#define F_b_f F_in(10)
#define F_m_norm_g F_in(11)
#define F_w_out F_in(12)
#define F_ln1_g F_in(13)
#define F_ln1_b F_in(14)
#define F_w_router F_in(15)
#define F_b_router F_in(16)
#define F_w_gu F_in(17)
#define F_b_gu F_in(18)
#define F_w_down F_in(19)
#define F_b_down F_in(20)
#define F_ln2_g F_in(21)
#define F_ln2_b F_in(22)
#define F_out (args.out)
#define F_ctl ((unsigned*)(args.ws + WS_CTL))
#define F_WinT ((bf16_t*)(args.ws + WS_WIN))
#define F_WoutT ((bf16_t*)(args.ws + WS_WOUT))
#define F_WguT ((bf16_t*)(args.ws + WS_WGU))
#define F_WdT ((bf16_t*)(args.ws + WS_WD))
#define F_xb ((bf16_t*)(args.ws + WS_XB))
#define F_h1b ((bf16_t*)(args.ws + WS_H1B))
#define F_projb ((bf16_t*)(args.ws + WS_PROJ))
#define F_cb ((bf16_t*)(args.ws + WS_CB))
#define F_mix ((bf16_t*)(args.ws + WS_MIX))
#define F_xg ((bf16_t*)(args.ws + WS_XG))
#define F_hb ((bf16_t*)(args.ws + WS_HB))
#define F_g32 ((float*)(args.ws + WS_G32))
#define F_pre1 ((float*)(args.ws + WS_PRE1))
#define F_gate ((float*)(args.ws + WS_GATE))
#define F_rgate ((float*)(args.ws + WS_RGATE))
#define F_mask ((unsigned*)(args.ws + WS_MASK))
#define F_tope ((int*)(args.ws + WS_TOPE))
#define F_rank ((int*)(args.ws + WS_RANK))
#define F_rtok ((int*)(args.ws + WS_RTOK))
#define F_wukb ((bf16_t*)(args.ws + WS_WUKB))
#define F_wuvf ((bf16_t*)(args.ws + WS_WUVF))
#define F_wmqT ((bf16_t*)(args.ws + WS_WMQT))
#define F_wmkT ((bf16_t*)(args.ws + WS_WMKT))

__device__ __forceinline__ int in_map(int n) {
    if (n < 1216) return n;
    if (n < 2752) return n + 8;
    if (n < 2760) return n - 2752 + 1216;
    if (n < 2768) return n;
    return -1;
}
template <int MODE>
__device__ __forceinline__ void transpose_item(const float* W, int K, int Norig, bf16_t* WT, LAS float* scr, int kb, int nb, int lane) {
    const int k0 = 64 * kb, n0 = 32 * nb;
    const int nn = n0 + (lane & 31);
    int oc;
    if (MODE == 0) oc = nn;
    else if (MODE == 1) oc = in_map(nn);
    else { const int pn = nn >> 8, half = (nn >> 7) & 1, i = nn & 127; oc = half * 1024 + pn * 128 + i; }
#pragma unroll 8
    for (int i = 0; i < 32; ++i) { const int kk = 2 * i + (lane >> 5); scr[kk * 33 + (lane & 31)] = (oc >= 0) ? W[(size_t)(k0 + kk) * Norig + oc] : 0.f; }
    asm volatile("s_waitcnt lgkmcnt(0)" ::: "memory");
    const int c = lane & 7;
#pragma unroll
    for (int j = 0; j < 4; ++j) { const int n = (lane >> 3) + 8 * j; const LAS float* s = scr + (8 * c) * 33 + n;
        u32x4 o; o.x = pk2(s[0 * 33], s[1 * 33]); o.y = pk2(s[2 * 33], s[3 * 33]); o.z = pk2(s[4 * 33], s[5 * 33]); o.w = pk2(s[6 * 33], s[7 * 33]);
        *(u32x4*)(WT + (size_t)(n0 + n) * K + k0 + 8 * c) = o; }
    asm volatile("s_waitcnt lgkmcnt(0)" ::: "memory");
}
__device__ __forceinline__ void p0_prologue(const Args& args, Frame& F) {
    LAS float* scr = (LAS float*)(F.lds + F.wave * 16384);
    const int gw = F.bid * NWAVES + F.wave, NGW = F.G * NWAVES;
    constexpr int I_IN = 16 * (NPROJ / 32), I_OUT = 16 * 32, I_GU = NEXP * 16 * 64, I_D = NEXP * 16 * 32;
    constexpr int NITEMS = I_IN + I_OUT + I_GU + I_D;
    for (int it = gw; it < NITEMS; it += NGW) {
        int r = it;
        if (r < I_IN) { const int nbk = NPROJ / 32; transpose_item<1>(F_w_in, DM, IN_W, F_WinT, scr, r / nbk, r % nbk, F.lane); continue; } r -= I_IN;
        if (r < I_OUT) { transpose_item<0>(F_w_out, DM, DM, F_WoutT, scr, r / 32, r % 32, F.lane); continue; } r -= I_OUT;
        if (r < I_GU) { const int e = r / (16 * 64), q = r % (16 * 64); transpose_item<2>(F_w_gu + (size_t)e * DM * 2048, DM, 2048, F_WguT + (size_t)e * 2048 * DM, scr, q / 64, q % 64, F.lane); continue; } r -= I_GU;
        { const int e = r / (16 * 32), q = r % (16 * 32); transpose_item<0>(F_w_down + (size_t)e * DM * DM, DM, DM, F_WdT + (size_t)e * DM * DM, scr, q / 32, q % 32, F.lane); }
    }
    { const int gtid = F.bid * NTHR + F.tid, NT_ = F.G * NTHR;
      for (int i = gtid; i < 8 * 128 * 64; i += NT_) F_wukb[i] = (bf16_t)f2bf(F_w_uk[i] * 0.125f);
      for (int i = gtid; i < 4 * 128 * 128; i += NT_) { const int d = i & 127, e = (i >> 7) & 127, h = i >> 14;
          F_wmqT[i] = (bf16_t)f2bf(F_w_mq[((size_t)h * 128 + d) * 128 + e]); F_wmkT[i] = (bf16_t)f2bf(F_w_mk[((size_t)h * 128 + d) * 128 + e] * 0.08838834764831845f); }
      for (int i = gtid; i < 8 * 2 * 4 * 2 * 64 * 8; i += NT_) { const int j = i & 7, ln = (i >> 3) & 63, sx = (i >> 9) & 1, d0 = (i >> 10) & 3, dt = (i >> 12) & 1, h = i >> 13;
          const int hi = ln >> 5, r32 = ln & 31; const int lat = 32 * d0 + 16 * sx + 8 * (j >> 2) + 4 * hi + (j & 3), dd = 32 * dt + r32;
          F_wuvf[i] = (bf16_t)f2bf(F_w_uv[((size_t)h * 128 + lat) * 64 + dd]); } }
    for (int m = gw; m < T; m += NGW) {
        const f32x4* xr = (const f32x4*)(F_x + (size_t)m * DM) + F.lane;
        u32x2* o = (u32x2*)(F_xb + (size_t)m * DM) + F.lane;
#pragma unroll
        for (int j = 0; j < 4; ++j) { const f32x4 v = xr[64 * j]; u32x2 w; w.x = pk2(v.x, v.y); w.y = pk2(v.z, v.w); o[64 * j] = w; }
    }
}

struct EpiProj {
    static constexpr bool PERM = true;
    bf16_t* O; float* g32;
    __device__ __forceinline__ void operator()(const f32x4 (&acc)[2][2][4][2], const pg8::Unit& u, int wr, int wc, int fr, int fq) const {
        const int row0 = u.pm * 256 + wr * 64 + fr, col0 = u.po * 256 + wc * 32 + 8 * fq;
#pragma unroll
        for (int ai = 0; ai < 2; ++ai)
#pragma unroll
            for (int m = 0; m < 4; ++m) { const int row = row0 + ai * 128 + m * 16;
#pragma unroll
                for (int bj = 0; bj < 2; ++bj) { const f32x4 v0 = acc[ai][bj][m][0], v1 = acc[ai][bj][m][1]; const int col = col0 + bj * 128;
                    u32x4 w; w.x = pg8::cvt_pk_bf16(v0[0], v0[1]); w.y = pg8::cvt_pk_bf16(v0[2], v0[3]); w.z = pg8::cvt_pk_bf16(v1[0], v1[1]); w.w = pg8::cvt_pk_bf16(v1[2], v1[3]);
                    *(u32x4*)(O + (size_t)row * NPROJ + col) = w;
                    if (col >= C_WI && col < C_WI + 16) { float* gp = g32 + (size_t)row * 16 + (col - C_WI); *(f32x4*)gp = v0; *(f32x4*)(gp + 4) = v1; } } }
    }
};
struct EpiOut {
    static constexpr bool PERM = false;
    const float* x; float* pre;
    __device__ __forceinline__ void operator()(const f32x4 (&acc)[2][2][4][2], const pg8::Unit& u, int wr, int wc, int fr, int fq) const {
        const int row0 = u.pm * 256 + wr * 64 + fr, col0 = u.po * 256 + wc * 32 + 4 * fq;
#pragma unroll
        for (int ai = 0; ai < 2; ++ai)
#pragma unroll
            for (int m = 0; m < 4; ++m) { const size_t off = (size_t)(row0 + ai * 128 + m * 16) * DM + col0;
#pragma unroll
                for (int bj = 0; bj < 2; ++bj)
#pragma unroll
                    for (int n = 0; n < 2; ++n) { const f32x4 xv = *(const f32x4*)(x + off + bj * 128 + n * 16); *(f32x4*)(pre + off + bj * 128 + n * 16) = xv * DN_ALPHA + acc[ai][bj][m][n]; } }
    }
};
struct EpiGU {
    static constexpr bool PERM = true;
    bf16_t* H; const float* b_gu;
    __device__ __forceinline__ void operator()(const f32x4 (&acc)[2][2][4][2], const pg8::Unit& u, int wr, int wc, int fr, int fq) const {
        const int row0 = u.pm * 256 + wr * 64 + fr, hc = u.po * 128 + wc * 32 + 8 * fq;
        const float* bg = b_gu + (size_t)u.pe * 2048 + hc;
        f32x4 bgv[2], buv[2];
#pragma unroll
        for (int n = 0; n < 2; ++n) { bgv[n] = *(const f32x4*)(bg + 4 * n); buv[n] = *(const f32x4*)(bg + 1024 + 4 * n); }
#pragma unroll
        for (int ai = 0; ai < 2; ++ai)
#pragma unroll
            for (int m = 0; m < 4; ++m) { const int row = row0 + ai * 128 + m * 16; float hv[8];
#pragma unroll
                for (int n = 0; n < 2; ++n)
#pragma unroll
                    for (int i = 0; i < 4; ++i) { float gt = acc[ai][0][m][n][i] + bgv[n][i], up = acc[ai][1][m][n][i] + buv[n][i];
                        gt = fminf(gt, 7.0f); up = fminf(fmaxf(up, -7.0f), 7.0f);
                        hv[n * 4 + i] = (up + 1.0f) * gt * sigmoidf_(1.702f * gt); }
                u32x4 w; w.x = pg8::cvt_pk_bf16(hv[0], hv[1]); w.y = pg8::cvt_pk_bf16(hv[2], hv[3]); w.z = pg8::cvt_pk_bf16(hv[4], hv[5]); w.w = pg8::cvt_pk_bf16(hv[6], hv[7]);
                *(u32x4*)(H + (size_t)row * DM + hc) = w; }
    }
};
struct EpiDown {
    static constexpr bool PERM = false;
    float* Y; const float* b_down; const int* rtok; const float* rgate; int first;
    __device__ __forceinline__ void operator()(const f32x4 (&acc)[2][2][4][2], const pg8::Unit& u, int wr, int wc, int fr, int fq) const {
        const int row0 = u.pm * 256 + wr * 64 + fr, col0 = u.po * 256 + wc * 32 + 4 * fq;
        const float* bd = b_down + (size_t)u.pe * DM + col0;
#pragma unroll
        for (int ai = 0; ai < 2; ++ai)
#pragma unroll
            for (int m = 0; m < 4; ++m) { const int row = row0 + ai * 128 + m * 16; const int tok = rtok[row]; const float gt = rgate[row];
                if (tok >= 0) { float* yp = Y + (size_t)tok * DM + col0;
#pragma unroll
                    for (int bj = 0; bj < 2; ++bj)
#pragma unroll
                        for (int n = 0; n < 2; ++n) { const f32x4 bv = *(const f32x4*)(bd + bj * 128 + n * 16); f32x4 v = (acc[ai][bj][m][n] + bv) * gt;
                            if (!first) v += *(const f32x4*)(yp + bj * 128 + n * 16);
                            *(f32x4*)(yp + bj * 128 + n * 16) = v; } } }
    }
};
struct MoeOrder {
    const LAS int* offs; int npn, G, c, nunits;
    __device__ void init(const LAS int* offs_, int npn_, int G_, int c_) { offs = offs_; npn = npn_; G = G_; c = c_; nunits = (offs_[NEXP] >> 8) * npn_; }
    __device__ bool next(int i, pg8::Unit& u) const {
        const int L = i * G + c; if (L >= nunits) return false;
        const int pm = L / npn, pnl = L % npn; int e = 0;
        for (int k = 1; k < NEXP; ++k) e += (offs[k] <= pm * 256) ? 1 : 0;
        u.pm = pm; u.pn = e * npn + pnl; u.po = pnl; u.pe = e; return true;
    }
};

__device__ __forceinline__ void p2_cb(const Args& args, Frame& F) {
    const int gw = F.bid * NWAVES + F.wave, NGW = F.G * NWAVES;
    const float g0 = F_kv_norm_g[2 * F.lane], g1 = F_kv_norm_g[2 * F.lane + 1];
    for (int tok = gw; tok < T; tok += NGW) {
        const unsigned p = *(const unsigned*)(F_projb + (size_t)tok * NPROJ + C_CKV + 2 * F.lane);
        const float a = bflo(p), b = bfhi(p);
        const float ss = wave_sum(a * a + b * b);
        const float r = 1.0f / sqrtf(ss * (1.0f / 128.0f) + LN_EPS);
        *(unsigned*)(F_cb + (size_t)tok * 128 + 2 * F.lane) = pk2(a * r * g0, b * r * g1);
    }
}

__device__ __forceinline__ void p2_indexer(const Args& args, Frame& F) {
    const int lane = F.lane, wave = F.wave;
    {
        const int gw = F.bid * NWAVES + wave, NGW = F.G * NWAVES;
        for (int i = gw; i < NB * 256; i += NGW) { const int b = i >> 8, t = i & 255, ci = t >> 6; const int tok = b * SEQ + t;
            F_mask[(size_t)tok * 64 + lane] = (lane < 2 * (ci + 1)) ? 0xffffffffu : 0u; }
    }
    LAS float* qs = (LAS float*)(F.lds) + wave * 512;
    LAS float* sc = (LAS float*)(F.lds + 16384) + wave * 2048;
    for (int r = 0; r < 28; ++r) {
        const int ci = 31 - r, ntl = ci + 1;
        for (int sub = F.bid; sub < 256; sub += F.G) {
            const int b = sub >> 3, qg = sub & 7;
            const int t = ci * 64 + qg * 8 + wave; const int tok = b * SEQ + t;
            { const u32x4 p = *(const u32x4*)(F_projb + (size_t)tok * NPROJ + C_QI + 8 * lane);
              LAS float* q = qs + 8 * lane;
              q[0] = bflo(p.x); q[1] = bfhi(p.x); q[2] = bflo(p.y); q[3] = bfhi(p.y); q[4] = bflo(p.z); q[5] = bfhi(p.z); q[6] = bflo(p.w); q[7] = bfhi(p.w); }
            float wq[8];
#pragma unroll
            for (int h = 0; h < 8; ++h) wq[h] = F_g32[(size_t)tok * 16 + h];
            asm volatile("s_waitcnt lgkmcnt(0)" ::: "memory");
            for (int j = 0; j < ntl; ++j) {
                const int s = j * 64 + lane;
                const u32x4* kp = (const u32x4*)(F_projb + (size_t)(b * SEQ + s) * NPROJ + C_KI);
                float kf[64];
#pragma unroll
                for (int c = 0; c < 8; ++c) { const u32x4 p = kp[c]; kf[8 * c] = bflo(p.x); kf[8 * c + 1] = bfhi(p.x); kf[8 * c + 2] = bflo(p.y); kf[8 * c + 3] = bfhi(p.y);
                    kf[8 * c + 4] = bflo(p.z); kf[8 * c + 5] = bfhi(p.z); kf[8 * c + 6] = bflo(p.w); kf[8 * c + 7] = bfhi(p.w); }
                float score = 0.f;
#pragma unroll
                for (int h = 0; h < 8; ++h) { float d = 0.f;
#pragma unroll
                    for (int c = 0; c < 16; ++c) { const f32x4 qv = *(const LAS f32x4*)(qs + h * 64 + 4 * c); d += qv.x * kf[4 * c] + qv.y * kf[4 * c + 1] + qv.z * kf[4 * c + 2] + qv.w * kf[4 * c + 3]; }
                    score += wq[h] * fmaxf(d, 0.f); }
                sc[j * 64 + lane] = score + 0.0f;
            }
            asm volatile("s_waitcnt lgkmcnt(0)" ::: "memory");
            unsigned u[32];
#pragma unroll
            for (int j = 0; j < 32; ++j) { unsigned v = 0u; if (j < ntl) { const unsigned bts = __builtin_bit_cast(unsigned, sc[j * 64 + lane]); v = (bts & 0x80000000u) ? ~bts : (bts | 0x80000000u); } u[j] = v; }
            unsigned thr = 0u;
            for (int bit = 31; bit >= 0; --bit) {
                const unsigned cand = thr | (1u << bit); int cnt = 0;
#pragma unroll
                for (int j = 0; j < 32; ++j) cnt += __popcll(__ballot(u[j] >= cand));
                if (cnt >= KSEL) thr = cand;
            }
            int cgt = 0;
#pragma unroll
            for (int j = 0; j < 32; ++j) cgt += __popcll(__ballot(u[j] > thr));
            const int need = KSEL - cgt;
            int eqbase = 0;
            const unsigned long long ltmask = (1ull << lane) - 1ull;
#pragma unroll
            for (int j = 0; j < 32; ++j) {
                const unsigned long long eqm = __ballot(u[j] == thr);
                const int rk = eqbase + __popcll(eqm & ltmask);
                const bool sel = (u[j] > thr) || (u[j] == thr && rk < need);
                const unsigned long long sm = __ballot(sel);
                eqbase += __popcll(eqm);
                if (lane == 0) { F_mask[(size_t)tok * 64 + 2 * j] = (unsigned)sm; F_mask[(size_t)tok * 64 + 2 * j + 1] = (unsigned)(sm >> 32); }
            }
        }
    }
}

__device__ __forceinline__ void p2_mlstm(const Args& args, Frame& F) {
    const int tid = F.tid, lane = F.lane, wave = F.wave;
    LAS float* ucL = (LAS float*)(F.lds);
    LAS float* qL = (LAS float*)(F.lds + 32768);
    LAS float* kL = (LAS float*)(F.lds + 65536);
    LAS float* vL = (LAS float*)(F.lds + 98304);
    LAS float* gL = (LAS float*)(F.lds + LCTL_OFF + 4096);
    for (int item = F.bid; item < NB * 4; item += F.G) {
        const int b = item >> 2, h = item & 3;
        const int v = tid >> 2, kq = tid & 3;
        float C[32], nst[32];
#pragma unroll
        for (int j = 0; j < 32; ++j) { C[j] = 0.f; nst[j] = 0.f; }
        const float bi = F_b_i[h], bfv = F_b_f[h];
        for (int c = 0; c < NCH; ++c) {
            const int tok0 = b * SEQ + c * CHK;
            __syncthreads();
            for (int idx = tid; idx < 64 * 128; idx += NTHR) { const int t = idx >> 7, d = idx & 127; const int ch = h * 128 + d;
                float y = F_m_conv_b[ch];
#pragma unroll
                for (int j = 0; j < 4; ++j) { const int tt = c * CHK + t - 3 + j; if (tt >= 0) y += F_m_conv_w[j * 512 + ch] * bf2f(F_projb[(size_t)(b * SEQ + tt) * NPROJ + C_U + ch]); }
                ucL[idx] = y * sigmoidf_(y);
                vL[idx] = bf2f(F_projb[(size_t)(tok0 + t) * NPROJ + C_V + ch]); }
            if (tid < 64) { const float ip = F_g32[(size_t)(tok0 + tid) * 16 + 8 + h] + bi, fp = F_g32[(size_t)(tok0 + tid) * 16 + 12 + h] + bfv;
                gL[tid] = __expf(ip); gL[64 + tid] = sigmoidf_(fp); }
            __syncthreads();
            { const int e = tid & 127, tg = tid >> 7; float aq[16], ak[16];
#pragma unroll
              for (int i = 0; i < 16; ++i) { aq[i] = 0.f; ak[i] = 0.f; }
              const float* wq = F_w_mq + (size_t)h * 128 * 128 + e; const float* wk = F_w_mk + (size_t)h * 128 * 128 + e;
              for (int d = 0; d < 128; ++d) { const float a = wq[d * 128], bb = wk[d * 128];
#pragma unroll
                  for (int i = 0; i < 16; ++i) { const float uu = ucL[(tg * 16 + i) * 128 + d]; aq[i] += uu * a; ak[i] += uu * bb; } }
#pragma unroll
              for (int i = 0; i < 16; ++i) { qL[(tg * 16 + i) * 128 + e] = aq[i]; kL[(tg * 16 + i) * 128 + e] = ak[i] * 0.08838834764831845f; } }
            __syncthreads();
            for (int t = 0; t < 64; ++t) {
                const float f = gL[64 + t], ii = gL[t], vv = vL[t * 128 + v] * ii;
                float num = 0.f, den = 0.f;
#pragma unroll
                for (int j4 = 0; j4 < 8; ++j4) { const f32x4 kk = *(const LAS f32x4*)(kL + t * 128 + j4 * 16 + kq * 4); const f32x4 qq = *(const LAS f32x4*)(qL + t * 128 + j4 * 16 + kq * 4);
#pragma unroll
                    for (int i = 0; i < 4; ++i) { const int j = j4 * 4 + i; C[j] = f * C[j] + vv * kk[i]; nst[j] = f * nst[j] + ii * kk[i]; num += C[j] * qq[i]; den += nst[j] * qq[i]; } }
                num += __shfl_xor(num, 1); num += __shfl_xor(num, 2);
                den += __shfl_xor(den, 1); den += __shfl_xor(den, 2);
                if (kq == 0) ucL[t * 128 + v] = num / fmaxf(fabsf(den), 1.0f);
            }
            __syncthreads();
            for (int t = wave; t < 64; t += 8) { const float a0 = ucL[t * 128 + 2 * lane], a1 = ucL[t * 128 + 2 * lane + 1];
                const float mu = wave_sum(a0 + a1) * (1.0f / 128.0f); const float d0 = a0 - mu, d1 = a1 - mu;
                const float var = wave_sum(d0 * d0 + d1 * d1) * (1.0f / 128.0f); const float rs = 1.0f / sqrtf(var + LN_EPS);
                const int ch = h * 128 + 2 * lane; const unsigned zp = *(const unsigned*)(F_projb + (size_t)(tok0 + t) * NPROJ + C_Z + ch);
                const float o0 = sigmoidf_(bflo(zp)) * d0 * rs * F_m_norm_g[ch], o1 = sigmoidf_(bfhi(zp)) * d1 * rs * F_m_norm_g[ch + 1];
                *(unsigned*)(F_mix + (size_t)(tok0 + t) * DM + 512 + ch) = pk2(o0, o1); }
        }
        __syncthreads();
    }
}

__device__ __forceinline__ void p3_attn(const Args& args, Frame& F) {
    const int tid = F.tid, lane = F.lane, wave = F.wave;
    LAS int* selL = (LAS int*)(F.lds);
    LAS int* nselL = (LAS int*)(F.lds + 1024);
    LAS float* qlat = (LAS float*)(F.lds + 2048);
    LAS float* lg = (LAS float*)(F.lds + 8192);
    LAS float* olat = (LAS float*)(F.lds + 16384);
    LAS unsigned char* csel = F.lds + 32768;
    constexpr int CROW = 272;
    for (int tok = F.bid; tok < T; tok += F.G) {
        const int b = tok >> 11, t = tok & 2047, ci = t >> 6, ntl = ci + 1;
        __syncthreads();
#pragma unroll
        for (int oo = 0; oo < 2; ++oo) { const int o = tid * 2 + oo, h = o >> 7; const float* w = F_w_uk + (size_t)o * 64; const u32x4* qp = (const u32x4*)(F_projb + (size_t)tok * NPROJ + C_QA + h * 64);
            float a = 0.f;
#pragma unroll
            for (int c = 0; c < 8; ++c) { const u32x4 p = qp[c]; const f32x4 w0 = *(const f32x4*)(w + 8 * c), w1 = *(const f32x4*)(w + 8 * c + 4);
                a += bflo(p.x) * w0.x + bfhi(p.x) * w0.y + bflo(p.y) * w0.z + bfhi(p.y) * w0.w + bflo(p.z) * w1.x + bfhi(p.z) * w1.y + bflo(p.w) * w1.z + bfhi(p.w) * w1.w; }
            qlat[o] = a * 0.125f; }
        if (wave == 0) { int base = 0;
            for (int j = 0; j < ntl; ++j) { const unsigned long long m = (unsigned long long)F_mask[(size_t)tok * 64 + 2 * j] | ((unsigned long long)F_mask[(size_t)tok * 64 + 2 * j + 1] << 32);
                if ((m >> lane) & 1ull) { const int pos = base + __popcll(m & ((1ull << lane) - 1ull)); if (pos < 256) selL[pos] = j * 64 + lane; }
                base += __popcll(m); }
            if (lane == 0) nselL[0] = base < 256 ? base : 256; }
        __syncthreads();
        const int nsel = nselL[0];
        for (int idx = tid; idx < 256 * 16; idx += NTHR) { const int j = idx >> 4, c = idx & 15;
            if (j < nsel) { const u32x4 p = *(const u32x4*)(F_cb + (size_t)(b * SEQ + selL[j]) * 128 + 8 * c); *(LAS u32x4*)(csel + j * CROW + 16 * c) = p; } }
        __syncthreads();
        { const int j = tid & 255, hg = tid >> 8; float a[4] = {0.f, 0.f, 0.f, 0.f};
          if (j < nsel) {
#pragma unroll
              for (int c = 0; c < 16; ++c) { const u32x4 p = *(const LAS u32x4*)(csel + j * CROW + 16 * c);
                  const float cv[8] = {bflo(p.x), bfhi(p.x), bflo(p.y), bfhi(p.y), bflo(p.z), bfhi(p.z), bflo(p.w), bfhi(p.w)};
#pragma unroll
                  for (int hh = 0; hh < 4; ++hh) { const LAS float* q = qlat + (hg * 4 + hh) * 128 + 8 * c;
#pragma unroll
                      for (int i = 0; i < 8; ++i) a[hh] += q[i] * cv[i]; } }
              const float dist = fabsf((float)(t - selL[j]));
#pragma unroll
              for (int hh = 0; hh < 4; ++hh) { const int h = hg * 4 + hh; const float slope = exp2f(-(float)(h + 1)); lg[h * 256 + j] = a[hh] - slope * dist; }
          } else {
#pragma unroll
              for (int hh = 0; hh < 4; ++hh) lg[(hg * 4 + hh) * 256 + j] = -INFINITY;
          } }
        __syncthreads();
        { float v[4]; float mx = -INFINITY;
#pragma unroll
          for (int i = 0; i < 4; ++i) { v[i] = lg[wave * 256 + lane + 64 * i]; mx = fmaxf(mx, v[i]); }
          mx = wave_max(mx); float s = 0.f;
#pragma unroll
          for (int i = 0; i < 4; ++i) { v[i] = __expf(v[i] - mx); s += v[i]; }
          s = wave_sum(s); const float inv = 1.0f / s;
#pragma unroll
          for (int i = 0; i < 4; ++i) lg[wave * 256 + lane + 64 * i] = v[i] * inv; }
        __syncthreads();
        { const int r = tid & 127, hg = tid >> 7; float a0 = 0.f, a1 = 0.f;
          for (int j = 0; j < nsel; ++j) { const float cv = bf2f(*(const LAS bf16_t*)(csel + j * CROW + 2 * r)); a0 += lg[(hg * 2) * 256 + j] * cv; a1 += lg[(hg * 2 + 1) * 256 + j] * cv; }
          olat[(hg * 2) * 128 + r] = a0; olat[(hg * 2 + 1) * 128 + r] = a1; }
        __syncthreads();
        { const int h = tid >> 6, d = tid & 63; const float* w = F_w_uv + (size_t)h * 128 * 64 + d; float a = 0.f;
#pragma unroll 8
          for (int r = 0; r < 128; ++r) a += olat[h * 128 + r] * w[r * 64];
          F_mix[(size_t)tok * DM + tid] = (bf16_t)f2bf(a); }
    }
}


__device__ __forceinline__ void p2_indexer_mfma(const Args& args, Frame& F) {
    const int lane = F.lane, wave = F.wave, tid = F.tid;
    {
        const int gw = F.bid * NWAVES + wave, NGW = F.G * NWAVES;
        for (int i = gw; i < NB * 256; i += NGW) { const int b = i >> 8, t = i & 255, ci = t >> 6; const int tok = b * SEQ + t;
            F_mask[(size_t)tok * 64 + lane] = (lane < 2 * (ci + 1)) ? 0xffffffffu : 0u; }
    }
    constexpr int KROW = 144;
    LAS unsigned char* kbuf = F.lds;
    const int c16 = lane & 15, q4 = lane >> 4, half = lane >> 5;
    const int nitems = NB * 28 * 4;
    LAS int* qslot = (LAS int*)(F.lds + 32768);
    for (;;) {
        __syncthreads();
        if (tid == 0) qslot[0] = (int)atomicAdd(F_ctl + CW_Q, 1u);
        __syncthreads();
        const int item = qslot[0];
        if (item >= nitems) break;
        const int r = item >> 7, q = item & 127; const int ci = 31 - r, b = q >> 2, g = q & 3; const int nch = ci + 1;
        const int tok0 = b * SEQ + ci * 64 + g * 16 + wave * 2;
        const bf16_t* kbase = F_projb + (size_t)(b * SEQ) * NPROJ + C_KI;
        const bf16_t* qp = F_projb + (size_t)(tok0 + (c16 >> 3)) * NPROJ + C_QI + (c16 & 7) * 64 + q4 * 8;
        const bf16x8 a0 = *(const bf16x8*)qp, a1 = *(const bf16x8*)(qp + 32);
        float wv[4];
#pragma unroll
        for (int i = 0; i < 4; ++i) wv[i] = F_g32[(size_t)(tok0 + (q4 >> 1)) * 16 + 4 * (q4 & 1) + i];
        __syncthreads();
        { const u32x4 k0 = *(const u32x4*)(kbase + (size_t)(tid >> 3) * NPROJ + (tid & 7) * 8); *(LAS u32x4*)(kbuf + (tid >> 3) * KROW + (tid & 7) * 16) = k0; }
        __syncthreads();
        unsigned u[64];
#pragma unroll
        for (int c = 0; c < 32; ++c) {
            u[2 * c] = 0u; u[2 * c + 1] = 0u;
            if (c < nch) {
                u32x4 kn;
                if (c + 1 < nch) kn = *(const u32x4*)(kbase + (size_t)((c + 1) * 64 + (tid >> 3)) * NPROJ + (tid & 7) * 8);
                const LAS unsigned char* kb = kbuf + (c & 1) * (64 * KROW);
#pragma unroll
                for (int pr = 0; pr < 2; ++pr) {
                    f32x4 acc0 = {0.f, 0.f, 0.f, 0.f}, acc1 = {0.f, 0.f, 0.f, 0.f};
                    const LAS unsigned char* k0p = kb + ((2 * pr) * 16 + c16) * KROW + q4 * 16;
                    const LAS unsigned char* k1p = kb + ((2 * pr + 1) * 16 + c16) * KROW + q4 * 16;
                    acc0 = __builtin_amdgcn_mfma_f32_16x16x32_bf16(a0, *(const LAS bf16x8*)k0p, acc0, 0, 0, 0);
                    acc0 = __builtin_amdgcn_mfma_f32_16x16x32_bf16(a1, *(const LAS bf16x8*)(k0p + 64), acc0, 0, 0, 0);
                    acc1 = __builtin_amdgcn_mfma_f32_16x16x32_bf16(a0, *(const LAS bf16x8*)k1p, acc1, 0, 0, 0);
                    acc1 = __builtin_amdgcn_mfma_f32_16x16x32_bf16(a1, *(const LAS bf16x8*)(k1p + 64), acc1, 0, 0, 0);
                    float p0 = 0.f, p1 = 0.f;
#pragma unroll
                    for (int i = 0; i < 4; ++i) { p0 += wv[i] * fmaxf(acc0[i], 0.f); p1 += wv[i] * fmaxf(acc1[i], 0.f); }
                    p0 += __shfl_xor(p0, 16); p1 += __shfl_xor(p1, 16);
                    const float sc = ((q4 & 1) ? p1 : p0) + 0.0f;
                    const unsigned bts = __builtin_bit_cast(unsigned, sc);
                    u[2 * c + pr] = (bts & 0x80000000u) ? ~bts : (bts | 0x80000000u);
                }
                if (c + 1 < nch) *(LAS u32x4*)(kbuf + ((c + 1) & 1) * (64 * KROW) + (tid >> 3) * KROW + (tid & 7) * 16) = kn;
                __syncthreads();
            }
        }
        unsigned thr = 0u;
        for (int bit = 31; bit >= 0; --bit) {
            const unsigned cand = thr | (1u << bit); int c0 = 0, c1 = 0;
#pragma unroll
            for (int j = 0; j < 64; ++j) { const unsigned long long m = __ballot(u[j] >= cand); c0 += __popc((unsigned)m); c1 += __popc((unsigned)(m >> 32)); }
            const int cm = half ? c1 : c0;
            if (cm >= KSEL) thr = cand;
            if (c0 == KSEL && c1 == KSEL) break;
        }
        int g0 = 0, g1 = 0;
#pragma unroll
        for (int j = 0; j < 64; ++j) { const unsigned long long m = __ballot(u[j] > thr); g0 += __popc((unsigned)m); g1 += __popc((unsigned)(m >> 32)); }
        const int need = KSEL - (half ? g1 : g0);
        int e0 = 0, e1 = 0;
        const unsigned lt32 = (1u << (lane & 31)) - 1u;
#pragma unroll
        for (int j = 0; j < 64; ++j) {
            const unsigned long long eqm = __ballot(u[j] == thr);
            const unsigned myeq = half ? (unsigned)(eqm >> 32) : (unsigned)eqm;
            const int rk = (half ? e1 : e0) + __popc(myeq & lt32);
            const bool sel = (u[j] > thr) || (u[j] == thr && rk < need);
            const unsigned long long sm = __ballot(sel);
            e0 += __popc((unsigned)eqm); e1 += __popc((unsigned)(eqm >> 32));
            if ((lane & 31) == 0) F_mask[(size_t)(tok0 + half) * 64 + j] = half ? (unsigned)(sm >> 32) : (unsigned)sm;
        }
    }
}

namespace at {
typedef short s16x4 __attribute__((ext_vector_type(4)));
typedef float f32x16 __attribute__((ext_vector_type(16)));
constexpr int SHM_V = 64 * 128 * 2, SHM_K = SHM_V;
constexpr float THRN = 8.0f;
#define AT_KSWZ(row, colB) ((row) * 256 + ((colB) ^ (((row) & 7) << 4)))
#define AT_SBAR() __builtin_amdgcn_sched_barrier(0)
__device__ __forceinline__ unsigned cvtpk(float lo, float hi) { return cvtpk_c(lo, hi); }
#define AT_PK4(P, BASE, OUT) do { unsigned a0_ = cvtpk_c(P[BASE + 0], P[BASE + 1]), a1_ = cvtpk_c(P[BASE + 2], P[BASE + 3]);   \
    unsigned b0_ = cvtpk_c(P[BASE + 4], P[BASE + 5]), b1_ = cvtpk_c(P[BASE + 6], P[BASE + 7]);                              \
    auto r0_ = __builtin_amdgcn_permlane32_swap(a0_, b0_, false, false); auto r1_ = __builtin_amdgcn_permlane32_swap(a1_, b1_, false, false); \
    u32x4 w_ = {r0_[0], r1_[0], r0_[1], r1_[1]}; OUT = *reinterpret_cast<bf16x8*>(&w_); } while (0)
__device__ __forceinline__ void mask_bias(f32x16& p0, f32x16& p1, unsigned w0, unsigned w1, float dq, float nslope, int hi) {
    const unsigned w0s = w0 >> (4 * hi), w1s = w1 >> (4 * hi);
#pragma unroll
    for (int r = 0; r < 16; ++r) { const int kb = (r & 3) + 8 * (r >> 2);
        const float v0 = fmaf(nslope, fabsf(dq - (float)kb), p0[r]), v1 = fmaf(nslope, fabsf(dq - (float)(32 + kb)), p1[r]);
        p0[r] = ((w0s >> kb) & 1u) ? v0 : -INFINITY; p1[r] = ((w1s >> kb) & 1u) ? v1 : -INFINITY; }
}
__device__ __forceinline__ void partialSM(f32x16& p0, f32x16& p1, float& m_reg, float& mn, float& alpha) {
    constexpr float C = 1.4426950408889634f;
    float pmax = p0[0];
#pragma unroll
    for (int r = 1; r < 16; ++r) pmax = fmaxf(pmax, p0[r]);
#pragma unroll
    for (int r = 0; r < 16; ++r) pmax = fmaxf(pmax, p1[r]);
    { auto rr = __builtin_amdgcn_permlane32_swap(__float_as_uint(pmax), __float_as_uint(pmax), false, false); pmax = fmaxf(__uint_as_float(rr[0]), __uint_as_float(rr[1])); }
    if (__builtin_expect(__all(pmax - m_reg <= THRN), 1)) { mn = m_reg; alpha = 1.f; }
    else { mn = fmaxf(m_reg, pmax); alpha = __builtin_amdgcn_exp2f((m_reg - mn) * C); m_reg = mn; }
    const float mnC = -mn * C;
#pragma unroll
    for (int r = 0; r < 16; ++r) p0[r] = fmaf(p0[r], C, mnC);
#pragma unroll
    for (int r = 0; r < 16; ++r) p1[r] = fmaf(p1[r], C, mnC);
#pragma unroll
    for (int r = 0; r < 16; ++r) p0[r] = __builtin_amdgcn_exp2f(p0[r]);
}
__device__ __forceinline__ void finishSM(f32x16& p0, f32x16& p1, float alpha, float& l_reg, bf16x8& pa0, bf16x8& pa1, bf16x8& pa2, bf16x8& pa3) {
#pragma unroll
    for (int r = 0; r < 16; ++r) p1[r] = __builtin_amdgcn_exp2f(p1[r]);
    float ps = 0;
#pragma unroll
    for (int r = 0; r < 16; ++r) ps += p0[r];
#pragma unroll
    for (int r = 0; r < 16; ++r) ps += p1[r];
    { auto rr = __builtin_amdgcn_permlane32_swap(__float_as_uint(ps), __float_as_uint(ps), false, false); ps = __uint_as_float(rr[0]) + __uint_as_float(rr[1]); }
    l_reg = l_reg * alpha + ps;
    AT_PK4(p0, 0, pa0); AT_PK4(p0, 8, pa1); AT_PK4(p1, 0, pa2); AT_PK4(p1, 8, pa3);
}
__device__ __forceinline__ void qkt(f32x16& p0, f32x16& p1, const LAS unsigned char* Ks, const bf16x8* qr, int r32, int hi) {
    p0 = f32x16{}; p1 = f32x16{};
#pragma unroll
    for (int d0 = 0; d0 < 8; ++d0) { const int cb = (d0 * 16 + hi * 8) * 2;
        const bf16x8 b0 = *(const LAS bf16x8*)(Ks + AT_KSWZ(r32, cb));
        const bf16x8 b1 = *(const LAS bf16x8*)(Ks + AT_KSWZ(32 + r32, cb));
        p0 = __builtin_amdgcn_mfma_f32_32x32x16_bf16(b0, qr[d0], p0, 0, 0, 0);
        p1 = __builtin_amdgcn_mfma_f32_32x32x16_bf16(b1, qr[d0], p1, 0, 0, 0); }
}
__device__ __forceinline__ int v_st(int k, int c) { const int kk = (k & ~0xC) | ((k & 4) << 1) | ((k & 8) >> 1); return ((kk >> 3) * 4 + (c >> 5)) * 512 + ((kk & 7) * 32 + (c & 31)) * 2; }
__device__ __forceinline__ int v_rd_base(int lane) { return ((lane & 3) << 3) | (((lane >> 2) & 3) << 6) | (((lane >> 4) & 1) << 5) | (((lane >> 5) & 1) << 8); }
constexpr int v_rd_off(int d0, int ks, int half) { return d0 * 512 + ks * 4096 + half * 2048; }
template <int OFF> __device__ __forceinline__ s16x4 tr_read(int vb) { s16x4 r; asm volatile("ds_read_b64_tr_b16 %0, %1 offset:%2" : "=&v"(r) : "v"(vb), "i"(OFF) : "memory"); return r; }
template <int D0> __device__ __forceinline__ void pv_one(f32x16& od, int vb, bf16x8 pa0, bf16x8 pa1, bf16x8 pa2, bf16x8 pa3) {
    const s16x4 l0 = tr_read<v_rd_off(D0, 0, 0)>(vb), h0 = tr_read<v_rd_off(D0, 0, 1)>(vb), l1 = tr_read<v_rd_off(D0, 1, 0)>(vb), h1 = tr_read<v_rd_off(D0, 1, 1)>(vb);
    const s16x4 l2 = tr_read<v_rd_off(D0, 2, 0)>(vb), h2 = tr_read<v_rd_off(D0, 2, 1)>(vb), l3 = tr_read<v_rd_off(D0, 3, 0)>(vb), h3 = tr_read<v_rd_off(D0, 3, 1)>(vb);
    asm volatile("s_waitcnt lgkmcnt(0)" ::: "memory"); AT_SBAR();
#define AT_PK(L, H) (bf16x8){L[0], L[1], L[2], L[3], H[0], H[1], H[2], H[3]}
    od = __builtin_amdgcn_mfma_f32_32x32x16_bf16(AT_PK(l0, h0), pa0, od, 0, 0, 0);
    od = __builtin_amdgcn_mfma_f32_32x32x16_bf16(AT_PK(l1, h1), pa1, od, 0, 0, 0);
    od = __builtin_amdgcn_mfma_f32_32x32x16_bf16(AT_PK(l2, h2), pa2, od, 0, 0, 0);
    od = __builtin_amdgcn_mfma_f32_32x32x16_bf16(AT_PK(l3, h3), pa3, od, 0, 0, 0);
#undef AT_PK
}
__device__ __forceinline__ void pv_d0(f32x16* o, int vb, bf16x8 pa0, bf16x8 pa1, bf16x8 pa2, bf16x8 pa3) {
    pv_one<0>(o[0], vb, pa0, pa1, pa2, pa3); pv_one<1>(o[1], vb, pa0, pa1, pa2, pa3); pv_one<2>(o[2], vb, pa0, pa1, pa2, pa3); pv_one<3>(o[3], vb, pa0, pa1, pa2, pa3);
}

__device__ __forceinline__ void unit(const bf16_t* __restrict__ projb, const bf16_t* __restrict__ cbp, const unsigned* __restrict__ maskp, const bf16_t* __restrict__ wukb,
                                     const bf16_t* __restrict__ wuvf, bf16_t* __restrict__ mix, int b, int ci, int hf, LAS unsigned char* lds, int wave_id) {
    int lane_ = my_lane(); asm volatile("" : "+v"(lane_));
    const int wid = wave_id, lane = lane_, tid = wid * 64 + lane;
    const int r32 = lane & 31, hi = lane >> 5;
    LAS unsigned char* V_lds = lds; LAS unsigned char* K_lds = lds + 2 * SHM_V;
    const int NT = ci + 1, NTp = (NT + 1) & ~1;
    const int tq = ci * 64 + hf * 32 + r32;
    const int tokq = b * SEQ + tq;
    const bf16_t* Kg = cbp + (size_t)b * SEQ * 128;
    const unsigned* mrow = maskp + (size_t)tokq * 64;
    const float nslope = -__builtin_amdgcn_exp2f(-(float)(wid + 1));
    bf16x8 qr[8];
    { bf16x8 qa[4];
      const bf16_t* qap = projb + (size_t)tokq * NPROJ + C_QA + wid * 64 + hi * 8;
#pragma unroll
      for (int ks = 0; ks < 4; ++ks) qa[ks] = *(const bf16x8*)(qap + 16 * ks);
      const bf16_t* wp = wukb + (size_t)wid * 128 * 64 + (size_t)r32 * 64 + hi * 8;
#pragma unroll
      for (int rt = 0; rt < 4; ++rt) { f32x16 x = f32x16{};
#pragma unroll
          for (int ks = 0; ks < 4; ++ks) { const bf16x8 wf = *(const bf16x8*)(wp + (size_t)rt * 32 * 64 + 16 * ks); x = __builtin_amdgcn_mfma_f32_32x32x16_bf16(wf, qa[ks], x, 0, 0, 0); }
          AT_PK4(x, 0, qr[2 * rt]); AT_PK4(x, 8, qr[2 * rt + 1]); } }
    float m_reg = -1e30f, l_reg = 0.f; f32x16 o[4] = {};
    const int sr = tid >> 4, sc = (tid & 15) * 8, vst0 = v_st(sr, sc), vst1 = v_st(32 + sr, sc);
    const int vb0 = (int)(uintptr_t)V_lds + v_rd_base(lane);
    struct { bf16x8 ks0, ks1; u32x2 mw; } sr_[2];
#define AT_TILE(t) ((t) < NT ? (t) : NT - 1)
#define AT_SLOAD(i, t) do { const int k0_ = AT_TILE(t) * 64; sr_[i].ks0 = *(const bf16x8*)(Kg + (size_t)(k0_ + sr) * 128 + sc); sr_[i].ks1 = *(const bf16x8*)(Kg + (size_t)(k0_ + 32 + sr) * 128 + sc); \
    sr_[i].mw = ((t) < NT) ? *(const u32x2*)(mrow + 2 * (t)) : (u32x2){0u, 0u}; } while (0)
#define AT_SWRITE(bb, i) do { *(LAS bf16x8*)(V_lds + (bb) * SHM_V + vst0) = sr_[i].ks0; *(LAS bf16x8*)(V_lds + (bb) * SHM_V + vst1) = sr_[i].ks1; const int kc_ = sc * 2; \
    *(LAS bf16x8*)(K_lds + (bb) * SHM_K + AT_KSWZ(sr, kc_)) = sr_[i].ks0; *(LAS bf16x8*)(K_lds + (bb) * SHM_K + AT_KSWZ(32 + sr, kc_)) = sr_[i].ks1; } while (0)
#define AT_SWAIT() asm volatile("s_waitcnt vmcnt(3)" ::: "memory")
#define AT_RESC(a) do { if (__any((a) < 1.f)) { _Pragma("unroll") for (int d = 0; d < 4; ++d) _Pragma("unroll") for (int r = 0; r < 16; ++r) o[d][r] *= (a); } } while (0)
#define AT_DQ(t) ((float)(tq - 64 * (t) - 4 * hi))
    f32x16 pA0, pA1, pB0, pB1; float mnA, mnB, alA, alB; bf16x8 pa0, pa1, pa2, pa3;
    u32x2 mwc;
    constexpr int SE = 0, SO = 1;
    __syncthreads();
    AT_SLOAD(SE, 0); asm volatile("s_waitcnt vmcnt(0)" ::: "memory"); AT_SWRITE(0, SE); mwc = sr_[SE].mw; __syncthreads();
    qkt(pA0, pA1, K_lds, qr, r32, hi); mask_bias(pA0, pA1, mwc.x, mwc.y, AT_DQ(0), nslope, hi); partialSM(pA0, pA1, m_reg, mnA, alA);
    AT_SLOAD(SO, 1); if (2 < NTp) AT_SLOAD(SE, 2);
    if (2 < NTp) AT_SWAIT(); else asm volatile("s_waitcnt vmcnt(0)" ::: "memory");
    AT_SWRITE(1, SO); __syncthreads();
    for (int j = 1; j + 1 < NTp; j += 2) {
        AT_SBAR(); qkt(pB0, pB1, K_lds + SHM_K, qr, r32, hi); mwc = sr_[SO].mw; mask_bias(pB0, pB1, mwc.x, mwc.y, AT_DQ(j), nslope, hi);
        finishSM(pA0, pA1, alA, l_reg, pa0, pa1, pa2, pa3); AT_SBAR();
        AT_SLOAD(SO, j + 2); AT_SBAR();
        pv_d0(o, vb0, pa0, pa1, pa2, pa3); partialSM(pB0, pB1, m_reg, mnB, alB);
        __syncthreads(); AT_SWAIT(); AT_SWRITE(0, SE);
        AT_RESC(alB); __syncthreads();
        AT_SBAR(); qkt(pA0, pA1, K_lds, qr, r32, hi); mwc = sr_[SE].mw; mask_bias(pA0, pA1, mwc.x, mwc.y, AT_DQ(j + 1), nslope, hi);
        finishSM(pB0, pB1, alB, l_reg, pa0, pa1, pa2, pa3); AT_SBAR();
        if (j + 3 < NTp) AT_SLOAD(SE, j + 3); AT_SBAR();
        pv_d0(o, vb0 + SHM_V, pa0, pa1, pa2, pa3); partialSM(pA0, pA1, m_reg, mnA, alA);
        __syncthreads(); if (j + 3 < NTp) AT_SWAIT(); else asm volatile("s_waitcnt vmcnt(0)" ::: "memory");
        AT_SWRITE(1, SO);
        AT_RESC(alA); __syncthreads();
    }
    AT_SBAR(); qkt(pB0, pB1, K_lds + SHM_K, qr, r32, hi); mwc = sr_[SO].mw; mask_bias(pB0, pB1, mwc.x, mwc.y, AT_DQ(NTp - 1), nslope, hi);
    finishSM(pA0, pA1, alA, l_reg, pa0, pa1, pa2, pa3); AT_SBAR();
    pv_d0(o, vb0, pa0, pa1, pa2, pa3); partialSM(pB0, pB1, m_reg, mnB, alB);
    AT_RESC(alB);
    finishSM(pB0, pB1, alB, l_reg, pa0, pa1, pa2, pa3); AT_SBAR();
    pv_d0(o, vb0 + SHM_V, pa0, pa1, pa2, pa3);
    const float inv = 1.0f / l_reg;
    f32x16 oa[2] = {f32x16{}, f32x16{}};
    const bf16_t* wf = wuvf + (size_t)wid * 8192 + (size_t)lane * 8;
#pragma unroll
    for (int d0 = 0; d0 < 4; ++d0)
#pragma unroll
        for (int sx = 0; sx < 2; ++sx) { u32x4 w; w.x = cvtpk(o[d0][8 * sx + 0] * inv, o[d0][8 * sx + 1] * inv); w.y = cvtpk(o[d0][8 * sx + 2] * inv, o[d0][8 * sx + 3] * inv);
            w.z = cvtpk(o[d0][8 * sx + 4] * inv, o[d0][8 * sx + 5] * inv); w.w = cvtpk(o[d0][8 * sx + 6] * inv, o[d0][8 * sx + 7] * inv);
            const bf16x8 bfrag = *reinterpret_cast<bf16x8*>(&w);
#pragma unroll
            for (int dt = 0; dt < 2; ++dt) { const bf16x8 af = *(const bf16x8*)(wf + (size_t)((dt * 4 + d0) * 2 + sx) * 512); oa[dt] = __builtin_amdgcn_mfma_f32_32x32x16_bf16(af, bfrag, oa[dt], 0, 0, 0); } }
    bf16_t* op = mix + (size_t)tokq * DM + wid * 64 + 4 * hi;
#pragma unroll
    for (int dt = 0; dt < 2; ++dt)
#pragma unroll
        for (int g = 0; g < 4; ++g) { u32x2 w; w.x = cvtpk(oa[dt][4 * g], oa[dt][4 * g + 1]); w.y = cvtpk(oa[dt][4 * g + 2], oa[dt][4 * g + 3]); *(u32x2*)(op + 32 * dt + 8 * g) = w; }
#undef AT_TILE
#undef AT_SLOAD
#undef AT_SWRITE
#undef AT_SWAIT
#undef AT_RESC
#undef AT_DQ
}
}
__device__ __forceinline__ void p3_attn_mfma(const Args& args, Frame& F) {
    for (int u = F.bid; u < 2048; u += F.G) {
        const int k = u >> 8, q = u & 255; const int b = q >> 3, hf = (q >> 2) & 1, g = q & 3; const int p = 4 * (k >> 1) + g; const int ci = (k & 1) ? p : 31 - p;
        at::unit(F_projb, F_cb, F_mask, F_wukb, F_wuvf, F_mix, b, ci, hf, F.lds, F.wave);
    }
    __syncthreads();
}


namespace ml {
using at::f32x16; using at::s16x4;
constexpr int L_UC = 0, L_Q = 16384, L_K = 32768, L_WK = 49152, L_V = 65536, L_CB = 81920, L_HC2 = 114688, L_SM = 131072, L_NV = L_SM + 2 * 5 * 256;
__device__ __forceinline__ int hc_off(int t, int col) { return (t < 32 ? L_UC + t * 512 : L_HC2 + (t - 32) * 512) + (((col + 4 * t) & 127) << 2); }
static_assert(L_NV + 512 <= LDS_BYTES, "mLSTM LDS map");
#define ML_PK(L, H) (bf16x8){L[0], L[1], L[2], L[3], H[0], H[1], H[2], H[3]}
__device__ __forceinline__ void stream(const Args& args, int b, int h, LAS unsigned char* lds, int wave_id) {
    int lane_ = my_lane(); asm volatile("" : "+v"(lane_));
    const int wid = wave_id, lane = lane_, tid = wid * 64 + lane;
    const int r32 = lane & 31, hi = lane >> 5;
    const int tt = wid >> 2, vt = wid & 3, mat = wid >> 2, et = wid & 3, kt0 = 2 * (wid >> 2);
    f32x16 C0 = f32x16{}, C1 = f32x16{};
    LAS float* NV = (LAS float*)(lds + L_NV);
    __syncthreads();
    for (int i = tid; i < 32768 / 16; i += NTHR) *(LAS u32x4*)(lds + L_CB + 16 * i) = (u32x4){0u, 0u, 0u, 0u};
    if (tid < 128) NV[tid] = 0.f;
    float m_prev = -1e30f;
    const float bi = F_b_i[h], bfv = F_b_f[h];
    for (int c = 0; c < NCH; ++c) {
        const int tok0 = b * SEQ + c * CHK;
        int lx = lane; asm volatile("" : "+v"(lx));
        const int r32 = lx & 31, hi = lx >> 5, tid = wid * 64 + lx;
        const int t_ld = tid >> 3, d0_ld = (tid & 7) * 16, ch_ld = h * 128 + d0_ld;
        const int vbV = (int)(uintptr_t)(lds + L_V) + at::v_rd_base(lx) + vt * 512;
        const int vbW = (int)(uintptr_t)(lds + L_WK) + at::v_rd_base(lx) + kt0 * 512;
        const bf16_t* WT = (mat ? F_wmkT : F_wmqT) + (size_t)h * 128 * 128 + (size_t)(32 * et + r32) * 128 + hi * 8;
        LAS float* SM = (LAS float*)(lds + L_SM + (c & 1) * 1280);
        { const float ip = F_g32[(size_t)(tok0 + lane) * 16 + 8 + h] + bi, fp = F_g32[(size_t)(tok0 + lane) * 16 + 12 + h] + bfv;
          float bc = fminf(fp, 0.f) - log1pf(__expf(-fabsf(fp)));
#pragma unroll
          for (int o = 1; o < 64; o <<= 1) { const float v = __shfl_up(bc, o); if (lane >= o) bc += v; }
          const float u = ip - bc; float pm = u;
#pragma unroll
          for (int o = 1; o < 64; o <<= 1) { const float v = __shfl_up(pm, o); if (lane >= o) pm = fmaxf(pm, v); }
          const float mm = fmaxf(m_prev, pm); const float mm63 = __shfl(mm, 63), b63 = __shfl(bc, 63);
          if (wid == 0) { SM[lane] = u; SM[64 + lane] = mm; SM[128 + lane] = __expf(m_prev - mm); SM[192 + lane] = __expf(u - mm63); SM[256 + lane] = __expf(-bc - mm); }
          m_prev = b63 + mm63; }
#ifndef ML_NO_A
        { float a[16];
#pragma unroll
          for (int q = 0; q < 4; ++q) { const f32x4 bv = *(const f32x4*)(F_m_conv_b + ch_ld + 4 * q); a[4 * q] = bv.x; a[4 * q + 1] = bv.y; a[4 * q + 2] = bv.z; a[4 * q + 3] = bv.w; }
#pragma unroll
          for (int j = 0; j < 4; ++j) { const int tg = c * CHK + t_ld - 3 + j;
              if (tg >= 0) { const u32x4* up = (const u32x4*)(F_projb + (size_t)(b * SEQ + tg) * NPROJ + C_U + ch_ld); const u32x4 p0 = up[0], p1 = up[1];
                  const float uv[16] = {bflo(p0.x), bfhi(p0.x), bflo(p0.y), bfhi(p0.y), bflo(p0.z), bfhi(p0.z), bflo(p0.w), bfhi(p0.w), bflo(p1.x), bfhi(p1.x), bflo(p1.y), bfhi(p1.y), bflo(p1.z), bfhi(p1.z), bflo(p1.w), bfhi(p1.w)};
                  const float* wp = F_m_conv_w + j * 512 + ch_ld;
#pragma unroll
                  for (int q = 0; q < 4; ++q) { const f32x4 wv = *(const f32x4*)(wp + 4 * q); a[4 * q] += wv.x * uv[4 * q]; a[4 * q + 1] += wv.y * uv[4 * q + 1]; a[4 * q + 2] += wv.z * uv[4 * q + 2]; a[4 * q + 3] += wv.w * uv[4 * q + 3]; } } }
#pragma unroll
          for (int i = 0; i < 16; ++i) a[i] = a[i] * sigmoidf_(a[i]);
          u32x4 w0, w1; w0.x = cvtpk_c(a[0], a[1]); w0.y = cvtpk_c(a[2], a[3]); w0.z = cvtpk_c(a[4], a[5]); w0.w = cvtpk_c(a[6], a[7]);
          w1.x = cvtpk_c(a[8], a[9]); w1.y = cvtpk_c(a[10], a[11]); w1.z = cvtpk_c(a[12], a[13]); w1.w = cvtpk_c(a[14], a[15]);
          *(LAS u32x4*)(lds + L_UC + AT_KSWZ(t_ld, d0_ld * 2)) = w0; *(LAS u32x4*)(lds + L_UC + AT_KSWZ(t_ld, d0_ld * 2 + 16)) = w1;
          const u32x4* vp = (const u32x4*)(F_projb + (size_t)(tok0 + t_ld) * NPROJ + C_V + ch_ld);
          *(LAS u32x4*)(lds + L_V + at::v_st(t_ld, d0_ld)) = vp[0]; *(LAS u32x4*)(lds + L_V + at::v_st(t_ld, d0_ld + 8)) = vp[1]; }
#endif
        __syncthreads();
#ifndef ML_NO_B
        bf16x8 wf[8];
#pragma unroll
        for (int ks = 0; ks < 8; ++ks) wf[ks] = *(const bf16x8*)(WT + 16 * ks);
#pragma unroll
        for (int t2 = 0; t2 < 2; ++t2) { f32x16 x = f32x16{};
#pragma unroll
            for (int ks = 0; ks < 8; ++ks) { const bf16x8 uf = *(const LAS bf16x8*)(lds + L_UC + AT_KSWZ(32 * t2 + r32, (16 * ks + 8 * hi) * 2)); x = __builtin_amdgcn_mfma_f32_32x32x16_bf16(wf[ks], uf, x, 0, 0, 0); }
            const int t = 32 * t2 + r32;
            if (mat == 0) {
#pragma unroll
                for (int g = 0; g < 4; ++g) { const int e = 32 * et + 8 * g + 4 * hi; u32x2 w; w.x = cvtpk_c(x[4 * g], x[4 * g + 1]); w.y = cvtpk_c(x[4 * g + 2], x[4 * g + 3]);
                    *(LAS u32x2*)(lds + L_Q + t * 256 + ((e * 2) ^ ((t & 7) << 4))) = w; }
            } else { const float wu = SM[192 + t];
#pragma unroll
                for (int g = 0; g < 4; ++g) { const int e = 32 * et + 8 * g + 4 * hi; u32x2 w; w.x = cvtpk_c(x[4 * g], x[4 * g + 1]); w.y = cvtpk_c(x[4 * g + 2], x[4 * g + 3]);
                    *(LAS u32x2*)(lds + L_K + t * 256 + ((e * 2) ^ ((t & 7) << 4))) = w;
                    u32x2 w2; w2.x = cvtpk_c(x[4 * g] * wu, x[4 * g + 1] * wu); w2.y = cvtpk_c(x[4 * g + 2] * wu, x[4 * g + 3] * wu);
                    *(LAS u32x2*)(lds + L_WK + at::v_st(t, e)) = w2; }
            } }
#endif
        __syncthreads();
#ifndef ML_NO_C
        {
            const int t = 32 * tt + r32;
            const float mmt = SM[64 + t], wst = SM[128 + t], em = SM[256 + t], decay = SM[128 + 63];
            f32x16 nA = f32x16{}, p0 = f32x16{}, p1 = f32x16{};
            float dS = 0.f;
#pragma unroll
            for (int kh = 0; kh < 2; ++kh) {
                bf16x8 qf[4];
#pragma unroll
                for (int k4 = 0; k4 < 4; ++k4) qf[k4] = *(const LAS bf16x8*)(lds + L_Q + AT_KSWZ(t, (16 * (4 * kh + k4) + 8 * hi) * 2));
#pragma unroll
                for (int k4 = 0; k4 < 4; ++k4) { const int ks = 4 * kh + k4, cb = (16 * ks + 8 * hi) * 2;
                    nA = __builtin_amdgcn_mfma_f32_32x32x16_bf16(*(const LAS bf16x8*)(lds + L_CB + AT_KSWZ(32 * vt + r32, cb)), qf[k4], nA, 0, 0, 0);
                    p0 = __builtin_amdgcn_mfma_f32_32x32x16_bf16(*(const LAS bf16x8*)(lds + L_K + AT_KSWZ(r32, cb)), qf[k4], p0, 0, 0, 0);
                    p1 = __builtin_amdgcn_mfma_f32_32x32x16_bf16(*(const LAS bf16x8*)(lds + L_K + AT_KSWZ(32 + r32, cb)), qf[k4], p1, 0, 0, 0);
                    const f32x4 n0 = *(const LAS f32x4*)(NV + 16 * ks + 8 * hi), n1 = *(const LAS f32x4*)(NV + 16 * ks + 8 * hi + 4); const u32x4 qq = *reinterpret_cast<const u32x4*>(&qf[k4]);
                    dS += n0.x * bflo(qq.x) + n0.y * bfhi(qq.x) + n0.z * bflo(qq.y) + n0.w * bfhi(qq.y) + n1.x * bflo(qq.z) + n1.y * bfhi(qq.z) + n1.z * bflo(qq.w) + n1.w * bfhi(qq.w); }
                AT_SBAR();
            }
            { auto rr = __builtin_amdgcn_permlane32_swap(__float_as_uint(dS), __float_as_uint(dS), false, false); dS = __uint_as_float(rr[0]) + __uint_as_float(rr[1]); }
            float ps = 0.f;
#pragma unroll
            for (int g = 0; g < 4; ++g) { const f32x4 u0 = *(const LAS f32x4*)(SM + 8 * g + 4 * hi), u1 = *(const LAS f32x4*)(SM + 32 + 8 * g + 4 * hi);
#pragma unroll
                for (int i = 0; i < 4; ++i) { const int s0 = 8 * g + 4 * hi + i, r = 4 * g + i;
                    const float w0 = (s0 <= t) ? __expf(u0[i] - mmt) : 0.f, w1 = (32 + s0 <= t) ? __expf(u1[i] - mmt) : 0.f;
                    p0[r] *= w0; p1[r] *= w1; ps += p0[r] + p1[r]; } }
            { auto rr = __builtin_amdgcn_permlane32_swap(__float_as_uint(ps), __float_as_uint(ps), false, false); ps = __uint_as_float(rr[0]) + __uint_as_float(rr[1]); }
            bf16x8 pa0, pa1, pa2, pa3;
            AT_PK4(p0, 0, pa0); AT_PK4(p0, 8, pa1); AT_PK4(p1, 0, pa2); AT_PK4(p1, 8, pa3);
#pragma unroll
            for (int r = 0; r < 16; ++r) nA[r] *= wst;
            const s16x4 l0 = at::tr_read<0>(vbV), h0 = at::tr_read<2048>(vbV), l1 = at::tr_read<4096>(vbV), h1 = at::tr_read<4096 + 2048>(vbV);
            const s16x4 l2 = at::tr_read<8192>(vbV), h2 = at::tr_read<8192 + 2048>(vbV), l3 = at::tr_read<12288>(vbV), h3 = at::tr_read<12288 + 2048>(vbV);
            asm volatile("s_waitcnt lgkmcnt(0)" ::: "memory"); AT_SBAR();
            const bf16x8 vf0 = ML_PK(l0, h0), vf1 = ML_PK(l1, h1), vf2 = ML_PK(l2, h2), vf3 = ML_PK(l3, h3);
            nA = __builtin_amdgcn_mfma_f32_32x32x16_bf16(vf0, pa0, nA, 0, 0, 0); nA = __builtin_amdgcn_mfma_f32_32x32x16_bf16(vf1, pa1, nA, 0, 0, 0);
            nA = __builtin_amdgcn_mfma_f32_32x32x16_bf16(vf2, pa2, nA, 0, 0, 0); nA = __builtin_amdgcn_mfma_f32_32x32x16_bf16(vf3, pa3, nA, 0, 0, 0);
            const float den = ps + wst * dS; const float inv = 1.0f / fmaxf(fabsf(den), em);
#pragma unroll
            for (int g = 0; g < 4; ++g) { f32x4 o; o.x = nA[4 * g] * inv; o.y = nA[4 * g + 1] * inv; o.z = nA[4 * g + 2] * inv; o.w = nA[4 * g + 3] * inv; *(LAS f32x4*)(lds + hc_off(t, 32 * vt + 8 * g + 4 * hi)) = o; }
#pragma unroll
            for (int r = 0; r < 16; ++r) { C0[r] *= decay; C1[r] *= decay; }
            { const s16x4 a0 = at::tr_read<0>(vbW), b0 = at::tr_read<2048>(vbW), a1 = at::tr_read<4096>(vbW), b1 = at::tr_read<4096 + 2048>(vbW);
              const s16x4 a2 = at::tr_read<8192>(vbW), b2 = at::tr_read<8192 + 2048>(vbW), a3 = at::tr_read<12288>(vbW), b3 = at::tr_read<12288 + 2048>(vbW);
              asm volatile("s_waitcnt lgkmcnt(0)" ::: "memory"); AT_SBAR();
              C0 = __builtin_amdgcn_mfma_f32_32x32x16_bf16(vf0, ML_PK(a0, b0), C0, 0, 0, 0); C0 = __builtin_amdgcn_mfma_f32_32x32x16_bf16(vf1, ML_PK(a1, b1), C0, 0, 0, 0);
              C0 = __builtin_amdgcn_mfma_f32_32x32x16_bf16(vf2, ML_PK(a2, b2), C0, 0, 0, 0); C0 = __builtin_amdgcn_mfma_f32_32x32x16_bf16(vf3, ML_PK(a3, b3), C0, 0, 0, 0); }
            { const s16x4 a0 = at::tr_read<512>(vbW), b0 = at::tr_read<512 + 2048>(vbW), a1 = at::tr_read<512 + 4096>(vbW), b1 = at::tr_read<512 + 4096 + 2048>(vbW);
              const s16x4 a2 = at::tr_read<512 + 8192>(vbW), b2 = at::tr_read<512 + 8192 + 2048>(vbW), a3 = at::tr_read<512 + 12288>(vbW), b3 = at::tr_read<512 + 12288 + 2048>(vbW);
              asm volatile("s_waitcnt lgkmcnt(0)" ::: "memory"); AT_SBAR();
              C1 = __builtin_amdgcn_mfma_f32_32x32x16_bf16(vf0, ML_PK(a0, b0), C1, 0, 0, 0); C1 = __builtin_amdgcn_mfma_f32_32x32x16_bf16(vf1, ML_PK(a1, b1), C1, 0, 0, 0);
              C1 = __builtin_amdgcn_mfma_f32_32x32x16_bf16(vf2, ML_PK(a2, b2), C1, 0, 0, 0); C1 = __builtin_amdgcn_mfma_f32_32x32x16_bf16(vf3, ML_PK(a3, b3), C1, 0, 0, 0); }
        }
#endif
        __syncthreads();
        {
#pragma unroll
            for (int r = 0; r < 16; ++r) { const int vv = 32 * vt + (r & 3) + 8 * (r >> 2) + 4 * hi;
                *(LAS bf16_t*)(lds + L_CB + AT_KSWZ(vv, (32 * kt0 + r32) * 2)) = (bf16_t)f2bf(C0[r]); *(LAS bf16_t*)(lds + L_CB + AT_KSWZ(vv, (32 * (kt0 + 1) + r32) * 2)) = (bf16_t)f2bf(C1[r]); }
            if (tid < 128) { const float decay = SM[128 + 63]; float a = decay * NV[tid];
                for (int s2 = 0; s2 < 64; ++s2) a += SM[192 + s2] * bf2f(*(const LAS bf16_t*)(lds + L_K + AT_KSWZ(s2, tid * 2)));
                NV[tid] = a; }
            for (int t = wid; t < 64; t += 8) { const LAS float* hr = (const LAS float*)(lds + hc_off(t, 2 * lx)); const float a0 = hr[0], a1 = hr[1];
                const float mu = wave_sum(a0 + a1) * (1.0f / 128.0f); const float d0 = a0 - mu, d1 = a1 - mu;
                const float var = wave_sum(d0 * d0 + d1 * d1) * (1.0f / 128.0f); const float rs = 1.0f / sqrtf(var + LN_EPS);
                const int ch = h * 128 + 2 * lx; const unsigned zp = *(const unsigned*)(F_projb + (size_t)(tok0 + t) * NPROJ + C_Z + ch);
                const float o0 = sigmoidf_(bflo(zp)) * d0 * rs * F_m_norm_g[ch], o1 = sigmoidf_(bfhi(zp)) * d1 * rs * F_m_norm_g[ch + 1];
                *(unsigned*)(F_mix + (size_t)(tok0 + t) * DM + 512 + ch) = pk2(o0, o1); }
        }
        __syncthreads();
    }
}
#undef ML_PK
}

__device__ __forceinline__ void p5_ln1_router(const Args& args, Frame& F) {
    const int lane = F.lane;
    const int gtid = F.bid * NTHR + F.tid, NT = F.G * NTHR;
    for (int i = gtid; i < NROUND * RCAP; i += NT) F_rtok[i] = -1;
    const int gw = F.bid * NWAVES + F.wave, NGW = F.G * NWAVES;
    f32x4 gv[4], bv[4];
#pragma unroll
    for (int j = 0; j < 4; ++j) { gv[j] = *((const f32x4*)F_ln1_g + lane + 64 * j); bv[j] = *((const f32x4*)F_ln1_b + lane + 64 * j); }
    for (int tok = gw; tok < T; tok += NGW) {
        const f32x4* pr = (const f32x4*)(F_pre1 + (size_t)tok * DM) + lane;
        f32x4 v[4]; float s = 0.f;
#pragma unroll
        for (int j = 0; j < 4; ++j) { v[j] = pr[64 * j]; s += (v[j].x + v[j].y) + (v[j].z + v[j].w); }
        const float mean = wave_sum(s) * (1.0f / DM); float s2 = 0.f;
#pragma unroll
        for (int j = 0; j < 4; ++j) { v[j] = v[j] - mean; s2 += (v[j].x * v[j].x + v[j].y * v[j].y) + (v[j].z * v[j].z + v[j].w * v[j].w); }
        const float rstd = 1.0f / sqrtf(wave_sum(s2) * (1.0f / DM) + LN_EPS);
        u32x2* o = (u32x2*)(F_h1b + (size_t)tok * DM) + lane;
#pragma unroll
        for (int j = 0; j < 4; ++j) { v[j] = v[j] * rstd * gv[j] + bv[j]; u32x2 w; w.x = pk2(v[j].x, v[j].y); w.y = pk2(v[j].z, v[j].w); o[64 * j] = w; }
        float lgt[32];
#pragma unroll
        for (int e = 0; e < 32; ++e) lgt[e] = 0.f;
#pragma unroll
        for (int j = 0; j < 4; ++j)
#pragma unroll
            for (int i = 0; i < 4; ++i) { const int d = 256 * j + 4 * lane + i; const f32x4* wr = (const f32x4*)(F_w_router + (size_t)d * 32); const float hv = v[j][i];
#pragma unroll
                for (int q = 0; q < 8; ++q) { const f32x4 w = wr[q]; lgt[4 * q] += hv * w.x; lgt[4 * q + 1] += hv * w.y; lgt[4 * q + 2] += hv * w.z; lgt[4 * q + 3] += hv * w.w; } }
#pragma unroll
        for (int e = 0; e < 32; ++e) lgt[e] = wave_sum(lgt[e]) + F_b_router[e];
        int te[4]; float tv[4];
#pragma unroll
        for (int k = 0; k < 4; ++k) { float best = -INFINITY; int bi = 0;
#pragma unroll
            for (int e = 0; e < 32; ++e) { const bool taken = (k > 0 && te[0] == e) || (k > 1 && te[1] == e) || (k > 2 && te[2] == e); if (!taken && lgt[e] > best) { best = lgt[e]; bi = e; } }
            te[k] = bi; tv[k] = best; }
        float es[4], sum = 0.f;
#pragma unroll
        for (int k = 0; k < 4; ++k) { es[k] = __expf(tv[k] - tv[0]); sum += es[k]; }
        if (lane == 0) { const float isum = 1.0f / sum;
#pragma unroll
            for (int k = 0; k < 4; ++k) { const int rk = (int)atomicAdd(F_ctl + CW_CNT + k * NEXP + te[k], 1u);
                F_tope[tok * 4 + k] = te[k]; F_gate[tok * 4 + k] = es[k] * isum; F_rank[tok * 4 + k] = rk; } }
    }
}
__device__ __forceinline__ void moe_offsets(const Args& args, Frame& F, LAS int* offs) {
    __syncthreads();
    if (F.tid < NROUND) { int acc = 0; for (int e = 0; e < NEXP; ++e) { offs[F.tid * 33 + e] = acc; const int c = (int)__hip_atomic_load(F_ctl + CW_CNT + F.tid * NEXP + e, __ATOMIC_RELAXED, __HIP_MEMORY_SCOPE_AGENT); acc += (c + 255) & ~255; } offs[F.tid * 33 + NEXP] = acc; }
    __syncthreads();
}
__device__ __forceinline__ void p6_fill(const Args& args, Frame& F, LAS int* offs) {
    const int gtid = F.bid * NTHR + F.tid, NT = F.G * NTHR;
    for (int i = gtid; i < T * 4; i += NT) { const int j = i & 3, tok = i >> 2; const int e = F_tope[i]; const int row = offs[j * 33 + e] + F_rank[i];
        F_rtok[j * RCAP + row] = tok; F_rgate[j * RCAP + row] = F_gate[i]; }
}
__device__ __forceinline__ void p7_gather(const Args& args, Frame& F, LAS int* offs, int rnd) {
    const int gw = F.bid * NWAVES + F.wave, NGW = F.G * NWAVES; const int nrows = offs[rnd * 33 + NEXP];
    for (int r = gw; r < nrows; r += NGW) { int tok = F_rtok[rnd * RCAP + r]; if (tok < 0) tok = 0;
        const u32x4* s = (const u32x4*)(F_h1b + (size_t)tok * DM) + F.lane; u32x4* d = (u32x4*)(F_xg + (size_t)r * DM) + F.lane;
        d[0] = s[0]; d[64] = s[64]; }
}
__device__ __forceinline__ void p9_final(const Args& args, Frame& F) {
    const int lane = F.lane; const int gw = F.bid * NWAVES + F.wave, NGW = F.G * NWAVES;
    f32x4 gv[4], bv[4];
#pragma unroll
    for (int j = 0; j < 4; ++j) { gv[j] = *((const f32x4*)F_ln2_g + lane + 64 * j); bv[j] = *((const f32x4*)F_ln2_b + lane + 64 * j); }
    for (int tok = gw; tok < T; tok += NGW) {
        f32x4* yr = (f32x4*)(F_out + (size_t)tok * DM) + lane; const u32x2* hr = (const u32x2*)(F_h1b + (size_t)tok * DM) + lane;
        f32x4 v[4]; float s = 0.f;
#pragma unroll
        for (int j = 0; j < 4; ++j) { const f32x4 y = yr[64 * j]; const u32x2 hp = hr[64 * j]; v[j].x = DN_ALPHA * bflo(hp.x) + y.x; v[j].y = DN_ALPHA * bfhi(hp.x) + y.y; v[j].z = DN_ALPHA * bflo(hp.y) + y.z; v[j].w = DN_ALPHA * bfhi(hp.y) + y.w;
            s += (v[j].x + v[j].y) + (v[j].z + v[j].w); }
        const float mean = wave_sum(s) * (1.0f / DM); float s2 = 0.f;
#pragma unroll
        for (int j = 0; j < 4; ++j) { v[j] = v[j] - mean; s2 += (v[j].x * v[j].x + v[j].y * v[j].y) + (v[j].z * v[j].z + v[j].w * v[j].w); }
        const float rstd = 1.0f / sqrtf(wave_sum(s2) * (1.0f / DM) + LN_EPS);
#pragma unroll
        for (int j = 0; j < 4; ++j) yr[64 * j] = v[j] * rstd * gv[j] + bv[j];
    }
}

constexpr int PH_P0 = 0, PH_P1 = 1, PH_P2 = 2, PH_P3 = 3, PH_P4 = 4, PH_P5 = 5, PH_P6 = 6, PH_MOE = 7, PH_FINAL = PH_MOE + 3 * NROUND, N_PHASES = PH_FINAL + 1;

template <unsigned MASK>
__global__ void __launch_bounds__(NTHR, 2) mk_fwd(Args args) {
    extern __shared__ __attribute__((aligned(16))) unsigned char lds_raw[];
    cg::grid_group grid = cg::this_grid();
    Frame F;
    F.lds = (LAS unsigned char*)lds_raw;
    F.wave = __builtin_amdgcn_readfirstlane((int)threadIdx.x >> 6); F.lane = my_lane(); F.tid = F.wave * 64 + F.lane; F.G = gridDim.x; F.bid = blockIdx.x;
    LAS int* offs = (LAS int*)(F.lds + LCTL_OFF);
    const int lo = args.ph_lo, hi = args.ph_hi;
#define PH_BIT(k) ((k) < PH_MOE ? (k) : ((k) == PH_FINAL ? 10 : 7 + (((k) - PH_MOE) % 3)))
#define IN(k) (((MASK >> PH_BIT(k)) & 1u) && lo <= (k) && (k) < hi)
#define SEAM(k) do { if (IN(k) && IN((k) + 1)) grid.sync(); F.lane = launder(my_lane()); F.tid = F.wave * 64 + F.lane; } while (0)

    if (IN(PH_P0)) { p0_prologue(args, F); } SEAM(PH_P0);
    if (IN(PH_P1)) { pg8::Gemm g{F_xb, F_WinT, DM, DM, DM}; pg8::StaticOrder S; S.init(T, NPROJ, F.G, F.bid); EpiProj E{F_projb, F_g32};
        pg8::gemm_phase<EpiProj, pg8::StaticOrder>(F.lds, g, S, E, F.wave); } SEAM(PH_P1);
    if (IN(PH_P2)) { p2_cb(args, F);
#ifndef P2_NO_ML
        for (int sidx = F.bid; sidx < NB * 4; sidx += F.G) ml::stream(args, sidx >> 2, sidx & 3, F.lds, F.wave);
#endif
        __syncthreads();
#ifndef P2_NO_IDX
        p2_indexer_mfma(args, F);
#endif
 } SEAM(PH_P2);
    if (IN(PH_P3)) { p3_attn_mfma(args, F); } SEAM(PH_P3);
    if (IN(PH_P4)) { pg8::Gemm g{F_mix, F_WoutT, DM, DM, DM}; pg8::StaticOrder S; S.init(T, DM, F.G, F.bid); EpiOut E{F_x, F_pre1};
        pg8::gemm_phase<EpiOut, pg8::StaticOrder>(F.lds, g, S, E, F.wave); } SEAM(PH_P4);
    if (IN(PH_P5)) { p5_ln1_router(args, F); } SEAM(PH_P5);
    if (IN(PH_P6)) { moe_offsets(args, F, offs); p6_fill(args, F, offs); } SEAM(PH_P6);
#define INM(j) (((MASK >> (7 + (j))) & 1u) && lo <= pa + (j) && pa + (j) < hi)
#define SEAMM(j) do { if (lo <= pa + (j) && pa + (j) + 1 < hi) grid.sync(); F.lane = launder(my_lane()); F.tid = F.wave * 64 + F.lane; } while (0)
#pragma unroll 1
    for (int rnd = 0; rnd < NROUND; ++rnd) {
        const int pa = PH_MOE + 3 * rnd;
        if (INM(0)) { moe_offsets(args, F, offs); p7_gather(args, F, offs, rnd); } SEAMM(0);
        if (INM(1)) { moe_offsets(args, F, offs); pg8::Gemm g{F_xg, F_WguT, DM, DM, DM}; MoeOrder S; S.init(offs + rnd * 33, 8, F.G, F.bid); EpiGU E{F_hb, F_b_gu};
            pg8::gemm_phase<EpiGU, MoeOrder>(F.lds, g, S, E, F.wave); } SEAMM(1);
        if (INM(2)) { moe_offsets(args, F, offs); pg8::Gemm g{F_hb, F_WdT, DM, DM, DM}; MoeOrder S; S.init(offs + rnd * 33, 4, F.G, F.bid);
            EpiDown E{F_out, F_b_down, F_rtok + rnd * RCAP, F_rgate + rnd * RCAP, rnd == 0 ? 1 : 0};
            pg8::gemm_phase<EpiDown, MoeOrder>(F.lds, g, S, E, F.wave); } SEAMM(2);
    }
    if (IN(PH_FINAL)) { p9_final(args, F); }
#undef IN
#undef SEAM
}

extern "C" void kernel_launch(void* const* d_in, const int* in_sizes, int n_in, void* d_out, int out_size, void* d_ws, size_t ws_size, hipStream_t stream) {
    static int grid = 0;
#if MK_ONE_LAUNCH
    void* kfn[1] = {(void*)mk_fwd<0x7ffu>};
    constexpr int NKFN = 1;
#else
    void* kfn[11] = {(void*)mk_fwd<1u << 0>, (void*)mk_fwd<1u << 1>, (void*)mk_fwd<1u << 2>, (void*)mk_fwd<1u << 3>, (void*)mk_fwd<1u << 4>, (void*)mk_fwd<1u << 5>,
                     (void*)mk_fwd<1u << 6>, (void*)mk_fwd<1u << 7>, (void*)mk_fwd<1u << 8>, (void*)mk_fwd<1u << 9>, (void*)mk_fwd<1u << 10>};
    constexpr int NKFN = 11;
#endif
    if (grid == 0) {
        if (n_in != 23 || out_size != T * DM || ws_size < WS_END) { fprintf(stderr, "kernel_launch: unexpected shapes (n_in %d, out %d, ws %zu, need %zu)\n", n_in, out_size, ws_size, (size_t)WS_END); grid = -1; return; }
        int dev = 0, cus = 0, per_cu = 0;
        hipGetDevice(&dev); hipDeviceGetAttribute(&cus, hipDeviceAttributeMultiprocessorCount, dev);
        for (int k = 0; k < NKFN; ++k) {
            if (hipFuncSetAttribute((const void*)kfn[k], hipFuncAttributeMaxDynamicSharedMemorySize, LDS_BYTES) != hipSuccess) { fprintf(stderr, "kernel_launch: hipFuncSetAttribute failed\n"); grid = -1; return; }
            int pc = 0;
            if (hipOccupancyMaxActiveBlocksPerMultiprocessor(&pc, (const void*)kfn[k], NTHR, LDS_BYTES) != hipSuccess || pc < 1) { fprintf(stderr, "kernel_launch: occupancy query says %d for kernel %d\n", pc, k); grid = -1; return; }
            per_cu = pc;
        }
        (void)hipGetLastError();
        grid = cus * 1;
        fprintf(stderr, "kernel_launch: cus %d per_cu %d grid %d\n", cus, per_cu, grid);
    }
    if (grid < 0) return;
    hipMemsetAsync((char*)d_ws + WS_CTL, 0, CTL_BYTES, stream);
    Args a{};
    for (int i = 0; i < 23; ++i) a.in[i] = (const float*)d_in[i];
    a.out = (float*)d_out; a.ws = (unsigned char*)d_ws;
#if MK_ONE_LAUNCH
    a.ph_lo = 0; a.ph_hi = N_PHASES;
    { void* kargs[] = {&a}; hipError_t e = hipLaunchCooperativeKernel((void*)mk_fwd<0x7ffu>, dim3(grid), dim3(NTHR), kargs, LDS_BYTES, stream);
      if (e != hipSuccess) fprintf(stderr, "cooperative launch failed: %s\n", hipGetErrorString(e)); }
#else
    for (int p = 0; p < N_PHASES; ++p) {
        a.ph_lo = p; a.ph_hi = p + 1;
        void* kargs[] = {&a}; hipError_t e = hipLaunchCooperativeKernel(kfn[PH_BIT(p)], dim3(grid), dim3(NTHR), kargs, LDS_BYTES, stream);
        if (e != hipSuccess) { fprintf(stderr, "cooperative launch %d failed: %s\n", p, hipGetErrorString(e)); break; }
    }
#endif
}
```

```cpp
#include <hip/hip_runtime.h>
#include <hip/hip_cooperative_groups.h>
#include <cstdio>
#include <cstdint>
namespace cg = cooperative_groups;

#ifndef MK_ONE_LAUNCH
#define MK_ONE_LAUNCH 1
#endif

#define GAS __attribute__((address_space(1)))
#define LAS __attribute__((address_space(3)))
typedef unsigned short bf16_t;
typedef short bf16x8 __attribute__((ext_vector_type(8)));
typedef float f32x4 __attribute__((ext_vector_type(4)));
typedef float f32x2 __attribute__((ext_vector_type(2)));
typedef unsigned u32x4 __attribute__((ext_vector_type(4)));
typedef unsigned u32x2 __attribute__((ext_vector_type(2)));

constexpr int T = 65536, DM = 1024, NB = 32, SEQ = 2048, CHK = 64, NCH = 32;
constexpr int NPROJ = 2816;
constexpr int C_QA = 0, C_CKV = 512, C_QI = 640, C_KI = 1152, C_U = 1216, C_V = 1728, C_Z = 2240, C_WI = 2752, C_IG = 2760, C_FG = 2764;
constexpr int IN_W = 2768;
constexpr int NEXP = 32, TOPE = 4, NROUND = 1, SPR = TOPE / NROUND;
constexpr int RCAP = SPR * T + NEXP * 256;
constexpr float LN_EPS = 1e-5f;
constexpr float DN_ALPHA = 1.189207115002721f;
constexpr int KSEL = 256;
constexpr float F8_ACT_S = 8.0f, F8_W_S = 128.0f;
constexpr int F8_ACT_E8 = 0x7c7c7c7c, F8_W_E8 = 0x78787878;

constexpr size_t MiB = 1u << 20;
constexpr size_t WS_CTL = 0, CTL_BYTES = 1 * MiB;
constexpr size_t WS_WIN = 1 * MiB;
constexpr size_t WS_WOUT = 7 * MiB;
constexpr size_t WS_WGU = 9 * MiB;
constexpr size_t WS_WD = 137 * MiB;
constexpr size_t WS_XB = 201 * MiB;
constexpr size_t WS_H1B = WS_XB;
constexpr size_t WS_PROJ = 329 * MiB;
constexpr size_t WS_PRE1 = WS_PROJ;
constexpr size_t WS_HB = WS_PROJ;
constexpr size_t WS_Y1 = 601 * MiB;
constexpr size_t WS_G32 = 681 * MiB;
constexpr size_t WS_CB = 685 * MiB;
constexpr size_t WS_MASK = 701 * MiB;
constexpr size_t WS_MIX = 717 * MiB;
constexpr size_t WS_TOPE = 857 * MiB;
constexpr size_t WS_GATE = 858 * MiB;
constexpr size_t WS_RANK = 859 * MiB;
constexpr size_t WS_RTOK = 933 * MiB;
constexpr size_t WS_RGATE = 941 * MiB;
constexpr int RT_STRIDE = T;
constexpr size_t WS_WRF = 868 * MiB + 512 * 1024;
constexpr size_t WS_WUKB = 864 * MiB;
constexpr size_t WS_WUVF = 865 * MiB;
constexpr size_t WS_WMQT = 866 * MiB;
constexpr size_t WS_WMKT = 867 * MiB;
constexpr size_t WS_BCNT = 868 * MiB;
constexpr size_t WS_H1Q = 869 * MiB;
constexpr size_t WS_END = 949 * MiB;
constexpr int CW_CNT = 64;
constexpr int CW_Q = 256;
constexpr int CW_BAR = 4096;

constexpr int RING_BYTES = 131072;
constexpr int LCTL_OFF = RING_BYTES;
constexpr int LDS_BYTES = 147456;
constexpr int NWAVES = 8, NTHR = 512;

__device__ __forceinline__ unsigned f2bf(float f) { unsigned u = __builtin_bit_cast(unsigned, f); return (u + 0x7fffu + ((u >> 16) & 1u)) >> 16; }
__device__ __forceinline__ unsigned pk2(float lo, float hi) { return f2bf(lo) | (f2bf(hi) << 16); }
typedef __bf16 bf16v2_t __attribute__((ext_vector_type(2)));
__device__ __forceinline__ unsigned cvtpk_c(float lo, float hi) { bf16v2_t v = {(__bf16)lo, (__bf16)hi}; return __builtin_bit_cast(unsigned, v); }
__device__ __forceinline__ unsigned f8x4(float a, float b, float c, float d) { int w = __builtin_amdgcn_cvt_pk_fp8_f32(a, b, 0, false); w = __builtin_amdgcn_cvt_pk_fp8_f32(c, d, w, true); return (unsigned)w; }
__device__ __forceinline__ float bf2f(unsigned h) { return __builtin_bit_cast(float, h << 16); }
__device__ __forceinline__ float relu_i(float x) { const int b = __builtin_bit_cast(int, x); return __builtin_bit_cast(float, b < 0 ? 0 : b); }
__device__ __forceinline__ float bflo(unsigned p) { return __builtin_bit_cast(float, p << 16); }
__device__ __forceinline__ float bfhi(unsigned p) { return __builtin_bit_cast(float, p & 0xffff0000u); }
template <int CTRL, int RM = 0xF> __device__ __forceinline__ float dppf(float old, float v) { return __builtin_bit_cast(float, __builtin_amdgcn_update_dpp(__builtin_bit_cast(int, old), __builtin_bit_cast(int, v), CTRL, RM, 0xF, false)); }
template <int CTRL, int RM = 0xF> __device__ __forceinline__ int dppi(int old, int v) { return __builtin_amdgcn_update_dpp(old, v, CTRL, RM, 0xF, false); }
__device__ __forceinline__ float rl(float v, int l) { return __builtin_bit_cast(float, __builtin_amdgcn_readlane(__builtin_bit_cast(int, v), l)); }
__device__ __forceinline__ float row_sum(float v) { v += dppf<0xB1>(v, v); v += dppf<0x4E>(v, v); v += dppf<0x141>(v, v); v += dppf<0x140>(v, v); return v; }
__device__ __forceinline__ float wave_sum(float v) { v = row_sum(v); return (rl(v, 0) + rl(v, 16)) + (rl(v, 32) + rl(v, 48)); }
__device__ __forceinline__ float wave_max(float v) {
    v = fmaxf(v, dppf<0xB1>(v, v)); v = fmaxf(v, dppf<0x4E>(v, v)); v = fmaxf(v, dppf<0x141>(v, v)); v = fmaxf(v, dppf<0x140>(v, v));
    return fmaxf(fmaxf(rl(v, 0), rl(v, 16)), fmaxf(rl(v, 32), rl(v, 48))); }
__device__ __forceinline__ int wave_min_i(int v) {
    v = min(v, dppi<0xB1>(v, v)); v = min(v, dppi<0x4E>(v, v)); v = min(v, dppi<0x141>(v, v)); v = min(v, dppi<0x140>(v, v));
    return min(min(__builtin_amdgcn_readlane(v, 0), __builtin_amdgcn_readlane(v, 16)), min(__builtin_amdgcn_readlane(v, 32), __builtin_amdgcn_readlane(v, 48))); }
__device__ __forceinline__ int half_sum_i(int v, int lane) { v += dppi<0xB1>(v, v); v += dppi<0x4E>(v, v); v += dppi<0x141>(v, v); v += dppi<0x140>(v, v);
    const int lo = __builtin_amdgcn_readlane(v, 0) + __builtin_amdgcn_readlane(v, 16), hi = __builtin_amdgcn_readlane(v, 32) + __builtin_amdgcn_readlane(v, 48); return (lane & 32) ? hi : lo; }
__device__ __forceinline__ unsigned half_max_u(unsigned v, int lane) { v = max(v, (unsigned)dppi<0xB1>((int)v, (int)v)); v = max(v, (unsigned)dppi<0x4E>((int)v, (int)v)); v = max(v, (unsigned)dppi<0x141>((int)v, (int)v)); v = max(v, (unsigned)dppi<0x140>((int)v, (int)v));
    const unsigned lo = max((unsigned)__builtin_amdgcn_readlane((int)v, 0), (unsigned)__builtin_amdgcn_readlane((int)v, 16)), hi = max((unsigned)__builtin_amdgcn_readlane((int)v, 32), (unsigned)__builtin_amdgcn_readlane((int)v, 48)); return (lane & 32) ? hi : lo; }
#ifndef DPP_SCAN
#define DPP_SCAN 1
#endif
#ifndef DPP_XCHG
#define DPP_XCHG 1
#endif
#if !DPP_SCAN
__device__ __forceinline__ float scan_add(float v) { const int ln = (int)__builtin_amdgcn_mbcnt_hi(~0u, __builtin_amdgcn_mbcnt_lo(~0u, 0u)); _Pragma("unroll") for (int o = 1; o < 64; o <<= 1) { const float t = __shfl_up(v, o); if (ln >= o) v += t; } return v; }
__device__ __forceinline__ float scan_max(float v) { const int ln = (int)__builtin_amdgcn_mbcnt_hi(~0u, __builtin_amdgcn_mbcnt_lo(~0u, 0u)); _Pragma("unroll") for (int o = 1; o < 64; o <<= 1) { const float t = __shfl_up(v, o); if (ln >= o) v = fmaxf(v, t); } return v; }
#else
__device__ __forceinline__ float scan_add(float v) { v += dppf<0x111>(0.f, v); v += dppf<0x112>(0.f, v); v += dppf<0x114>(0.f, v); v += dppf<0x118>(0.f, v); v += dppf<0x142, 0xA>(0.f, v); v += dppf<0x143, 0xC>(0.f, v); return v; }
__device__ __forceinline__ float scan_max(float v) { const float ni = -INFINITY;
    v = fmaxf(v, dppf<0x111>(ni, v)); v = fmaxf(v, dppf<0x112>(ni, v)); v = fmaxf(v, dppf<0x114>(ni, v)); v = fmaxf(v, dppf<0x118>(ni, v)); v = fmaxf(v, dppf<0x142, 0xA>(ni, v)); v = fmaxf(v, dppf<0x143, 0xC>(ni, v)); return v; }
#endif
template <int M> __device__ __forceinline__ float xchg(float v, int lane) {
#if !DPP_XCHG
    return __shfl_xor(v, M);
#endif
    if (M == 1) return dppf<0xB1>(v, v); if (M == 2) return dppf<0x4E>(v, v); if (M == 8) return dppf<0x128>(v, v);
    const float a = dppf<0x114>(v, v), b = dppf<0x104>(v, v); return (lane & 4) ? a : b; }
__device__ __forceinline__ int my_lane() { return (int)__builtin_amdgcn_mbcnt_hi(~0u, __builtin_amdgcn_mbcnt_lo(~0u, 0u)); }
__device__ __forceinline__ int launder(int v) { asm volatile("" : "+v"(v)); return v; }
__device__ __forceinline__ float sigmoidf_(float x) { return __builtin_amdgcn_rcpf(1.0f + __expf(-x)); }

namespace pg8 {
typedef int v4i_t __attribute__((ext_vector_type(4)));
typedef int v8i_t __attribute__((ext_vector_type(8)));
constexpr int BM = 256, BK = 64, HALF = 128, HTB = HALF * BK * 2, STAGE_BYTES = 8 * HTB, NXCD = 8, WGM = 8;
__host__ __device__ __forceinline__ int lds_byte(int r, int c) { const int st = (r >> 4) * 2 + (c >> 5), rr = r & 15, cc = c & 31, ob = rr * 64 + cc * 2; return st * 1024 + (ob ^ (((ob >> 9) & 1) << 5)); }
__host__ __device__ __forceinline__ void stage_rc(int b, int& R, int& C) { const int st = b / 1024, sb = b % 1024, swz = sb ^ (((sb >> 9) & 1) << 5); R = (st >> 1) * 16 + swz / 64; C = (st & 1) * 32 + (swz % 64) / 2; }
__host__ __device__ __forceinline__ int perm32(int rho) { const int n = rho >> 4, i = rho & 15; return 8 * (i >> 2) + 4 * n + (i & 3); }

struct Unit { int pm, pn, po, pe, pr; };
struct Gemm { const void* A; const void* Bt; int pa, pb, kb; const int* rtok; };

struct StaticOrder {
    int nM, nN, nwg, G, c;
    __device__ void init(int M, int N, int G_, int c_) { nM = M / BM; nN = N / BM; nwg = nM * nN; G = G_; c = c_; }
    __device__ bool next(int i, Unit& u) const {
        const long L = (long)i * G + c; if (L >= nwg) return false;
        int wgid = (int)L; { const int q = nwg / NXCD, r = nwg % NXCD, xcd = wgid % NXCD, off = wgid / NXCD; wgid = (xcd < r ? xcd * (q + 1) : r * (q + 1) + (xcd - r) * q) + off; }
        const int nig = WGM * nN, gid = wgid / nig, fm = gid * WGM, gsz = (nM - fm) < WGM ? (nM - fm) : WGM;
        u.pm = fm + ((wgid % nig) % gsz); u.pn = (wgid % nig) / gsz; u.po = u.pn; u.pe = 0; return true;
    }
};

__device__ __forceinline__ unsigned cvt_pk_bf16(float lo, float hi) { return cvtpk_c(lo, hi); }

template <class Epi, class Sched, bool GATHER = false, bool FP8 = false>
__device__ __forceinline__ void gemm_phase(LAS unsigned char* lds, const Gemm g, const Sched& S, const Epi& E, int wave_id) {
    int lane_ = my_lane(); asm volatile("" : "+v"(lane_));
    const int wid = wave_id, lane = lane_, tid = wid * 64 + lane;
    const int wr = wid >> 2, wc = wid & 3, fr = lane & 15, fq = lane >> 4;
    const int nt = g.kb / (BK * 2);
    unsigned voffB[2]; int RA[2], CA[2];
#pragma unroll
    for (int i = 0; i < 2; ++i) { int R, C; stage_rc(tid * 16 + i * 8192, R, C); const int Rb = Epi::PERM == 2 ? (64 * (R >> 5) + 16 * ((R >> 2) & 3) + 4 * ((R >> 4) & 1) + (R & 3)) : Epi::PERM ? ((R & ~31) + perm32(R & 31)) : R;
        RA[i] = R; CA[i] = C; voffB[i] = (unsigned)(Rb * g.pb + C * 2); }
    unsigned cvo[2][2], nvo[2][2];
#define PG8_SETVO(vo, u) do { _Pragma("unroll") for (int h_ = 0; h_ < 2; ++h_) _Pragma("unroll") for (int i_ = 0; i_ < 2; ++i_) { \
        if (GATHER) { int tk_ = g.rtok[(u).pr + h_ * 128 + RA[i_]]; tk_ = tk_ < 0 ? 0 : (tk_ & 0xffff); vo[h_][i_] = (unsigned)(tk_ * g.pa + CA[i_] * 2); } \
        else vo[h_][i_] = (unsigned)((h_ * 128 + RA[i_]) * g.pa + CA[i_] * 2); } } while (0)
    const unsigned kstep = (unsigned)(BK * 2);
    const unsigned hstepB = (Epi::PERM == 2 ? 8u : (unsigned)HALF) * g.pb;
    const unsigned tstepA = GATHER ? 0u : 2u * HALF * g.pa, tstepB = 2u * HALF * g.pb;
    const auto rsA = __builtin_amdgcn_make_buffer_rsrc((void*)g.A, 0, -1, 0x00020000);
    const auto rsB = __builtin_amdgcn_make_buffer_rsrc((void*)g.Bt, 0, -1, 0x00020000);
    const unsigned ldsw = (unsigned)wid * 1024u;
    const int aoff = lds_byte(wr * 64 + fr, fq * 8), boff = lds_byte(wc * 32 + fr, fq * 8);
#define PG8_SA(b, h) (((b) * 2 + (h)) * HTB)
#define PG8_SB(b, h) ((4 + (b) * 2 + (h)) * HTB)
#define PG8_STAGEA(bufoff, soff, voff) do { _Pragma("unroll") for (int _i = 0; _i < 2; ++_i) \
        __builtin_amdgcn_raw_ptr_buffer_load_lds(rsA, (LAS unsigned*)(lds + (bufoff) + ldsw + _i * 8192), 16, (voff)[_i], (soff), 0, 0); } while (0)
#define PG8_STAGEB(bufoff, soff, voff) do { _Pragma("unroll") for (int _i = 0; _i < 2; ++_i) \
        __builtin_amdgcn_raw_ptr_buffer_load_lds(rsB, (LAS unsigned*)(lds + (bufoff) + ldsw + _i * 8192), 16, (voff)[_i], (soff), 0, 0); } while (0)
#define PG8_LD8(p) __builtin_shufflevector(*(const LAS v4i_t*)(p), *(const LAS v4i_t*)((p) + 1024), 0, 1, 2, 3, 4, 5, 6, 7)
#define PG8_LDA(dst, b, h) do { _Pragma("unroll") for (int m = 0; m < 4; ++m) dst[m] = PG8_LD8(lds + PG8_SA(b, h) + aoff + m * 2048); } while (0)
#define PG8_LDB(dst, b, h) do { _Pragma("unroll") for (int n = 0; n < 2; ++n) dst[n] = PG8_LD8(lds + PG8_SB(b, h) + boff + n * 2048); } while (0)
#define PG8_LO(X) __builtin_bit_cast(bf16x8, __builtin_shufflevector(X, X, 0, 1, 2, 3))
#define PG8_HI(X) __builtin_bit_cast(bf16x8, __builtin_shufflevector(X, X, 4, 5, 6, 7))
#define PG8_MMA(ai, bj, At, Bt) do { __builtin_amdgcn_s_setprio(1); _Pragma("unroll") for (int m = 0; m < 4; ++m) _Pragma("unroll") for (int n = 0; n < 2; ++n) { \
        if (FP8) acc[ai][bj][m][n] = __builtin_amdgcn_mfma_scale_f32_16x16x128_f8f6f4(Bt[n], At[m], acc[ai][bj][m][n], 0, 0, 0, F8_W_E8, 0, F8_ACT_E8); \
        else { acc[ai][bj][m][n] = __builtin_amdgcn_mfma_f32_16x16x32_bf16(PG8_LO(Bt[n]), PG8_LO(At[m]), acc[ai][bj][m][n], 0, 0, 0); \
               acc[ai][bj][m][n] = __builtin_amdgcn_mfma_f32_16x16x32_bf16(PG8_HI(Bt[n]), PG8_HI(At[m]), acc[ai][bj][m][n], 0, 0, 0); } } \
        __builtin_amdgcn_s_setprio(0); } while (0)
#define PG8_WAIT_V(n) asm volatile("s_waitcnt vmcnt(" #n ")" ::: "memory")
#define PG8_WAIT_L(n) asm volatile("s_waitcnt lgkmcnt(" #n ")" ::: "memory")
#define PG8_BAR __builtin_amdgcn_s_barrier()
#define PG8_SCHED __builtin_amdgcn_sched_barrier(0)
    Unit cur, nxt; int ui = 0;
    if (!S.next(0, cur)) return;
    f32x4 acc[2][2][4][2];
#pragma unroll
    for (int a = 0; a < 2; ++a)
#pragma unroll
        for (int b = 0; b < 2; ++b)
#pragma unroll
            for (int m = 0; m < 4; ++m)
#pragma unroll
                for (int n = 0; n < 2; ++n) acc[a][b][m][n] = (f32x4){0.f, 0.f, 0.f, 0.f};
    v8i_t At[4], B0[2], B1[2];
    unsigned cA = (unsigned)cur.pm * tstepA, cB = (unsigned)cur.pn * tstepB;
    PG8_SETVO(cvo, cur);
    PG8_STAGEB(PG8_SB(0, 0), cB, voffB); PG8_STAGEB(PG8_SB(0, 1), cB + hstepB, voffB); PG8_STAGEA(PG8_SA(0, 0), cA, cvo[0]); PG8_STAGEA(PG8_SA(0, 1), cA, cvo[1]);
    if (wr == 1) PG8_BAR;
    PG8_WAIT_V(2); PG8_BAR;
    PG8_STAGEB(PG8_SB(1, 0), cB + kstep, voffB); PG8_STAGEA(PG8_SA(1, 0), cA + kstep, cvo[0]); PG8_STAGEB(PG8_SB(1, 1), cB + hstepB + kstep, voffB);
    PG8_WAIT_V(6); PG8_BAR;
    for (;;) {
        const bool has_next = S.next(ui + 1, nxt);
        const unsigned nA = has_next ? (unsigned)nxt.pm * tstepA : cA, nB = has_next ? (unsigned)nxt.pn * tstepB : cB;
        if (GATHER) { if (has_next) PG8_SETVO(nvo, nxt); else { _Pragma("unroll") for (int h_ = 0; h_ < 2; ++h_) _Pragma("unroll") for (int i_ = 0; i_ < 2; ++i_) nvo[h_][i_] = cvo[h_][i_]; } }
#pragma unroll 1
        for (int t = 0; t < nt; t += 2) {
            const bool last = (t == nt - 2);
            unsigned v2[2][2];
#pragma unroll
            for (int h_ = 0; h_ < 2; ++h_)
#pragma unroll
                for (int i_ = 0; i_ < 2; ++i_) v2[h_][i_] = (GATHER && last) ? nvo[h_][i_] : cvo[h_][i_];
            const unsigned a1 = cA + (unsigned)(t + 1) * kstep;
            const unsigned a2 = last ? nA : cA + (unsigned)(t + 2) * kstep, b2 = last ? nB : cB + (unsigned)(t + 2) * kstep;
            const unsigned a3 = a2 + kstep, b3 = b2 + kstep;
            PG8_LDB(B0, 0, 0); PG8_LDB(B1, 0, 1); PG8_SCHED; PG8_LDA(At, 0, 0); PG8_STAGEA(PG8_SA(1, 1), a1, cvo[1]);
            PG8_WAIT_V(8); PG8_WAIT_L(0); PG8_BAR; PG8_MMA(0, 0, At, B0); PG8_MMA(0, 1, At, B1); PG8_BAR; PG8_SCHED;
            PG8_LDA(At, 0, 1); PG8_STAGEB(PG8_SB(0, 0), b2, voffB); PG8_STAGEB(PG8_SB(0, 1), b2 + hstepB, voffB); PG8_STAGEA(PG8_SA(0, 0), a2, v2[0]);
            PG8_WAIT_V(8); PG8_WAIT_L(0); PG8_BAR; PG8_MMA(1, 0, At, B0); PG8_MMA(1, 1, At, B1); PG8_BAR; PG8_SCHED;
            PG8_LDB(B0, 1, 0); PG8_LDB(B1, 1, 1); PG8_SCHED; PG8_LDA(At, 1, 0); PG8_STAGEA(PG8_SA(0, 1), a2, v2[1]);
            PG8_WAIT_V(8); PG8_WAIT_L(0); PG8_BAR; PG8_MMA(0, 0, At, B0); PG8_MMA(0, 1, At, B1); PG8_BAR; PG8_SCHED;
            PG8_LDA(At, 1, 1); PG8_STAGEB(PG8_SB(1, 0), b3, voffB); PG8_STAGEB(PG8_SB(1, 1), b3 + hstepB, voffB); PG8_STAGEA(PG8_SA(1, 0), a3, v2[0]);
            PG8_WAIT_V(8); PG8_WAIT_L(0); PG8_BAR; PG8_MMA(1, 0, At, B0); PG8_MMA(1, 1, At, B1); PG8_BAR; PG8_SCHED;
        }
        if (wr == 0) PG8_BAR;
        E(acc, cur, wr, wc, fr, fq);
        if (!has_next) break;
#pragma unroll
        for (int a = 0; a < 2; ++a)
#pragma unroll
            for (int b = 0; b < 2; ++b)
#pragma unroll
                for (int m = 0; m < 4; ++m)
#pragma unroll
                    for (int n = 0; n < 2; ++n) acc[a][b][m][n] = (f32x4){0.f, 0.f, 0.f, 0.f};
        cur = nxt; cA = nA; cB = nB; ++ui;
        if (GATHER) { _Pragma("unroll") for (int h_ = 0; h_ < 2; ++h_) _Pragma("unroll") for (int i_ = 0; i_ < 2; ++i_) cvo[h_][i_] = nvo[h_][i_]; }
        if (wr == 1) PG8_BAR;
    }
    PG8_WAIT_V(0);
    PG8_BAR;
#undef PG8_SETVO
#undef PG8_LD8
#undef PG8_LO
#undef PG8_HI
#undef PG8_SA
#undef PG8_SB
#undef PG8_STAGEA
#undef PG8_STAGEB
#undef PG8_LDA
#undef PG8_LDB
#undef PG8_MMA
#undef PG8_WAIT_V
#undef PG8_WAIT_L
#undef PG8_BAR
#undef PG8_SCHED
}
}

struct Args {
    const float* in[23];
    float* out; unsigned char* ws;
    int ph_lo, ph_hi;
};
struct Frame {
    LAS unsigned char* lds;
    int tid, lane, wave, G, bid;
};
#define F_in(k) (args.in[k])
#define F_x F_in(0)
#define F_w_in F_in(1)
#define F_kv_norm_g F_in(2)
#define F_w_uk F_in(3)
#define F_w_uv F_in(4)
#define F_m_conv_w F_in(5)
#define F_m_conv_b F_in(6)
#define F_w_mq F_in(7)
#define F_w_mk F_in(8)
#define F_b_i F_in(9)
#define F_b_f F_in(10)
#define F_m_norm_g F_in(11)
#define F_w_out F_in(12)
#define F_ln1_g F_in(13)
#define F_ln1_b F_in(14)
#define F_w_router F_in(15)
#define F_b_router F_in(16)
#define F_w_gu F_in(17)
#define F_b_gu F_in(18)
#define F_w_down F_in(19)
#define F_b_down F_in(20)
#define F_ln2_g F_in(21)
#define F_ln2_b F_in(22)
#define F_out (args.out)
#define F_ctl ((unsigned*)(args.ws + WS_CTL))
#define F_WinT ((bf16_t*)(args.ws + WS_WIN))
#define F_WoutT ((bf16_t*)(args.ws + WS_WOUT))
#define F_WguT ((bf16_t*)(args.ws + WS_WGU))
#define F_WdT ((bf16_t*)(args.ws + WS_WD))
#define F_xb ((bf16_t*)(args.ws + WS_XB))
#define F_h1b ((bf16_t*)(args.ws + WS_H1B))
#define F_projb ((bf16_t*)(args.ws + WS_PROJ))
#define F_cb ((bf16_t*)(args.ws + WS_CB))
#define F_mix ((bf16_t*)(args.ws + WS_MIX))
#define F_y1 ((float*)(args.ws + WS_Y1))
#define F_hb ((unsigned char*)(args.ws + WS_HB))
#define F_g32 ((float*)(args.ws + WS_G32))
#define F_pre1 ((float*)(args.ws + WS_PRE1))
#define F_gate ((float*)(args.ws + WS_GATE))
#define F_rgate ((float*)(args.ws + WS_RGATE))
#define F_mask ((unsigned*)(args.ws + WS_MASK))
#define F_tope ((int*)(args.ws + WS_TOPE))
#define F_rank ((int*)(args.ws + WS_RANK))
#define F_rtok ((int*)(args.ws + WS_RTOK))
#define F_wukb ((bf16_t*)(args.ws + WS_WUKB))
#define F_wuvf ((bf16_t*)(args.ws + WS_WUVF))
#define F_wmqT ((bf16_t*)(args.ws + WS_WMQT))
#define F_wmkT ((bf16_t*)(args.ws + WS_WMKT))
#define F_bcnt ((int*)(args.ws + WS_BCNT))
#define F_wrf ((bf16_t*)(args.ws + WS_WRF))
#define F_h1q ((unsigned char*)(args.ws + WS_H1Q))

__device__ __forceinline__ int in_map(int n) {
    if (n < 1216) return n;
    if (n < 2752) return n + 8;
    if (n < 2760) return n - 2752 + 1216;
    if (n < 2768) return n;
    return -1;
}
template <int MODE>
__device__ __forceinline__ void ti_load(float (&r)[32], const float* W, int Norig, int kb, int nb, int lane) {
    const int k0 = 64 * kb, nn = 32 * nb + (lane & 31);
    int oc;
    if (MODE == 0) oc = nn;
    else if (MODE == 1) oc = in_map(nn);
    else { const int pn = nn >> 8, half = (nn >> 7) & 1, i = nn & 127; oc = half * 1024 + pn * 128 + i; }
    const float* src = W + (size_t)(k0 + (lane >> 5)) * Norig + (oc >= 0 ? oc : 0);
#pragma unroll
    for (int i = 0; i < 32; ++i) { const float v = src[(size_t)(2 * i) * Norig]; r[i] = (MODE == 1 && oc < 0) ? 0.f : v; }
}
template <bool OUT8>
__device__ __forceinline__ void ti_store(const float (&r)[32], int K, bf16_t* WT, LAS float* scr, int kb, int nb, int lane) {
    const int k0 = 64 * kb, n0 = 32 * nb;
#pragma unroll
    for (int i = 0; i < 32; ++i) { const int kk = 2 * i + (lane >> 5); scr[kk * 33 + (lane & 31)] = r[i]; }
    asm volatile("s_waitcnt lgkmcnt(0)" ::: "memory");
    const int c = lane & 7;
#pragma unroll
    for (int j = 0; j < 4; ++j) { const int n = (lane >> 3) + 8 * j; const LAS float* s = scr + (8 * c) * 33 + n;
        if (OUT8) { u32x2 o; o.x = f8x4(s[0 * 33] * F8_W_S, s[1 * 33] * F8_W_S, s[2 * 33] * F8_W_S, s[3 * 33] * F8_W_S); o.y = f8x4(s[4 * 33] * F8_W_S, s[5 * 33] * F8_W_S, s[6 * 33] * F8_W_S, s[7 * 33] * F8_W_S);
            *(u32x2*)((unsigned char*)WT + (size_t)(n0 + n) * K + k0 + 8 * c) = o; }
        else { u32x4 o; o.x = pk2(s[0 * 33], s[1 * 33]); o.y = pk2(s[2 * 33], s[3 * 33]); o.z = pk2(s[4 * 33], s[5 * 33]); o.w = pk2(s[6 * 33], s[7 * 33]);
            *(u32x4*)(WT + (size_t)(n0 + n) * K + k0 + 8 * c) = o; } }
    asm volatile("s_waitcnt lgkmcnt(0)" ::: "memory");
}
template <int MODE>
__device__ __forceinline__ void ti8_load(float (&r)[64], const float* W, int Norig, int kb, int nb, int lane) {
    const int k0 = 128 * kb, nn = 32 * nb + (lane & 31);
    int oc;
    if (MODE == 0) oc = nn;
    else { const int pn = nn >> 8, half = (nn >> 7) & 1, i = nn & 127; oc = half * 1024 + pn * 128 + i; }
    const float* src = W + (size_t)(k0 + (lane >> 5)) * Norig + oc;
#pragma unroll
    for (int i = 0; i < 64; ++i) r[i] = src[(size_t)(2 * i) * Norig];
}
__device__ __forceinline__ void ti8_store(const float (&r)[64], int K, unsigned char* WT, LAS float* scr, int kb, int nb, int lane) {
    const int k0 = 128 * kb, n0 = 32 * nb;
#pragma unroll
    for (int i = 0; i < 64; ++i) { const int kk = 2 * i + (lane >> 5); scr[kk * 33 + (lane & 31)] = r[i]; }
    asm volatile("s_waitcnt lgkmcnt(0)" ::: "memory");
    const int c = lane & 15;
#pragma unroll
    for (int j = 0; j < 8; ++j) { const int n = (lane >> 4) + 4 * j; const LAS float* s = scr + (8 * c) * 33 + n;
        u32x2 o; o.x = f8x4(s[0 * 33] * F8_W_S, s[1 * 33] * F8_W_S, s[2 * 33] * F8_W_S, s[3 * 33] * F8_W_S); o.y = f8x4(s[4 * 33] * F8_W_S, s[5 * 33] * F8_W_S, s[6 * 33] * F8_W_S, s[7 * 33] * F8_W_S);
        *(u32x2*)(WT + (size_t)(n0 + n) * K + k0 + 8 * c) = o; }
    asm volatile("s_waitcnt lgkmcnt(0)" ::: "memory");
}
__device__ __forceinline__ void p0_prologue(const Args& args, Frame& F) {
    LAS float* scr = (LAS float*)(F.lds + F.wave * 16896);
    const int gw = F.bid * NWAVES + F.wave, NGW = F.G * NWAVES;
    constexpr int I_IN = 16 * (NPROJ / 32), I_OUT = 16 * 32, I_GU = NEXP * 8 * 64, I_D = NEXP * 8 * 32;
    for (int r = gw; r < I_IN + I_OUT; r += NGW) { float v[32];
        if (r < I_IN) { const int nbk = NPROJ / 32; ti_load<1>(v, F_w_in, IN_W, r / nbk, r % nbk, F.lane); ti_store<false>(v, DM, F_WinT, scr, r / nbk, r % nbk, F.lane); }
        else { const int q = r - I_IN; ti_load<0>(v, F_w_out, DM, q / 32, q % 32, F.lane); ti_store<false>(v, DM, F_WoutT, scr, q / 32, q % 32, F.lane); } }
#define P0_GU_LOAD(R, IT) { const int e_ = (IT) / (8 * 64), q_ = (IT) % (8 * 64); ti8_load<2>(R, F_w_gu + (size_t)e_ * DM * 2048, 2048, q_ / 64, q_ % 64, F.lane); }
#define P0_GU_STORE(R, IT) { const int e_ = (IT) / (8 * 64), q_ = (IT) % (8 * 64); ti8_store(R, DM, (unsigned char*)F_WguT + (size_t)e_ * 2048 * DM, scr, q_ / 64, q_ % 64, F.lane); }
#define P0_D_LOAD(R, IT) { const int e_ = (IT) / (8 * 32), q_ = (IT) % (8 * 32); ti8_load<0>(R, F_w_down + (size_t)e_ * DM * DM, DM, q_ / 32, q_ % 32, F.lane); }
#define P0_D_STORE(R, IT) { const int e_ = (IT) / (8 * 32), q_ = (IT) % (8 * 32); ti8_store(R, DM, (unsigned char*)F_WdT + (size_t)e_ * DM * DM, scr, q_ / 32, q_ % 32, F.lane); }
    { float va[64], vb[64]; int it = gw;
      if (it < I_GU) P0_GU_LOAD(va, it)
#pragma unroll 1
      for (; it < I_GU; it += 2 * NGW) {
          if (it + NGW < I_GU) P0_GU_LOAD(vb, it + NGW)
          P0_GU_STORE(va, it)
          if (it + 2 * NGW < I_GU) P0_GU_LOAD(va, it + 2 * NGW)
          if (it + NGW < I_GU) P0_GU_STORE(vb, it + NGW) } }
    { float va[64], vb[64]; int it = gw;
      if (it < I_D) P0_D_LOAD(va, it)
#pragma unroll 1
      for (; it < I_D; it += 2 * NGW) {
          if (it + NGW < I_D) P0_D_LOAD(vb, it + NGW)
          P0_D_STORE(va, it)
          if (it + 2 * NGW < I_D) P0_D_LOAD(va, it + 2 * NGW)
          if (it + NGW < I_D) P0_D_STORE(vb, it + NGW) } }
#undef P0_GU_LOAD
#undef P0_GU_STORE
#undef P0_D_LOAD
#undef P0_D_STORE
    { const int gtid = F.bid * NTHR + F.tid, NT_ = F.G * NTHR;
      for (int i = gtid; i < 8 * 128 * 64; i += NT_) F_wukb[i] = (bf16_t)f2bf(F_w_uk[i] * 0.125f);
      for (int i = gtid; i < 4 * 128 * 128; i += NT_) { const int d = i & 127, e = (i >> 7) & 127, h = i >> 14;
          F_wmqT[i] = (bf16_t)f2bf(F_w_mq[((size_t)h * 128 + d) * 128 + e]); F_wmkT[i] = (bf16_t)f2bf(F_w_mk[((size_t)h * 128 + d) * 128 + e] * 0.08838834764831845f); }
      for (int i = gtid; i < 8 * 2 * 4 * 2 * 64 * 8; i += NT_) { const int j = i & 7, ln = (i >> 3) & 63, sx = (i >> 9) & 1, d0 = (i >> 10) & 3, dt = (i >> 12) & 1, h = i >> 13;
          const int hi = ln >> 5, r32 = ln & 31; const int lat = 32 * d0 + 16 * sx + 8 * (j >> 2) + 4 * hi + (j & 3), dd = 32 * dt + r32;
          F_wuvf[i] = (bf16_t)f2bf(F_w_uv[((size_t)h * 128 + lat) * 64 + dd]); }
      for (int i = gtid; i < 64 * 64 * 8; i += NT_) { const int j = i & 7, ln = (i >> 3) & 63, ks = i >> 9; const int e = ln & 31, hi = ln >> 5;
          const int d = 64 * (ks >> 2) + 32 * hi + 8 * (ks & 3) + j; const float w = F_w_router[d * NEXP + e]; const unsigned h = f2bf(w);
          F_wrf[i] = (bf16_t)h; F_wrf[32768 + i] = (bf16_t)f2bf(w - __builtin_bit_cast(float, h << 16)); } }
    for (int m = gw; m < T; m += 2 * NGW) {
        const int m2 = (m + NGW < T) ? m + NGW : m;
        const f32x4* xr = (const f32x4*)(F_x + (size_t)m * DM) + F.lane; const f32x4* xr2 = (const f32x4*)(F_x + (size_t)m2 * DM) + F.lane;
        f32x4 v[4], w2[4];
#pragma unroll
        for (int j = 0; j < 4; ++j) { v[j] = xr[64 * j]; w2[j] = xr2[64 * j]; }
        u32x2* o = (u32x2*)(F_xb + (size_t)m * DM) + F.lane; u32x2* o2 = (u32x2*)(F_xb + (size_t)m2 * DM) + F.lane;
#pragma unroll
        for (int j = 0; j < 4; ++j) { u32x2 w; w.x = pk2(v[j].x, v[j].y); w.y = pk2(v[j].z, v[j].w); o[64 * j] = w; }
#pragma unroll
        for (int j = 0; j < 4; ++j) { u32x2 w; w.x = pk2(w2[j].x, w2[j].y); w.y = pk2(w2[j].z, w2[j].w); o2[64 * j] = w; }
    }
}

struct EpiProj {
    static constexpr int PERM = 2;
    bf16_t* O; float* g32;
    __device__ __forceinline__ void operator()(const f32x4 (&acc)[2][2][4][2], const pg8::Unit& u, int wr, int wc, int fr, int fq) const {
        const int row0 = u.pm * 256 + wr * 64 + fr, col0 = u.po * 256 + wc * 64 + 16 * fq;
#pragma unroll
        for (int ai = 0; ai < 2; ++ai)
#pragma unroll
            for (int m = 0; m < 4; ++m) { const int row = row0 + ai * 128 + m * 16;
#pragma unroll
                for (int bj = 0; bj < 2; ++bj) { const f32x4 v0 = acc[ai][bj][m][0], v1 = acc[ai][bj][m][1];
                    u32x4 w; w.x = pg8::cvt_pk_bf16(v0[0], v0[1]); w.y = pg8::cvt_pk_bf16(v0[2], v0[3]); w.z = pg8::cvt_pk_bf16(v1[0], v1[1]); w.w = pg8::cvt_pk_bf16(v1[2], v1[3]);
                    *(u32x4*)(O + (size_t)row * NPROJ + col0 + 8 * bj) = w;
                    if (col0 == C_WI) { float* gp = g32 + (size_t)row * 16 + 8 * bj; *(f32x4*)gp = v0; *(f32x4*)(gp + 4) = v1; } } }
    }
};
struct EpiOut {
    static constexpr int PERM = 2;
    bf16_t* O;
    __device__ __forceinline__ void operator()(const f32x4 (&acc)[2][2][4][2], const pg8::Unit& u, int wr, int wc, int fr, int fq) const {
        const int row0 = u.pm * 256 + wr * 64 + fr, col0 = u.po * 256 + wc * 64 + 16 * fq;
#pragma unroll
        for (int ai = 0; ai < 2; ++ai)
#pragma unroll
            for (int m = 0; m < 4; ++m) { const int row = row0 + ai * 128 + m * 16;
#pragma unroll
                for (int bj = 0; bj < 2; ++bj) { const f32x4 v0 = acc[ai][bj][m][0], v1 = acc[ai][bj][m][1];
                    u32x4 w; w.x = cvtpk_c(v0[0], v0[1]); w.y = cvtpk_c(v0[2], v0[3]); w.z = cvtpk_c(v1[0], v1[1]); w.w = cvtpk_c(v1[2], v1[3]);
                    *(u32x4*)(O + (size_t)row * DM + col0 + 8 * bj) = w; } }
    }
};
struct EpiGU {
    static constexpr int PERM = 1;
    unsigned char* H; const float* b_gu;
    __device__ __forceinline__ u32x2 one(const f32x4 (&acc)[2][2][4][2], int ai, int m, const f32x4 (&bgv)[2], const f32x4 (&buv)[2]) const {
        float hv[8];
#pragma unroll
        for (int n = 0; n < 2; ++n)
#pragma unroll
            for (int i = 0; i < 4; ++i) { float gt = acc[ai][0][m][n][i] + bgv[n][i], up = acc[ai][1][m][n][i] + buv[n][i];
                gt = fminf(gt, 7.0f); up = fminf(fmaxf(up, -7.0f), 7.0f);
                hv[n * 4 + i] = (up + 1.0f) * gt * sigmoidf_(1.702f * gt); }
        u32x2 w; w.x = f8x4(hv[0] * F8_ACT_S, hv[1] * F8_ACT_S, hv[2] * F8_ACT_S, hv[3] * F8_ACT_S); w.y = f8x4(hv[4] * F8_ACT_S, hv[5] * F8_ACT_S, hv[6] * F8_ACT_S, hv[7] * F8_ACT_S);
        return w;
    }
    __device__ __forceinline__ void operator()(const f32x4 (&acc)[2][2][4][2], const pg8::Unit& u, int wr, int wc, int fr, int fq) const {
        const int hc = u.po * 128 + wc * 32 + 8 * fq;
        const float* bg = b_gu + (size_t)u.pe * 2048 + hc;
        f32x4 bgv[2], buv[2];
#pragma unroll
        for (int n = 0; n < 2; ++n) { bgv[n] = *(const f32x4*)(bg + 4 * n); buv[n] = *(const f32x4*)(bg + 1024 + 4 * n); }
        unsigned char* base = H + (size_t)(u.pm * 256 + wr * 64 + fr + 16 * (fq & 1)) * DM + u.po * 128 + wc * 32 + 8 * (fq & 2);
#pragma unroll
        for (int ai = 0; ai < 2; ++ai)
#pragma unroll
            for (int mp = 0; mp < 2; ++mp) { u32x2 a = one(acc, ai, 2 * mp, bgv, buv), b = one(acc, ai, 2 * mp + 1, bgv, buv);
                asm volatile("s_nop 1\n\tv_permlane16_swap_b32 %0, %1" : "+v"(a.x), "+v"(b.x));
                asm volatile("s_nop 1\n\tv_permlane16_swap_b32 %0, %1" : "+v"(a.y), "+v"(b.y));
                *(u32x4*)(base + (size_t)(ai * 128 + mp * 32) * DM) = (u32x4){a.x, a.y, b.x, b.y}; }
    }
};
constexpr float F8_Y_S = 64.0f;
struct EpiDown {
    static constexpr int PERM = 2;
    unsigned char* Y; const float* b_down; const int* rtok; const float* rgate;
    __device__ __forceinline__ void operator()(const f32x4 (&acc)[2][2][4][2], const pg8::Unit& u, int wr, int wc, int fr, int fq) const {
        const int row0 = u.pr + wr * 64 + fr, col0 = u.po * 256 + wc * 64 + 16 * fq;
        const float* bd = b_down + (size_t)u.pe * DM + col0;
        f32x4 bv[2][2];
#pragma unroll
        for (int bj = 0; bj < 2; ++bj)
#pragma unroll
            for (int n = 0; n < 2; ++n) bv[bj][n] = *(const f32x4*)(bd + bj * 8 + 4 * n);
        int tvs[2][4]; float gts[2][4];
#pragma unroll
        for (int ai = 0; ai < 2; ++ai)
#pragma unroll
            for (int m = 0; m < 4; ++m) { tvs[ai][m] = rtok[row0 + ai * 128 + m * 16]; gts[ai][m] = rgate[row0 + ai * 128 + m * 16]; }
#pragma unroll
        for (int ai = 0; ai < 2; ++ai)
#pragma unroll
            for (int m = 0; m < 4; ++m) { const int tv = tvs[ai][m]; const float gt = gts[ai][m] * F8_Y_S;
                if (tv >= 0) { unsigned char* yp = Y + (size_t)(tv & 0xffff) * 4096 + ((tv >> 16) & 3) * 1024 + col0;
                    const f32x4 v0 = (acc[ai][0][m][0] + bv[0][0]) * gt, v1 = (acc[ai][0][m][1] + bv[0][1]) * gt, v2 = (acc[ai][1][m][0] + bv[1][0]) * gt, v3 = (acc[ai][1][m][1] + bv[1][1]) * gt;
                    u32x4 w; w.x = f8x4(v0[0], v0[1], v0[2], v0[3]); w.y = f8x4(v1[0], v1[1], v1[2], v1[3]); w.z = f8x4(v2[0], v2[1], v2[2], v2[3]); w.w = f8x4(v3[0], v3[1], v3[2], v3[3]);
                    *(u32x4*)yp = w; } }
    }
};
struct MoeOrder {
    const LAS int* offs; int npn, G, c, ntiles, xc, cb, bpx;
    __device__ void init(const LAS int* offs_, int npn_, int G_, int c_) { offs = offs_; npn = npn_; G = G_; c = c_; ntiles = offs_[NEXP] >> 8;
        if ((G_ & 7) == 0) { xc = c_ & 7; cb = c_ >> 3; bpx = G_ >> 3; } else { xc = 0; cb = c_; bpx = G_; } }
    __device__ bool next(int i, pg8::Unit& u) const {
        const int k = i * bpx + cb; const int nx = ((G & 7) == 0) ? 8 : 1;
        const int pm = nx * (k / npn) + xc, pnl = k % npn; if (pm >= ntiles) return false;
        int e = 0;
        for (int q = 1; q < NEXP; ++q) e += (offs[q] <= pm * 256) ? 1 : 0;
        u.pm = pm; u.pn = e * npn + pnl; u.po = pnl; u.pe = e; u.pr = e * RT_STRIDE + pm * 256 - offs[e]; return true;
    }
};

__device__ __forceinline__ void p2_cb(const Args& args, Frame& F) {
    const int gw = F.bid * NWAVES + F.wave, NGW = F.G * NWAVES;
    const float g0 = F_kv_norm_g[2 * F.lane], g1 = F_kv_norm_g[2 * F.lane + 1];
    for (int tok = gw; tok < T; tok += NGW) {
        const unsigned p = *(const unsigned*)(F_projb + (size_t)tok * NPROJ + C_CKV + 2 * F.lane);
        const float a = bflo(p), b = bfhi(p);
        const float ss = wave_sum(a * a + b * b);
        const float r = 1.0f / sqrtf(ss * (1.0f / 128.0f) + LN_EPS);
        *(unsigned*)(F_cb + (size_t)tok * 128 + 2 * F.lane) = pk2(a * r * g0, b * r * g1);
    }
}

__device__ __forceinline__ void p2_indexer_mfma(const Args& args, Frame& F, int qsel) {
    const int lane = F.lane, wave = F.wave, tid = F.tid;
    {
        const int gw = F.bid * NWAVES + wave, NGW = F.G * NWAVES;
        for (int i = gw; i < NB * 256; i += NGW) { const int b = i >> 8, t = i & 255, ci = t >> 6; const int tok = b * SEQ + t;
            F_mask[(size_t)tok * 64 + lane] = (lane < 2 * (ci + 1)) ? 0xffffffffu : 0u; }
    }
    LAS unsigned char* kbuf = F.lds;
    const int c16 = lane & 15, q4 = lane >> 4, half = lane >> 5;
    const int nitems = NB * 28 * 4;
    LAS int* qslot = (LAS int*)(F.lds + 65536);
    const int srow = tid >> 3, sp = tid & 7;
    const unsigned svoff = (unsigned)(srow * NPROJ * 2 + ((sp ^ (srow & 7)) << 4));
    for (;;) {
        __syncthreads();
        if (tid == 0) qslot[0] = (int)atomicAdd(F_ctl + CW_Q + 64 * qsel, 1u);
        __syncthreads();
        const int item = qslot[0];
        if (item >= nitems) break;
        const int r = item >> 7, q = item & 127; const int ci = 31 - r, b = q >> 2, g = q & 3; const int nch = ci + 1, nst = (nch + 1) >> 1;
        const int tok0 = b * SEQ + ci * 64 + g * 16 + wave * 2;
        const auto rsK = __builtin_amdgcn_make_buffer_rsrc((void*)(F_projb + (size_t)(b * SEQ) * NPROJ + C_KI), 0, -1, 0x00020000);
#define IDX_ISSUE(cc) do { __builtin_amdgcn_raw_ptr_buffer_load_lds(rsK, (LAS unsigned*)(kbuf + ((cc) & 3) * 16384 + wave * 1024), 16, svoff, (unsigned)((cc) * 128 * NPROJ * 2), 0, 0); \
        __builtin_amdgcn_raw_ptr_buffer_load_lds(rsK, (LAS unsigned*)(kbuf + ((cc) & 3) * 16384 + 8192 + wave * 1024), 16, svoff, (unsigned)(((cc) * 128 + 64) * NPROJ * 2), 0, 0); } while (0)
        const bf16_t* qp = F_projb + (size_t)(tok0 + (c16 >> 3)) * NPROJ + C_QI + (c16 & 7) * 64 + q4 * 8;
        const bf16x8 a0 = *(const bf16x8*)qp, a1 = *(const bf16x8*)(qp + 32);
        float wv[4];
#pragma unroll
        for (int i = 0; i < 4; ++i) wv[i] = F_g32[(size_t)(tok0 + (q4 >> 1)) * 16 + 4 * (q4 & 1) + i];
        asm volatile("s_waitcnt vmcnt(0)" ::: "memory");
        IDX_ISSUE(0); if (1 < nst) IDX_ISSUE(1); if (2 < nst) IDX_ISSUE(2);
        unsigned u[64];
#pragma unroll
        for (int c = 0; c < 16; ++c) {
            u[4 * c] = 0u; u[4 * c + 1] = 0u; u[4 * c + 2] = 0u; u[4 * c + 3] = 0u;
            if (c < nst) {
                if (c + 2 < nst) asm volatile("s_waitcnt vmcnt(4)" ::: "memory"); else if (c + 1 < nst) asm volatile("s_waitcnt vmcnt(2)" ::: "memory"); else asm volatile("s_waitcnt vmcnt(0)" ::: "memory");
                __builtin_amdgcn_s_barrier();
                if (c + 3 < nst) IDX_ISSUE(c + 3);
                const LAS unsigned char* kb = kbuf + (c & 3) * 16384;
                const bool full = (2 * c + 1 < nch);
#pragma unroll
                for (int pr = 0; pr < 4; ++pr) {
                    f32x4 acc0 = {0.f, 0.f, 0.f, 0.f}, acc1 = {0.f, 0.f, 0.f, 0.f};
                    const int r0 = (2 * pr) * 16 + c16, r1 = (2 * pr + 1) * 16 + c16;
                    const LAS unsigned char* k0p = kb + r0 * 128; const LAS unsigned char* k1p = kb + r1 * 128;
                    const int x0 = (r0 & 7), x1 = (r1 & 7);
                    acc0 = __builtin_amdgcn_mfma_f32_16x16x32_bf16(a0, *(const LAS bf16x8*)(k0p + ((q4 ^ x0) << 4)), acc0, 0, 0, 0);
                    acc0 = __builtin_amdgcn_mfma_f32_16x16x32_bf16(a1, *(const LAS bf16x8*)(k0p + (((q4 + 4) ^ x0) << 4)), acc0, 0, 0, 0);
                    acc1 = __builtin_amdgcn_mfma_f32_16x16x32_bf16(a0, *(const LAS bf16x8*)(k1p + ((q4 ^ x1) << 4)), acc1, 0, 0, 0);
                    acc1 = __builtin_amdgcn_mfma_f32_16x16x32_bf16(a1, *(const LAS bf16x8*)(k1p + (((q4 + 4) ^ x1) << 4)), acc1, 0, 0, 0);
                    float p0 = 0.f, p1 = 0.f;
#pragma unroll
                    for (int i = 0; i < 4; ++i) { p0 += wv[i] * relu_i(acc0[i]); p1 += wv[i] * relu_i(acc1[i]); }
                    asm volatile("s_nop 1\n\tv_permlane16_swap_b32 %0, %1" : "+v"(p0), "+v"(p1));
                    const float sc = p0 + p1 + 0.0f;
                    const unsigned bts = __builtin_bit_cast(unsigned, sc);
                    const unsigned key = (bts & 0x80000000u) ? ~bts : (bts | 0x80000000u);
                    u[4 * c + pr] = (pr < 2 || full) ? key : 0u;
                }
            }
        }
#undef IDX_ISSUE
#define IDX_CHAIN(OP) do { OP(0) if (nst <= 1) break; OP(1) if (nst <= 2) break; OP(2) if (nst <= 3) break; OP(3) if (nst <= 4) break; OP(4) if (nst <= 5) break; OP(5) if (nst <= 6) break; \
        OP(6) if (nst <= 7) break; OP(7) if (nst <= 8) break; OP(8) if (nst <= 9) break; OP(9) if (nst <= 10) break; OP(10) if (nst <= 11) break; OP(11) if (nst <= 12) break; \
        OP(12) if (nst <= 13) break; OP(13) if (nst <= 14) break; OP(14) if (nst <= 15) break; OP(15) } while (0)
        unsigned km = 0u;
#define IDX_MAX(c) km = max(max(km, u[4 * (c)]), max(max(u[4 * (c) + 1], u[4 * (c) + 2]), u[4 * (c) + 3]));
        IDX_CHAIN(IDX_MAX);
#undef IDX_MAX
        km = half_max_u(km, lane);
        unsigned thr = 0u; bool done = false;
        for (int bit = 31; bit >= 0; --bit) {
            const unsigned cand = thr | (1u << bit); int cl = 0;
            if (__all(cand > km)) continue;
#define IDX_CNT(c) cl += ((u[4 * (c)] >= cand) ? 1 : 0) + ((u[4 * (c) + 1] >= cand) ? 1 : 0) + ((u[4 * (c) + 2] >= cand) ? 1 : 0) + ((u[4 * (c) + 3] >= cand) ? 1 : 0);
            IDX_CHAIN(IDX_CNT);
#undef IDX_CNT
            cl = half_sum_i(cl, lane);
            if (cl >= KSEL) { thr = cand; done = done || (cl == KSEL); }
            if (__all(done)) break;
        }
        int cge = 0, cgt = 0;
#define IDX_CNT2(c) _Pragma("unroll") for (int j_ = 4 * (c); j_ < 4 * (c) + 4; ++j_) { cge += (u[j_] >= thr) ? 1 : 0; cgt += (u[j_] > thr) ? 1 : 0; }
        IDX_CHAIN(IDX_CNT2);
#undef IDX_CNT2
        cge = half_sum_i(cge, lane); cgt = half_sum_i(cgt, lane);
        int w0 = 0, w1 = 0;
        if (__all(cge == KSEL)) {
#define IDX_SEL(c) _Pragma("unroll") for (int j_ = 4 * (c); j_ < 4 * (c) + 4; ++j_) { const unsigned long long sm = __ballot(u[j_] >= thr); \
            { const bool me_ = (lane == j_); w0 = me_ ? (int)(unsigned)sm : w0; w1 = me_ ? (int)(unsigned)(sm >> 32) : w1; } }
            IDX_CHAIN(IDX_SEL);
#undef IDX_SEL
        } else {
            const int need = KSEL - cgt;
            int e0 = 0, e1 = 0;
            const unsigned lt32 = (1u << (lane & 31)) - 1u;
#pragma unroll
            for (int j = 0; j < 64; ++j) {
                const unsigned long long eqm = __ballot(u[j] == thr);
                const unsigned myeq = half ? (unsigned)(eqm >> 32) : (unsigned)eqm;
                const int rk = (half ? e1 : e0) + __popc(myeq & lt32);
                const bool sel = (u[j] > thr) || (u[j] == thr && rk < need);
                const unsigned long long sm = __ballot(sel);
                e0 += __popc((unsigned)eqm); e1 += __popc((unsigned)(eqm >> 32));
                { const bool me_ = (lane == j); w0 = me_ ? (int)(unsigned)sm : w0; w1 = me_ ? (int)(unsigned)(sm >> 32) : w1; }
            }
        }
        F_mask[(size_t)tok0 * 64 + lane] = (unsigned)w0; F_mask[(size_t)(tok0 + 1) * 64 + lane] = (unsigned)w1;
#undef IDX_CHAIN
    }
}

namespace at {
typedef short s16x4 __attribute__((ext_vector_type(4)));
typedef float f32x16 __attribute__((ext_vector_type(16)));
constexpr int SHM_V = 64 * 128 * 2, SHM_K = SHM_V;
constexpr float THRN = 8.0f;
#define AT_KSWZ(row, colB) ((row) * 256 + ((colB) ^ (((row) & 7) << 4)))
#define AT_SBAR() __builtin_amdgcn_sched_barrier(0)
__device__ __forceinline__ unsigned cvtpk(float lo, float hi) { return cvtpk_c(lo, hi); }
#define AT_PK4(P, BASE, OUT) do { unsigned a0_ = cvtpk_c(P[BASE + 0], P[BASE + 1]), a1_ = cvtpk_c(P[BASE + 2], P[BASE + 3]);   \
    unsigned b0_ = cvtpk_c(P[BASE + 4], P[BASE + 5]), b1_ = cvtpk_c(P[BASE + 6], P[BASE + 7]);                              \
    auto r0_ = __builtin_amdgcn_permlane32_swap(a0_, b0_, false, false); auto r1_ = __builtin_amdgcn_permlane32_swap(a1_, b1_, false, false); \
    u32x4 w_ = {r0_[0], r1_[0], r0_[1], r1_[1]}; OUT = *reinterpret_cast<bf16x8*>(&w_); } while (0)
__device__ __forceinline__ float sel_mask(float v, unsigned ws, int kb) {
    const int mk = __builtin_amdgcn_sbfe((int)ws, kb, 1); return __builtin_bit_cast(float, (__builtin_bit_cast(int, v) & mk) | (~mk & (int)0xff800000)); }
__device__ __forceinline__ void mask_bias(f32x16& p0, f32x16& p1, unsigned w0, unsigned w1, float dq, float nslope, int hi) {
    const unsigned w0s = w0 >> (4 * hi), w1s = w1 >> (4 * hi);
#pragma unroll
    for (int r = 0; r < 16; ++r) { const int kb = (r & 3) + 8 * (r >> 2);
        const float v0 = fmaf(nslope, fabsf(dq - (float)kb), p0[r]), v1 = fmaf(nslope, fabsf(dq - (float)(32 + kb)), p1[r]);
        p0[r] = sel_mask(v0, w0s, kb); p1[r] = sel_mask(v1, w1s, kb); }
}
__device__ __forceinline__ void partialSM(f32x16& p0, f32x16& p1, float& m_reg, float& mn, float& alpha) {
    constexpr float C = 1.4426950408889634f;
    float pmax = p0[0];
#pragma unroll
    for (int r = 1; r < 16; ++r) pmax = fmaxf(pmax, p0[r]);
#pragma unroll
    for (int r = 0; r < 16; ++r) pmax = fmaxf(pmax, p1[r]);
    { auto rr = __builtin_amdgcn_permlane32_swap(__float_as_uint(pmax), __float_as_uint(pmax), false, false); pmax = fmaxf(__uint_as_float(rr[0]), __uint_as_float(rr[1])); }
    if (__builtin_expect(__all(pmax - m_reg <= THRN), 1)) { mn = m_reg; alpha = 1.f; }
    else { mn = fmaxf(m_reg, pmax); alpha = __builtin_amdgcn_exp2f((m_reg - mn) * C); m_reg = mn; }
    const float mnC = -mn * C;
#pragma unroll
    for (int r = 0; r < 16; ++r) p0[r] = fmaf(p0[r], C, mnC);
#pragma unroll
    for (int r = 0; r < 16; ++r) p1[r] = fmaf(p1[r], C, mnC);
#pragma unroll
    for (int r = 0; r < 16; ++r) p0[r] = __builtin_amdgcn_exp2f(p0[r]);
}
__device__ __forceinline__ void finishSM(f32x16& p0, f32x16& p1, float alpha, float& l_reg, bf16x8& pa0, bf16x8& pa1, bf16x8& pa2, bf16x8& pa3) {
#pragma unroll
    for (int r = 0; r < 16; ++r) p1[r] = __builtin_amdgcn_exp2f(p1[r]);
    float ps = 0;
#pragma unroll
    for (int r = 0; r < 16; ++r) ps += p0[r];
#pragma unroll
    for (int r = 0; r < 16; ++r) ps += p1[r];
    { auto rr = __builtin_amdgcn_permlane32_swap(__float_as_uint(ps), __float_as_uint(ps), false, false); ps = __uint_as_float(rr[0]) + __uint_as_float(rr[1]); }
    l_reg = l_reg * alpha + ps;
    AT_PK4(p0, 0, pa0); AT_PK4(p0, 8, pa1); AT_PK4(p1, 0, pa2); AT_PK4(p1, 8, pa3);
}
__device__ __forceinline__ void qkt(f32x16& p0, f32x16& p1, const LAS unsigned char* Ks, const bf16x8* qr, int r32, int hi) {
    p0 = f32x16{}; p1 = f32x16{};
#pragma unroll
    for (int d0 = 0; d0 < 8; ++d0) { const int cb = (d0 * 16 + hi * 8) * 2;
        const bf16x8 b0 = *(const LAS bf16x8*)(Ks + AT_KSWZ(r32, cb));
        const bf16x8 b1 = *(const LAS bf16x8*)(Ks + AT_KSWZ(32 + r32, cb));
        p0 = __builtin_amdgcn_mfma_f32_32x32x16_bf16(b0, qr[d0], p0, 0, 0, 0);
        p1 = __builtin_amdgcn_mfma_f32_32x32x16_bf16(b1, qr[d0], p1, 0, 0, 0); }
}
__device__ __forceinline__ int v_st(int k, int c) { const int kk = (k & ~0xC) | ((k & 4) << 1) | ((k & 8) >> 1); return ((kk >> 3) * 4 + (c >> 5)) * 512 + ((kk & 7) * 32 + (c & 31)) * 2; }
__device__ __forceinline__ int v_rd_base(int lane) { return ((lane & 3) << 3) | (((lane >> 2) & 3) << 6) | (((lane >> 4) & 1) << 5) | (((lane >> 5) & 1) << 8); }
constexpr int v_rd_off(int d0, int ks, int half) { return d0 * 512 + ks * 4096 + half * 2048; }
template <int OFF> __device__ __forceinline__ s16x4 tr_read(int vb) { s16x4 r; asm volatile("ds_read_b64_tr_b16 %0, %1 offset:%2" : "=&v"(r) : "v"(vb), "i"(OFF) : "memory"); return r; }
template <int D0> __device__ __forceinline__ void pv_one(f32x16& od, int vb, bf16x8 pa0, bf16x8 pa1, bf16x8 pa2, bf16x8 pa3) {
    const s16x4 l0 = tr_read<v_rd_off(D0, 0, 0)>(vb), h0 = tr_read<v_rd_off(D0, 0, 1)>(vb), l1 = tr_read<v_rd_off(D0, 1, 0)>(vb), h1 = tr_read<v_rd_off(D0, 1, 1)>(vb);
    const s16x4 l2 = tr_read<v_rd_off(D0, 2, 0)>(vb), h2 = tr_read<v_rd_off(D0, 2, 1)>(vb), l3 = tr_read<v_rd_off(D0, 3, 0)>(vb), h3 = tr_read<v_rd_off(D0, 3, 1)>(vb);
    asm volatile("s_waitcnt lgkmcnt(0)" ::: "memory"); AT_SBAR();
#define AT_PK(L, H) (bf16x8){L[0], L[1], L[2], L[3], H[0], H[1], H[2], H[3]}
    od = __builtin_amdgcn_mfma_f32_32x32x16_bf16(AT_PK(l0, h0), pa0, od, 0, 0, 0);
    od = __builtin_amdgcn_mfma_f32_32x32x16_bf16(AT_PK(l1, h1), pa1, od, 0, 0, 0);
    od = __builtin_amdgcn_mfma_f32_32x32x16_bf16(AT_PK(l2, h2), pa2, od, 0, 0, 0);
    od = __builtin_amdgcn_mfma_f32_32x32x16_bf16(AT_PK(l3, h3), pa3, od, 0, 0, 0);
#undef AT_PK
}
__device__ __forceinline__ void pv_d0(f32x16* o, int vb, bf16x8 pa0, bf16x8 pa1, bf16x8 pa2, bf16x8 pa3) {
    pv_one<0>(o[0], vb, pa0, pa1, pa2, pa3); pv_one<1>(o[1], vb, pa0, pa1, pa2, pa3); pv_one<2>(o[2], vb, pa0, pa1, pa2, pa3); pv_one<3>(o[3], vb, pa0, pa1, pa2, pa3);
}

__device__ __forceinline__ void unit(const bf16_t* __restrict__ projb, const bf16_t* __restrict__ cbp, const unsigned* __restrict__ maskp, const bf16_t* __restrict__ wukb,
                                     const bf16_t* __restrict__ wuvf, bf16_t* __restrict__ mix, int b, int ci, int hf, LAS unsigned char* lds, int wave_id) {
    int lane_ = my_lane(); asm volatile("" : "+v"(lane_));
    const int wid = wave_id, lane = lane_, tid = wid * 64 + lane;
    const int r32 = lane & 31, hi = lane >> 5;
    LAS unsigned char* V_lds = lds; LAS unsigned char* K_lds = lds + 2 * SHM_V;
    const int NT = ci + 1, NTp = (NT + 1) & ~1;
    const int tq = ci * 64 + hf * 32 + r32;
    const int tokq = b * SEQ + tq;
    const bf16_t* Kg = cbp + (size_t)b * SEQ * 128;
    const unsigned* mrow = maskp + (size_t)tokq * 64;
    const float nslope = -__builtin_amdgcn_exp2f(-(float)(wid + 1));
    bf16x8 qr[8];
    { bf16x8 qa[4];
      const bf16_t* qap = projb + (size_t)tokq * NPROJ + C_QA + wid * 64 + hi * 8;
#pragma unroll
      for (int ks = 0; ks < 4; ++ks) qa[ks] = *(const bf16x8*)(qap + 16 * ks);
      const bf16_t* wp = wukb + (size_t)wid * 128 * 64 + (size_t)r32 * 64 + hi * 8;
#pragma unroll
      for (int rt = 0; rt < 4; ++rt) { f32x16 x = f32x16{};
#pragma unroll
          for (int ks = 0; ks < 4; ++ks) { const bf16x8 wf = *(const bf16x8*)(wp + (size_t)rt * 32 * 64 + 16 * ks); x = __builtin_amdgcn_mfma_f32_32x32x16_bf16(wf, qa[ks], x, 0, 0, 0); }
          AT_PK4(x, 0, qr[2 * rt]); AT_PK4(x, 8, qr[2 * rt + 1]); } }
    float m_reg = -1e30f, l_reg = 0.f; f32x16 o[4] = {};
    const int sr = tid >> 4, sc = (tid & 15) * 8, vst0 = v_st(sr, sc), vst1 = v_st(32 + sr, sc);
    const int vb0 = (int)(uintptr_t)V_lds + v_rd_base(lane);
    struct { bf16x8 ks0, ks1; u32x2 mw; } sr_[2];
#define AT_TILE(t) ((t) < NT ? (t) : NT - 1)
#define AT_SLOAD(i, t) do { const int k0_ = AT_TILE(t) * 64; sr_[i].ks0 = *(const bf16x8*)(Kg + (size_t)(k0_ + sr) * 128 + sc); sr_[i].ks1 = *(const bf16x8*)(Kg + (size_t)(k0_ + 32 + sr) * 128 + sc); \
    sr_[i].mw = ((t) < NT) ? *(const u32x2*)(mrow + 2 * (t)) : (u32x2){0u, 0u}; } while (0)
#define AT_SWRITE(bb, i) do { *(LAS bf16x8*)(V_lds + (bb) * SHM_V + vst0) = sr_[i].ks0; *(LAS bf16x8*)(V_lds + (bb) * SHM_V + vst1) = sr_[i].ks1; const int kc_ = sc * 2; \
    *(LAS bf16x8*)(K_lds + (bb) * SHM_K + AT_KSWZ(sr, kc_)) = sr_[i].ks0; *(LAS bf16x8*)(K_lds + (bb) * SHM_K + AT_KSWZ(32 + sr, kc_)) = sr_[i].ks1; } while (0)
#define AT_SWAIT() asm volatile("s_waitcnt vmcnt(3)" ::: "memory")
#define AT_RESC(a) do { if (__any((a) < 1.f)) { _Pragma("unroll") for (int d = 0; d < 4; ++d) _Pragma("unroll") for (int r = 0; r < 16; ++r) o[d][r] *= (a); } } while (0)
#define AT_DQ(t) ((float)(tq - 64 * (t) - 4 * hi))
    f32x16 pA0, pA1, pB0, pB1; float mnA, mnB, alA, alB; bf16x8 pa0, pa1, pa2, pa3;
    u32x2 mwc;
    constexpr int SE = 0, SO = 1;
    __syncthreads();
    AT_SLOAD(SE, 0); asm volatile("s_waitcnt vmcnt(0)" ::: "memory"); AT_SWRITE(0, SE); mwc = sr_[SE].mw; __syncthreads();
    qkt(pA0, pA1, K_lds, qr, r32, hi); mask_bias(pA0, pA1, mwc.x, mwc.y, AT_DQ(0), nslope, hi); partialSM(pA0, pA1, m_reg, mnA, alA);
    AT_SLOAD(SO, 1); if (2 < NTp) AT_SLOAD(SE, 2);
    if (2 < NTp) AT_SWAIT(); else asm volatile("s_waitcnt vmcnt(0)" ::: "memory");
    AT_SWRITE(1, SO); __syncthreads();
    for (int j = 1; j + 1 < NTp; j += 2) {
        AT_SBAR(); qkt(pB0, pB1, K_lds + SHM_K, qr, r32, hi); mwc = sr_[SO].mw; mask_bias(pB0, pB1, mwc.x, mwc.y, AT_DQ(j), nslope, hi);
        finishSM(pA0, pA1, alA, l_reg, pa0, pa1, pa2, pa3); AT_SBAR();
        AT_SLOAD(SO, j + 2); AT_SBAR();
        pv_d0(o, vb0, pa0, pa1, pa2, pa3); partialSM(pB0, pB1, m_reg, mnB, alB);
        __syncthreads(); AT_SWAIT(); AT_SWRITE(0, SE);
        AT_RESC(alB); __syncthreads();
        AT_SBAR(); qkt(pA0, pA1, K_lds, qr, r32, hi); mwc = sr_[SE].mw; mask_bias(pA0, pA1, mwc.x, mwc.y, AT_DQ(j + 1), nslope, hi);
        finishSM(pB0, pB1, alB, l_reg, pa0, pa1, pa2, pa3); AT_SBAR();
        if (j + 3 < NTp) AT_SLOAD(SE, j + 3); AT_SBAR();
        pv_d0(o, vb0 + SHM_V, pa0, pa1, pa2, pa3); partialSM(pA0, pA1, m_reg, mnA, alA);
        __syncthreads(); if (j + 3 < NTp) AT_SWAIT(); else asm volatile("s_waitcnt vmcnt(0)" ::: "memory");
        AT_SWRITE(1, SO);
        AT_RESC(alA); __syncthreads();
    }
    AT_SBAR(); qkt(pB0, pB1, K_lds + SHM_K, qr, r32, hi); mwc = sr_[SO].mw; mask_bias(pB0, pB1, mwc.x, mwc.y, AT_DQ(NTp - 1), nslope, hi);
    finishSM(pA0, pA1, alA, l_reg, pa0, pa1, pa2, pa3); AT_SBAR();
    pv_d0(o, vb0, pa0, pa1, pa2, pa3); partialSM(pB0, pB1, m_reg, mnB, alB);
    AT_RESC(alB);
    finishSM(pB0, pB1, alB, l_reg, pa0, pa1, pa2, pa3); AT_SBAR();
    pv_d0(o, vb0 + SHM_V, pa0, pa1, pa2, pa3);
    const float inv = 1.0f / l_reg;
    f32x16 oa[2] = {f32x16{}, f32x16{}};
    const bf16_t* wf = wuvf + (size_t)wid * 8192 + (size_t)lane * 8;
#pragma unroll
    for (int d0 = 0; d0 < 4; ++d0)
#pragma unroll
        for (int sx = 0; sx < 2; ++sx) { u32x4 w; w.x = cvtpk(o[d0][8 * sx + 0] * inv, o[d0][8 * sx + 1] * inv); w.y = cvtpk(o[d0][8 * sx + 2] * inv, o[d0][8 * sx + 3] * inv);
            w.z = cvtpk(o[d0][8 * sx + 4] * inv, o[d0][8 * sx + 5] * inv); w.w = cvtpk(o[d0][8 * sx + 6] * inv, o[d0][8 * sx + 7] * inv);
            const bf16x8 bfrag = *reinterpret_cast<bf16x8*>(&w);
#pragma unroll
            for (int dt = 0; dt < 2; ++dt) { const bf16x8 af = *(const bf16x8*)(wf + (size_t)((dt * 4 + d0) * 2 + sx) * 512); oa[dt] = __builtin_amdgcn_mfma_f32_32x32x16_bf16(af, bfrag, oa[dt], 0, 0, 0); } }
    bf16_t* op = mix + (size_t)tokq * DM + wid * 64 + 4 * hi;
#pragma unroll
    for (int dt = 0; dt < 2; ++dt)
#pragma unroll
        for (int g = 0; g < 4; ++g) { u32x2 w; w.x = cvtpk(oa[dt][4 * g], oa[dt][4 * g + 1]); w.y = cvtpk(oa[dt][4 * g + 2], oa[dt][4 * g + 3]); *(u32x2*)(op + 32 * dt + 8 * g) = w; }
#undef AT_TILE
#undef AT_SLOAD
#undef AT_SWRITE
#undef AT_SWAIT
#undef AT_RESC
#undef AT_DQ
}
}
__device__ __forceinline__ void p3_attn_mfma(const Args& args, Frame& F) {
    LAS int* qslot = (LAS int*)(F.lds + LCTL_OFF + 2048);
    for (;;) {
        __syncthreads();
        if (F.tid == 0) qslot[0] = (int)atomicAdd(F_ctl + CW_Q + 32, 1u);
        __syncthreads();
        const int u = qslot[0];
        if (u >= 2048) break;
        const int ci = 31 - (u >> 6), b = (u & 63) >> 1, hf = u & 1;
        at::unit(F_projb, F_cb, F_mask, F_wukb, F_wuvf, F_mix, b, ci, hf, F.lds, F.wave);
    }
    __syncthreads();
}

namespace ml {
using at::f32x16; using at::s16x4;
constexpr int L_UC = 0, L_Q = 16384, L_K = 32768, L_WK = 49152, L_V = 65536, L_CB = 81920, L_HC2 = 114688, L_SM = 131072, L_NV = L_SM + 2 * 5 * 256;
__device__ __forceinline__ int hc_off(int t, int col) { return L_HC2 + t * 256 + (((col + 4 * t) & 127) << 1); }
static_assert(L_NV + 512 <= LDS_BYTES, "mLSTM LDS map");
#define ML_PK(L, H) (bf16x8){L[0], L[1], L[2], L[3], H[0], H[1], H[2], H[3]}
__device__ __forceinline__ void stream(const Args& args, int b, int h, LAS unsigned char* lds, int wave_id) {
    int lane_ = my_lane(); asm volatile("" : "+v"(lane_));
    const int wid = wave_id, lane = lane_, tid = wid * 64 + lane;
    const int r32 = lane & 31, hi = lane >> 5;
    const int tt = wid >> 2, vt = wid & 3, mat = wid >> 2, et = wid & 3, kt0 = 2 * (wid >> 2);
    f32x16 C0 = f32x16{}, C1 = f32x16{};
    bf16x8 wf[8];
    { const bf16_t* WT = (mat ? F_wmkT : F_wmqT) + (size_t)h * 128 * 128 + (size_t)(32 * et + r32) * 128 + hi * 8;
#pragma unroll
      for (int ks = 0; ks < 8; ++ks) wf[ks] = *(const bf16x8*)(WT + 16 * ks); }
    LAS float* NV = (LAS float*)(lds + L_NV);
    __syncthreads();
    for (int i = tid; i < 32768 / 16; i += NTHR) *(LAS u32x4*)(lds + L_CB + 16 * i) = (u32x4){0u, 0u, 0u, 0u};
    if (tid < 128) NV[tid] = 0.f;
    float m_prev = -1e30f;
    const float bi = F_b_i[h], bfv = F_b_f[h];
    u32x4 upre[8]; float gpre[2];
#define ML_PREFETCH(cn) do { const int t_ld_ = tid >> 3, ch_ld_ = h * 128 + (tid & 7) * 16; \
        _Pragma("unroll") for (int j_ = 0; j_ < 4; ++j_) { const int tg_ = (cn) * CHK + t_ld_ - 3 + j_; const u32x4* up_ = (const u32x4*)(F_projb + (size_t)(b * SEQ + (tg_ < 0 ? 0 : tg_)) * NPROJ + C_U + ch_ld_); upre[2 * j_] = up_[0]; upre[2 * j_ + 1] = up_[1]; } \
        gpre[0] = F_g32[(size_t)(b * SEQ + (cn) * CHK + lane) * 16 + 8 + h]; gpre[1] = F_g32[(size_t)(b * SEQ + (cn) * CHK + lane) * 16 + 12 + h]; } while (0)
    ML_PREFETCH(0);
    for (int c = 0; c < NCH; ++c) {
        const int tok0 = b * SEQ + c * CHK;
        int lx = lane; asm volatile("" : "+v"(lx));
        const int r32 = lx & 31, hi = lx >> 5, tid = wid * 64 + lx;
        const int t_ld = tid >> 3, d0_ld = (tid & 7) * 16, ch_ld = h * 128 + d0_ld;
        const int vbV = (int)(uintptr_t)(lds + L_V) + at::v_rd_base(lx) + vt * 512;
        const int vbW = (int)(uintptr_t)(lds + L_WK) + at::v_rd_base(lx) + kt0 * 512;
        LAS float* SM = (LAS float*)(lds + L_SM + (c & 1) * 1280);
        const int nt_ = wid + 8 * (lx >> 3), ncg = lx & 7;
        u32x4 zpre[2];
        { const u32x4* zp_ = (const u32x4*)(F_projb + (size_t)(tok0 + nt_) * NPROJ + C_Z + h * 128 + 16 * ncg); zpre[0] = zp_[0]; zpre[1] = zp_[1]; }
        u32x4 vpre[2];
        { const u32x4* vp_ = (const u32x4*)(F_projb + (size_t)(tok0 + t_ld) * NPROJ + C_V + ch_ld); vpre[0] = vp_[0]; vpre[1] = vp_[1]; }
        { const float ip = gpre[0] + bi, fp = gpre[1] + bfv;
          const float bc = scan_add(fminf(fp, 0.f) - log1pf(__expf(-fabsf(fp))));
          const float u = ip - bc; const float pm = scan_max(u);
          const float mm = fmaxf(m_prev, pm); const float mm63 = __builtin_bit_cast(float, __builtin_amdgcn_readlane(__builtin_bit_cast(int, mm), 63)), b63 = __builtin_bit_cast(float, __builtin_amdgcn_readlane(__builtin_bit_cast(int, bc), 63));
          if (wid == 0) { SM[lane] = u; SM[64 + lane] = mm; SM[128 + lane] = __expf(m_prev - mm); SM[192 + lane] = __expf(u - mm63); SM[256 + lane] = __expf(-bc - mm); }
          m_prev = b63 + mm63; }
#ifndef ML_NO_A
        { float a[16];
#pragma unroll
          for (int q = 0; q < 4; ++q) { const f32x4 bv = *(const f32x4*)(F_m_conv_b + ch_ld + 4 * q); a[4 * q] = bv.x; a[4 * q + 1] = bv.y; a[4 * q + 2] = bv.z; a[4 * q + 3] = bv.w; }
#pragma unroll
          for (int j = 0; j < 4; ++j) { const int tg = c * CHK + t_ld - 3 + j;
              if (tg >= 0) { const u32x4 p0 = upre[2 * j], p1 = upre[2 * j + 1];
                  const float uv[16] = {bflo(p0.x), bfhi(p0.x), bflo(p0.y), bfhi(p0.y), bflo(p0.z), bfhi(p0.z), bflo(p0.w), bfhi(p0.w), bflo(p1.x), bfhi(p1.x), bflo(p1.y), bfhi(p1.y), bflo(p1.z), bfhi(p1.z), bflo(p1.w), bfhi(p1.w)};
                  const float* wp = F_m_conv_w + j * 512 + ch_ld;
#pragma unroll
                  for (int q = 0; q < 4; ++q) { const f32x4 wv = *(const f32x4*)(wp + 4 * q); a[4 * q] += wv.x * uv[4 * q]; a[4 * q + 1] += wv.y * uv[4 * q + 1]; a[4 * q + 2] += wv.z * uv[4 * q + 2]; a[4 * q + 3] += wv.w * uv[4 * q + 3]; } } }
#pragma unroll
          for (int i = 0; i < 16; ++i) a[i] = a[i] * sigmoidf_(a[i]);
          u32x4 w0, w1; w0.x = cvtpk_c(a[0], a[1]); w0.y = cvtpk_c(a[2], a[3]); w0.z = cvtpk_c(a[4], a[5]); w0.w = cvtpk_c(a[6], a[7]);
          w1.x = cvtpk_c(a[8], a[9]); w1.y = cvtpk_c(a[10], a[11]); w1.z = cvtpk_c(a[12], a[13]); w1.w = cvtpk_c(a[14], a[15]);
          *(LAS u32x4*)(lds + L_UC + AT_KSWZ(t_ld, d0_ld * 2)) = w0; *(LAS u32x4*)(lds + L_UC + AT_KSWZ(t_ld, d0_ld * 2 + 16)) = w1;
        }
#endif
        __syncthreads();
#ifndef ML_NO_B
#pragma unroll
        for (int t2 = 0; t2 < 2; ++t2) { f32x16 x = f32x16{};
#pragma unroll
            for (int ks = 0; ks < 8; ++ks) { const bf16x8 uf = *(const LAS bf16x8*)(lds + L_UC + AT_KSWZ(32 * t2 + r32, (16 * ks + 8 * hi) * 2)); x = __builtin_amdgcn_mfma_f32_32x32x16_bf16(wf[ks], uf, x, 0, 0, 0); }
            const int t = 32 * t2 + r32;
            if (mat == 0) {
#pragma unroll
                for (int g = 0; g < 4; ++g) { const int e = 32 * et + 8 * g + 4 * hi; u32x2 w; w.x = cvtpk_c(x[4 * g], x[4 * g + 1]); w.y = cvtpk_c(x[4 * g + 2], x[4 * g + 3]);
                    *(LAS u32x2*)(lds + L_Q + t * 256 + ((e * 2) ^ ((t & 7) << 4))) = w; }
            } else { const float wu = SM[192 + t];
#pragma unroll
                for (int g = 0; g < 4; ++g) { const int e = 32 * et + 8 * g + 4 * hi; u32x2 w; w.x = cvtpk_c(x[4 * g], x[4 * g + 1]); w.y = cvtpk_c(x[4 * g + 2], x[4 * g + 3]);
                    *(LAS u32x2*)(lds + L_K + t * 256 + ((e * 2) ^ ((t & 7) << 4))) = w;
                    u32x2 w2; w2.x = cvtpk_c(x[4 * g] * wu, x[4 * g + 1] * wu); w2.y = cvtpk_c(x[4 * g + 2] * wu, x[4 * g + 3] * wu);
                    *(LAS u32x2*)(lds + L_WK + at::v_st(t, e)) = w2; }
            } }
#endif
        *(LAS u32x4*)(lds + L_V + at::v_st(t_ld, d0_ld)) = vpre[0]; *(LAS u32x4*)(lds + L_V + at::v_st(t_ld, d0_ld + 8)) = vpre[1];
        __syncthreads();
#ifndef ML_NO_C
        {
            const int t = 32 * tt + r32;
            const float mmt = SM[64 + t], wst = SM[128 + t], em = SM[256 + t], decay = SM[128 + 63];
            f32x16 nA = f32x16{}, p0 = f32x16{}, p1 = f32x16{};
            float dS = 0.f;
#pragma unroll
            for (int kh = 0; kh < 2; ++kh) {
                bf16x8 qf[4];
#pragma unroll
                for (int k4 = 0; k4 < 4; ++k4) qf[k4] = *(const LAS bf16x8*)(lds + L_Q + AT_KSWZ(t, (16 * (4 * kh + k4) + 8 * hi) * 2));
#pragma unroll
                for (int k4 = 0; k4 < 4; ++k4) { const int ks = 4 * kh + k4, cb = (16 * ks + 8 * hi) * 2;
                    nA = __builtin_amdgcn_mfma_f32_32x32x16_bf16(*(const LAS bf16x8*)(lds + L_CB + AT_KSWZ(32 * vt + r32, cb)), qf[k4], nA, 0, 0, 0);
                    p0 = __builtin_amdgcn_mfma_f32_32x32x16_bf16(*(const LAS bf16x8*)(lds + L_K + AT_KSWZ(r32, cb)), qf[k4], p0, 0, 0, 0);
                    p1 = __builtin_amdgcn_mfma_f32_32x32x16_bf16(*(const LAS bf16x8*)(lds + L_K + AT_KSWZ(32 + r32, cb)), qf[k4], p1, 0, 0, 0);
                    const f32x4 n0 = *(const LAS f32x4*)(NV + 16 * ks + 8 * hi), n1 = *(const LAS f32x4*)(NV + 16 * ks + 8 * hi + 4); const u32x4 qq = *reinterpret_cast<const u32x4*>(&qf[k4]);
                    dS += n0.x * bflo(qq.x) + n0.y * bfhi(qq.x) + n0.z * bflo(qq.y) + n0.w * bfhi(qq.y) + n1.x * bflo(qq.z) + n1.y * bfhi(qq.z) + n1.z * bflo(qq.w) + n1.w * bfhi(qq.w); }
                AT_SBAR();
            }
            { auto rr = __builtin_amdgcn_permlane32_swap(__float_as_uint(dS), __float_as_uint(dS), false, false); dS = __uint_as_float(rr[0]) + __uint_as_float(rr[1]); }
            float ps = 0.f;
#pragma unroll
            for (int g = 0; g < 4; ++g) { const f32x4 u0 = *(const LAS f32x4*)(SM + 8 * g + 4 * hi), u1 = *(const LAS f32x4*)(SM + 32 + 8 * g + 4 * hi);
#pragma unroll
                for (int i = 0; i < 4; ++i) { const int s0 = 8 * g + 4 * hi + i, r = 4 * g + i;
                    const float w0 = (s0 <= t) ? __expf(u0[i] - mmt) : 0.f, w1 = (32 + s0 <= t) ? __expf(u1[i] - mmt) : 0.f;
                    p0[r] *= w0; p1[r] *= w1; ps += p0[r] + p1[r]; } }
            { auto rr = __builtin_amdgcn_permlane32_swap(__float_as_uint(ps), __float_as_uint(ps), false, false); ps = __uint_as_float(rr[0]) + __uint_as_float(rr[1]); }
            bf16x8 pa0, pa1, pa2, pa3;
            AT_PK4(p0, 0, pa0); AT_PK4(p0, 8, pa1); AT_PK4(p1, 0, pa2); AT_PK4(p1, 8, pa3);
#pragma unroll
            for (int r = 0; r < 16; ++r) nA[r] *= wst;
            const s16x4 l0 = at::tr_read<0>(vbV), h0 = at::tr_read<2048>(vbV), l1 = at::tr_read<4096>(vbV), h1 = at::tr_read<4096 + 2048>(vbV);
            const s16x4 l2 = at::tr_read<8192>(vbV), h2 = at::tr_read<8192 + 2048>(vbV), l3 = at::tr_read<12288>(vbV), h3 = at::tr_read<12288 + 2048>(vbV);
            asm volatile("s_waitcnt lgkmcnt(0)" ::: "memory"); AT_SBAR();
            const bf16x8 vf0 = ML_PK(l0, h0), vf1 = ML_PK(l1, h1), vf2 = ML_PK(l2, h2), vf3 = ML_PK(l3, h3);
            nA = __builtin_amdgcn_mfma_f32_32x32x16_bf16(vf0, pa0, nA, 0, 0, 0); nA = __builtin_amdgcn_mfma_f32_32x32x16_bf16(vf1, pa1, nA, 0, 0, 0);
            nA = __builtin_amdgcn_mfma_f32_32x32x16_bf16(vf2, pa2, nA, 0, 0, 0); nA = __builtin_amdgcn_mfma_f32_32x32x16_bf16(vf3, pa3, nA, 0, 0, 0);
            const float den = ps + wst * dS; const float inv = 1.0f / fmaxf(fabsf(den), em);
#pragma unroll
            for (int g = 0; g < 4; ++g) { u32x2 o; o.x = cvtpk_c(nA[4 * g] * inv, nA[4 * g + 1] * inv); o.y = cvtpk_c(nA[4 * g + 2] * inv, nA[4 * g + 3] * inv); *(LAS u32x2*)(lds + hc_off(t, 32 * vt + 8 * g + 4 * hi)) = o; }
#pragma unroll
            for (int r = 0; r < 16; ++r) { C0[r] *= decay; C1[r] *= decay; }
            { const s16x4 a0 = at::tr_read<0>(vbW), b0 = at::tr_read<2048>(vbW), a1 = at::tr_read<4096>(vbW), b1 = at::tr_read<4096 + 2048>(vbW);
              const s16x4 a2 = at::tr_read<8192>(vbW), b2 = at::tr_read<8192 + 2048>(vbW), a3 = at::tr_read<12288>(vbW), b3 = at::tr_read<12288 + 2048>(vbW);
              asm volatile("s_waitcnt lgkmcnt(0)" ::: "memory"); AT_SBAR();
              C0 = __builtin_amdgcn_mfma_f32_32x32x16_bf16(vf0, ML_PK(a0, b0), C0, 0, 0, 0); C0 = __builtin_amdgcn_mfma_f32_32x32x16_bf16(vf1, ML_PK(a1, b1), C0, 0, 0, 0);
              C0 = __builtin_amdgcn_mfma_f32_32x32x16_bf16(vf2, ML_PK(a2, b2), C0, 0, 0, 0); C0 = __builtin_amdgcn_mfma_f32_32x32x16_bf16(vf3, ML_PK(a3, b3), C0, 0, 0, 0); }
            { const s16x4 a0 = at::tr_read<512>(vbW), b0 = at::tr_read<512 + 2048>(vbW), a1 = at::tr_read<512 + 4096>(vbW), b1 = at::tr_read<512 + 4096 + 2048>(vbW);
              const s16x4 a2 = at::tr_read<512 + 8192>(vbW), b2 = at::tr_read<512 + 8192 + 2048>(vbW), a3 = at::tr_read<512 + 12288>(vbW), b3 = at::tr_read<512 + 12288 + 2048>(vbW);
              asm volatile("s_waitcnt lgkmcnt(0)" ::: "memory"); AT_SBAR();
              C1 = __builtin_amdgcn_mfma_f32_32x32x16_bf16(vf0, ML_PK(a0, b0), C1, 0, 0, 0); C1 = __builtin_amdgcn_mfma_f32_32x32x16_bf16(vf1, ML_PK(a1, b1), C1, 0, 0, 0);
              C1 = __builtin_amdgcn_mfma_f32_32x32x16_bf16(vf2, ML_PK(a2, b2), C1, 0, 0, 0); C1 = __builtin_amdgcn_mfma_f32_32x32x16_bf16(vf3, ML_PK(a3, b3), C1, 0, 0, 0); }
        }
#endif
        __syncthreads();
        if (c + 1 < NCH) ML_PREFETCH(c + 1);
        {
#pragma unroll
            for (int r = 0; r < 16; ++r) { const int vv = 32 * vt + (r & 3) + 8 * (r >> 2) + 4 * hi;
                *(LAS bf16_t*)(lds + L_CB + AT_KSWZ(vv, (32 * kt0 + r32) * 2)) = (bf16_t)f2bf(C0[r]); *(LAS bf16_t*)(lds + L_CB + AT_KSWZ(vv, (32 * (kt0 + 1) + r32) * 2)) = (bf16_t)f2bf(C1[r]); }
            { const int kk = 16 * wid + (lx & 15), sg = lx >> 4; float a = 0.f;
#pragma unroll
              for (int s2 = 0; s2 < 16; ++s2) { const int sx = 16 * sg + s2; a += SM[192 + sx] * bf2f(*(const LAS bf16_t*)(lds + L_K + AT_KSWZ(sx, kk * 2))); }
              a += __shfl_xor(a, 16); a += __shfl_xor(a, 32);
              if (sg == 0) NV[kk] = SM[128 + 63] * NV[kk] + a; }
            {
                float hv[16];
#pragma unroll
                for (int i = 0; i < 4; ++i) { const u32x2 p = *(const LAS u32x2*)(lds + hc_off(nt_, 16 * ncg + 4 * i)); hv[4 * i] = bflo(p.x); hv[4 * i + 1] = bfhi(p.x); hv[4 * i + 2] = bflo(p.y); hv[4 * i + 3] = bfhi(p.y); }
                float s1 = 0.f;
#pragma unroll
                for (int i = 0; i < 16; ++i) s1 += hv[i];
                s1 += dppf<0xB1>(s1, s1); s1 += dppf<0x4E>(s1, s1); s1 += dppf<0x141>(s1, s1);
                const float mu = s1 * (1.0f / 128.0f); float s2 = 0.f;
#pragma unroll
                for (int i = 0; i < 16; ++i) { hv[i] -= mu; s2 += hv[i] * hv[i]; }
                s2 += dppf<0xB1>(s2, s2); s2 += dppf<0x4E>(s2, s2); s2 += dppf<0x141>(s2, s2);
                const float rs = __builtin_amdgcn_rsqf(s2 * (1.0f / 128.0f) + LN_EPS);
                const float* gp = F_m_norm_g + h * 128 + 16 * ncg;
                const unsigned zw[8] = {zpre[0].x, zpre[0].y, zpre[0].z, zpre[0].w, zpre[1].x, zpre[1].y, zpre[1].z, zpre[1].w};
                unsigned ow[8];
#pragma unroll
                for (int i = 0; i < 8; ++i) { const f32x2 g2 = *(const f32x2*)(gp + 2 * i);
                    ow[i] = cvtpk_c(sigmoidf_(bflo(zw[i])) * hv[2 * i] * rs * g2.x, sigmoidf_(bfhi(zw[i])) * hv[2 * i + 1] * rs * g2.y); }
                u32x4* op = (u32x4*)(F_mix + (size_t)(tok0 + nt_) * DM + 512 + h * 128 + 16 * ncg);
                op[0] = (u32x4){ow[0], ow[1], ow[2], ow[3]}; op[1] = (u32x4){ow[4], ow[5], ow[6], ow[7]};
            }
        }
    }
    __syncthreads();
}
#undef ML_PK
#undef ML_PREFETCH
}

__device__ __forceinline__ void p5_ln1(const Args& args, Frame& F) {
    const int lane = F.lane;
    const int gtid = F.bid * NTHR + F.tid, NT = F.G * NTHR;
    for (int i = gtid; i < NEXP * RT_STRIDE / 4; i += NT) ((u32x4*)F_rtok)[i] = u32x4{0xffffffffu, 0xffffffffu, 0xffffffffu, 0xffffffffu};
    const int gw = F.bid * NWAVES + F.wave, NGW = F.G * NWAVES;
    f32x4 gv[4], bv[4];
#pragma unroll
    for (int j = 0; j < 4; ++j) { gv[j] = *((const f32x4*)F_ln1_g + lane + 64 * j); bv[j] = *((const f32x4*)F_ln1_b + lane + 64 * j); }
    f32x4 vn[4]; u32x2 mn_[4];
    { const f32x4* pr = (const f32x4*)(F_x + (size_t)gw * DM) + lane; const u32x2* mr = (const u32x2*)((const bf16_t*)F_pre1 + (size_t)gw * DM) + lane;
#pragma unroll
      for (int j = 0; j < 4; ++j) { vn[j] = pr[64 * j]; mn_[j] = mr[64 * j]; } }
    for (int tok = gw; tok < T; tok += NGW) {
        f32x4 v[4]; float s = 0.f;
#pragma unroll
        for (int j = 0; j < 4; ++j) { v[j].x = DN_ALPHA * vn[j].x + bflo(mn_[j].x); v[j].y = DN_ALPHA * vn[j].y + bfhi(mn_[j].x); v[j].z = DN_ALPHA * vn[j].z + bflo(mn_[j].y); v[j].w = DN_ALPHA * vn[j].w + bfhi(mn_[j].y);
            s += (v[j].x + v[j].y) + (v[j].z + v[j].w); }
        if (tok + NGW < T) { const f32x4* pr = (const f32x4*)(F_x + (size_t)(tok + NGW) * DM) + lane; const u32x2* mr = (const u32x2*)((const bf16_t*)F_pre1 + (size_t)(tok + NGW) * DM) + lane;
#pragma unroll
            for (int j = 0; j < 4; ++j) { vn[j] = pr[64 * j]; mn_[j] = mr[64 * j]; } }
        const float mean = wave_sum(s) * (1.0f / DM); float s2 = 0.f;
#pragma unroll
        for (int j = 0; j < 4; ++j) { v[j] = v[j] - mean; s2 += (v[j].x * v[j].x + v[j].y * v[j].y) + (v[j].z * v[j].z + v[j].w * v[j].w); }
        const float rstd = 1.0f / sqrtf(wave_sum(s2) * (1.0f / DM) + LN_EPS);
        u32x2* o = (u32x2*)(F_h1b + (size_t)tok * DM) + lane;
#pragma unroll
        for (int j = 0; j < 4; ++j) { v[j] = v[j] * rstd * gv[j] + bv[j]; u32x2 w; w.x = cvtpk_c(v[j].x, v[j].y); w.y = cvtpk_c(v[j].z, v[j].w); o[64 * j] = w; }
        { unsigned* q8 = (unsigned*)(F_h1q + (size_t)tok * DM) + lane;
#pragma unroll
          for (int j = 0; j < 4; ++j) q8[64 * j] = f8x4(v[j].x * F8_ACT_S, v[j].y * F8_ACT_S, v[j].z * F8_ACT_S, v[j].w * F8_ACT_S); }
    }
}
#define P6_INS(GT, V, E) { const bool g0_ = GT(V, E, t0, i0), g1_ = GT(V, E, t1, i1), g2_ = GT(V, E, t2, i2), g3_ = GT(V, E, t3, i3); \
        t3 = g2_ ? t2 : (g3_ ? (V) : t3); i3 = g2_ ? i2 : (g3_ ? (E) : i3); t2 = g1_ ? t1 : (g2_ ? (V) : t2); i2 = g1_ ? i1 : (g2_ ? (E) : i2); \
        t1 = g0_ ? t0 : (g1_ ? (V) : t1); i1 = g0_ ? i0 : (g1_ ? (E) : i1); t0 = g0_ ? (V) : t0; i0 = g0_ ? (E) : i0; }
#define P6_GT1(V, E, TT, II) ((V) > (TT))
#define P6_GT2(V, E, TT, II) ((V) > (TT) || ((V) == (TT) && (E) < (II)))
__device__ __forceinline__ void p6_router_fill(const Args& args, Frame& F) {
    const int lane = F.lane, r32 = lane & 31, hi = lane >> 5;
    LAS unsigned char* WL = F.lds;
    LAS int* lc = (LAS int*)(F.lds + 131072);
    LAS int* lbase = lc + 32;
    __syncthreads();
    for (int i = F.tid; i < 8192; i += NTHR) *(LAS u32x4*)(WL + i * 16) = *((const u32x4*)F_wrf + i);
    float bias[16];
#pragma unroll
    for (int r = 0; r < 16; ++r) bias[r] = F_b_router[8 * (r >> 2) + 4 * hi + (r & 3)];
    constexpr int NGRP = T / 32;
    const int rounds = (NGRP + F.G * NWAVES - 1) / (F.G * NWAVES);
    for (int rd = 0; rd < rounds; ++rd) {
        const int grp = (rd * F.G + F.bid) * NWAVES + F.wave; const bool act = grp < NGRP;
        __syncthreads();
        if (F.tid < 32) lc[F.tid] = 0;
        __syncthreads();
        const int tok = grp * 32 + r32;
        float t0 = -INFINITY, t1 = -INFINITY, t2 = -INFINITY, t3 = -INFINITY; int i0 = 0, i1 = 0, i2 = 0, i3 = 0, k0 = 0, k1 = 0, k2 = 0, k3 = 0;
        if (act) {
            const bf16_t* hrow = F_h1b + (size_t)tok * DM + 32 * hi;
            at::f32x16 acc;
#pragma unroll
            for (int r = 0; r < 16; ++r) acc[r] = 0.f;
#pragma unroll 1
            for (int qh = 0; qh < 2; ++qh) {
                bf16x8 b[32];
#pragma unroll
                for (int q = 0; q < 8; ++q)
#pragma unroll
                    for (int i = 0; i < 4; ++i) b[q * 4 + i] = *(const bf16x8*)(hrow + 64 * (qh * 8 + q) + 8 * i);
#pragma unroll
                for (int k = 0; k < 32; ++k) { const int ks = qh * 32 + k;
                    const bf16x8 ah = *(const LAS bf16x8*)(WL + (ks * 64 + lane) * 16), al = *(const LAS bf16x8*)(WL + 65536 + (ks * 64 + lane) * 16);
                    acc = __builtin_amdgcn_mfma_f32_32x32x16_bf16(ah, b[k], acc, 0, 0, 0); acc = __builtin_amdgcn_mfma_f32_32x32x16_bf16(al, b[k], acc, 0, 0, 0); }
            }
#pragma unroll
            for (int r = 0; r < 16; ++r) { const float v = acc[r] + bias[r]; const int e = 8 * (r >> 2) + 4 * hi + (r & 3); P6_INS(P6_GT1, v, e) }
            const float p0 = __shfl_xor(t0, 32), p1 = __shfl_xor(t1, 32), p2 = __shfl_xor(t2, 32), p3 = __shfl_xor(t3, 32);
            const int q0 = __shfl_xor(i0, 32), q1 = __shfl_xor(i1, 32), q2 = __shfl_xor(i2, 32), q3 = __shfl_xor(i3, 32);
            P6_INS(P6_GT2, p0, q0) P6_INS(P6_GT2, p1, q1) P6_INS(P6_GT2, p2, q2) P6_INS(P6_GT2, p3, q3)
            if (hi == 0) { k0 = __hip_atomic_fetch_add(lc + i0, 1, __ATOMIC_RELAXED, __HIP_MEMORY_SCOPE_WORKGROUP); k1 = __hip_atomic_fetch_add(lc + i1, 1, __ATOMIC_RELAXED, __HIP_MEMORY_SCOPE_WORKGROUP);
                k2 = __hip_atomic_fetch_add(lc + i2, 1, __ATOMIC_RELAXED, __HIP_MEMORY_SCOPE_WORKGROUP); k3 = __hip_atomic_fetch_add(lc + i3, 1, __ATOMIC_RELAXED, __HIP_MEMORY_SCOPE_WORKGROUP); }
        }
        __syncthreads();
        if (F.tid < 32) { const int c = lc[F.tid]; lbase[F.tid] = c ? (int)__hip_atomic_fetch_add(F_ctl + CW_CNT + F.tid, (unsigned)c, __ATOMIC_RELAXED, __HIP_MEMORY_SCOPE_AGENT) : 0; }
        __syncthreads();
        if (act && hi == 0) {
            const float e1 = __expf(t1 - t0), e2 = __expf(t2 - t0), e3 = __expf(t3 - t0); const float isum = 1.0f / (1.0f + e1 + e2 + e3);
            int row;
            row = i0 * RT_STRIDE + lbase[i0] + k0; F_rtok[row] = tok;             F_rgate[row] = isum;
            row = i1 * RT_STRIDE + lbase[i1] + k1; F_rtok[row] = tok | (1 << 16); F_rgate[row] = e1 * isum;
            row = i2 * RT_STRIDE + lbase[i2] + k2; F_rtok[row] = tok | (2 << 16); F_rgate[row] = e2 * isum;
            row = i3 * RT_STRIDE + lbase[i3] + k3; F_rtok[row] = tok | (3 << 16); F_rgate[row] = e3 * isum;
        }
    }
    __syncthreads();
}
#undef P6_INS
#undef P6_GT1
#undef P6_GT2
__device__ __forceinline__ void moe_offsets(const Args& args, Frame& F, LAS int* offs) {
    __syncthreads();
    if (F.tid < NROUND) { int acc = 0; for (int e = 0; e < NEXP; ++e) { offs[F.tid * 33 + e] = acc; const int c = (int)__hip_atomic_load(F_ctl + CW_CNT + F.tid * NEXP + e, __ATOMIC_RELAXED, __HIP_MEMORY_SCOPE_AGENT); acc += (c + 255) & ~255; } offs[F.tid * 33 + NEXP] = acc; }
    __syncthreads();
}
template <int I> __device__ __forceinline__ float f8dec(unsigned w) { return __builtin_amdgcn_cvt_f32_fp8((int)w, I); }
__device__ __forceinline__ void p9_final(const Args& args, Frame& F) {
    const int lane = F.lane; const int gw = F.bid * NWAVES + F.wave, NGW = F.G * NWAVES;
    f32x4 gv[4], bv[4];
#pragma unroll
    for (int j = 0; j < 4; ++j) { gv[j] = *((const f32x4*)F_ln2_g + lane + 64 * j); bv[j] = *((const f32x4*)F_ln2_b + lane + 64 * j); }
    for (int tok = gw; tok < T; tok += NGW) {
        f32x4* yr = (f32x4*)(F_out + (size_t)tok * DM) + lane;
        const unsigned* ys = (const unsigned*)((const unsigned char*)F_out + (size_t)tok * 4096) + lane;
        const u32x2* hr = (const u32x2*)(F_h1b + (size_t)tok * DM) + lane;
        unsigned yw[4][4]; u32x2 hp[4];
#pragma unroll
        for (int q = 0; q < 4; ++q)
#pragma unroll
            for (int j = 0; j < 4; ++j) yw[q][j] = ys[256 * q + 64 * j];
#pragma unroll
        for (int j = 0; j < 4; ++j) hp[j] = hr[64 * j];
        f32x4 v[4]; float s = 0.f;
#pragma unroll
        for (int j = 0; j < 4; ++j) {
            const float y0 = (f8dec<0>(yw[0][j]) + f8dec<0>(yw[1][j])) + (f8dec<0>(yw[2][j]) + f8dec<0>(yw[3][j])), y1 = (f8dec<1>(yw[0][j]) + f8dec<1>(yw[1][j])) + (f8dec<1>(yw[2][j]) + f8dec<1>(yw[3][j]));
            const float y2 = (f8dec<2>(yw[0][j]) + f8dec<2>(yw[1][j])) + (f8dec<2>(yw[2][j]) + f8dec<2>(yw[3][j])), y3 = (f8dec<3>(yw[0][j]) + f8dec<3>(yw[1][j])) + (f8dec<3>(yw[2][j]) + f8dec<3>(yw[3][j]));
            v[j].x = DN_ALPHA * bflo(hp[j].x) + y0 * (1.0f / F8_Y_S); v[j].y = DN_ALPHA * bfhi(hp[j].x) + y1 * (1.0f / F8_Y_S);
            v[j].z = DN_ALPHA * bflo(hp[j].y) + y2 * (1.0f / F8_Y_S); v[j].w = DN_ALPHA * bfhi(hp[j].y) + y3 * (1.0f / F8_Y_S);
            s += (v[j].x + v[j].y) + (v[j].z + v[j].w); }
        const float mean = wave_sum(s) * (1.0f / DM); float s2 = 0.f;
#pragma unroll
        for (int j = 0; j < 4; ++j) { v[j] = v[j] - mean; s2 += (v[j].x * v[j].x + v[j].y * v[j].y) + (v[j].z * v[j].z + v[j].w * v[j].w); }
        const float rstd = 1.0f / sqrtf(wave_sum(s2) * (1.0f / DM) + LN_EPS);
#pragma unroll
        for (int j = 0; j < 4; ++j) yr[64 * j] = v[j] * rstd * gv[j] + bv[j];
    }
}

#define XB_TMO      128
#define XB_XCNT(j)  (256  + 64 * (j))
#define XB_XSUB(j)  (1280 + 64 * (j))
#define XB_XGEN(j)  (2304 + 64 * (j))
#define XB_TOP      3328
#define XB_TOPGEN   3392
#define XCD_BAR_WORDS 3456
#define XB_SPIN_CAP (1u << 22)
__device__ __forceinline__ unsigned xb_ld(unsigned* p)              { return __hip_atomic_load(p, __ATOMIC_RELAXED, __HIP_MEMORY_SCOPE_AGENT); }
__device__ __forceinline__ unsigned xb_add(unsigned* p, unsigned v) { return __hip_atomic_fetch_add(p, v, __ATOMIC_RELAXED, __HIP_MEMORY_SCOPE_AGENT); }
__device__ __forceinline__ unsigned xb_xcc_id() { return (unsigned)__builtin_amdgcn_s_getreg((3 << 11) | 20) & 0xFu; }
#define XB_SPIN(cond, bar) do { unsigned _sp = 0; while (cond) { __builtin_amdgcn_s_sleep(1); \
    if ((++_sp & 255u) == 0u) { if (xb_ld(&(bar)[XB_TMO])) break; if (_sp > XB_SPIN_CAP) { atomicAdd(&(bar)[XB_TMO], 1u); break; } } } } while (0)
struct XcdBarrier { unsigned* bar; unsigned x; volatile LAS unsigned* st; };
__device__ __forceinline__ XcdBarrier xcd_barrier_post(unsigned* bar, volatile LAS unsigned* st, bool leader) {
    XcdBarrier b; b.bar = bar; b.x = xb_xcc_id(); b.st = st;
    if (leader) (void)xb_add(&bar[XB_XCNT(b.x)], 1u);
    return b;
}
__device__ __forceinline__ void xcd_barrier_complete(unsigned* bar, unsigned x, unsigned& nloc, unsigned& nx) {
    const unsigned G = gridDim.x * gridDim.y * gridDim.z;
    unsigned sum, cnt, mine, sp = 0u;
    for (;;) {
        sum = 0u; cnt = 0u; mine = 0u;
#pragma unroll
        for (unsigned j = 0; j < 16; ++j) { const unsigned c = xb_ld(&bar[XB_XCNT(j)]); sum += c; cnt += (c > 0u) ? 1u : 0u; mine = (j == x) ? c : mine; }
        if (sum == G) break;
        __builtin_amdgcn_s_sleep(1);
        if ((++sp & 255u) == 0u) { if (xb_ld(&bar[XB_TMO])) break; if (sp > XB_SPIN_CAP) { atomicAdd(&bar[XB_TMO], 1u); break; } }
    }
    nloc = mine > 0u ? mine : 1u; nx = cnt > 0u ? cnt : 1u;
}
__device__ __forceinline__ void xcd_barrier(const XcdBarrier& b, bool leader) {
    asm volatile("s_waitcnt vmcnt(0)" ::: "memory");
    __syncthreads();
    if (leader) {
        unsigned* bar = b.bar;
        __builtin_amdgcn_s_waitcnt(0);
        unsigned nloc = b.st[0], nx = b.st[1];
        if (nloc == 0u) { xcd_barrier_complete(bar, b.x, nloc, nx); b.st[0] = nloc; b.st[1] = nx; }
        const unsigned old = xb_add(&bar[XB_XSUB(b.x)], 1u);
        const unsigned gen = old / nloc;
        if (old + 1u == (gen + 1u) * nloc) {
            __builtin_amdgcn_fence(__ATOMIC_RELEASE, "agent");
            asm volatile("s_waitcnt vmcnt(0)" ::: "memory");
            const unsigned og = xb_add(&bar[XB_TOP], 1u);
            const unsigned tg = og / nx;
            if (og + 1u == (tg + 1u) * nx) xb_add(&bar[XB_TOPGEN], 1u);
            else XB_SPIN(xb_ld(&bar[XB_TOPGEN]) == tg, bar);
            __builtin_amdgcn_fence(__ATOMIC_ACQUIRE, "agent");
            xb_add(&bar[XB_XGEN(b.x)], 1u);
            asm volatile("s_waitcnt vmcnt(0)" ::: "memory");
        } else {
            XB_SPIN(xb_ld(&bar[XB_XGEN(b.x)]) == gen, bar);
            __builtin_amdgcn_fence(__ATOMIC_ACQUIRE, "agent");
            asm volatile("s_waitcnt vmcnt(0)" ::: "memory");
        }
    }
    __syncthreads();
}

constexpr int PH_P0 = 0, PH_P1 = 1, PH_P2 = 2, PH_P3 = 3, PH_P4 = 4, PH_P5 = 5, PH_P6 = 6, PH_MOE = 7, PH_FINAL = PH_MOE + 2 * NROUND, N_PHASES = PH_FINAL + 1;

#ifndef PROBE_T
#define PROBE_T -1
#endif
#ifndef PROBE_T0
#define PROBE_T0 PROBE_T
#endif
#define STAMP(k) do { if (PROBE_T >= 0 && F.tid == 0) { const unsigned long long t_ = __builtin_amdgcn_s_memrealtime(); tstamp[2 * ((k) + 1)] = (unsigned)t_; tstamp[2 * ((k) + 1) + 1] = (unsigned)(t_ >> 32); } } while (0)
template <unsigned MASK>
__global__ void __launch_bounds__(NTHR, 2) mk_fwd(Args args) {
    extern __shared__ __attribute__((aligned(16))) unsigned char lds_raw[];
    cg::grid_group grid = cg::this_grid();
    Frame F;
    F.lds = (LAS unsigned char*)lds_raw;
    F.wave = __builtin_amdgcn_readfirstlane((int)threadIdx.x >> 6); F.lane = my_lane(); F.tid = F.wave * 64 + F.lane; F.G = gridDim.x; F.bid = blockIdx.x;
    LAS int* offs = (LAS int*)(F.lds + LCTL_OFF);
    volatile LAS unsigned* bst = (volatile LAS unsigned*)(F.lds + LDS_BYTES - 16);
    volatile LAS unsigned* tstamp = (volatile LAS unsigned*)(F.lds + LDS_BYTES - 512);
    STAMP(-1);
    const bool multi = (args.ph_hi - args.ph_lo) > 1;
    XcdBarrier xbar; xbar.bar = F_ctl + CW_BAR; xbar.x = 0; xbar.st = bst;
    if (multi) { if (F.tid == 0) { bst[0] = 0u; bst[1] = 0u; } __syncthreads(); xbar = xcd_barrier_post(F_ctl + CW_BAR, bst, F.tid == 0); }
    const int lo = args.ph_lo, hi = args.ph_hi;
#define PH_BIT(k) ((k) < PH_MOE ? (k) : ((k) == PH_FINAL ? 9 : 7 + (((k) - PH_MOE) % 2)))
#define IN(k) (((MASK >> PH_BIT(k)) & 1u) && lo <= (k) && (k) < hi)
#ifndef PROBE_PH
#define PROBE_PH -1
#endif
#ifndef PROBE_REP
#define PROBE_REP 1
#endif
#define REPS(k) for (int rep_ = 0; rep_ < (((k) == PROBE_PH) ? PROBE_REP : 1); ++rep_)
#define REPSYNC(k) do { if (rep_ > 0) { xcd_barrier(xbar, F.wave == 0 && F.lane == 0); if ((k) == PH_P2) { if (F.bid == 0 && F.tid == 0) __hip_atomic_store(F_ctl + CW_Q, 0u, __ATOMIC_RELAXED, __HIP_MEMORY_SCOPE_AGENT); xcd_barrier(xbar, F.wave == 0 && F.lane == 0); } } } while (0)
#define SEAM(k) do { if (IN(k) && IN((k) + 1)) { if (args.ph_lo < 0) grid.sync(); else xcd_barrier(xbar, F.wave == 0 && F.lane == 0); }     F.lane = launder(my_lane()); F.tid = F.wave * 64 + F.lane; STAMP(k); } while (0)

    if (IN(PH_P0)) REPS(PH_P0) { REPSYNC(PH_P0); p0_prologue(args, F); } SEAM(PH_P0);
    if (IN(PH_P1)) REPS(PH_P1) { REPSYNC(PH_P1); pg8::Gemm g{F_xb, F_WinT, DM * 2, DM * 2, DM * 2, nullptr}; pg8::StaticOrder S; S.init(T, NPROJ, F.G, F.bid); EpiProj E{F_projb, F_g32};
        pg8::gemm_phase<EpiProj, pg8::StaticOrder>(F.lds, g, S, E, F.wave); } SEAM(PH_P1);
    if (IN(PH_P2)) REPS(PH_P2) { REPSYNC(PH_P2); p2_cb(args, F);
#ifndef PROBE_ML
#define PROBE_ML 1
#endif
#ifndef PROBE_IDX
#define PROBE_IDX 1
#endif
        __syncthreads();
#pragma unroll 1
        for (int ridx = 0; ridx < PROBE_IDX; ++ridx) p2_indexer_mfma(args, F, ridx);
 } SEAM(PH_P2);
    if (IN(PH_P3)) REPS(PH_P3) { REPSYNC(PH_P3);
#pragma unroll 1
        for (int rml = 0; rml < PROBE_ML; ++rml)
        for (int sidx = F.bid; sidx < NB * 4; sidx += F.G) ml::stream(args, sidx >> 2, sidx & 3, F.lds, F.wave);
        p3_attn_mfma(args, F); } SEAM(PH_P3);
    if (IN(PH_P4)) REPS(PH_P4) { REPSYNC(PH_P4); pg8::Gemm g{F_mix, F_WoutT, DM * 2, DM * 2, DM * 2, nullptr}; pg8::StaticOrder S; S.init(T, DM, F.G, F.bid); EpiOut E{(bf16_t*)F_pre1};
        pg8::gemm_phase<EpiOut, pg8::StaticOrder>(F.lds, g, S, E, F.wave); } SEAM(PH_P4);
    if (IN(PH_P5)) { p5_ln1(args, F); } SEAM(PH_P5);
    if (IN(PH_P6)) { p6_router_fill(args, F); } SEAM(PH_P6);
#define INM(j) (((MASK >> (7 + (j))) & 1u) && lo <= pa + (j) && pa + (j) < hi)
#define SEAMM(j) do { if (lo <= pa + (j) && pa + (j) + 1 < hi) xcd_barrier(xbar, F.wave == 0 && F.lane == 0); F.lane = launder(my_lane()); F.tid = F.wave * 64 + F.lane; STAMP(pa + (j)); } while (0)
#pragma unroll 1
    for (int rnd = 0; rnd < NROUND; ++rnd) {
        const int pa = PH_MOE + 2 * rnd;
        if (INM(0)) REPS(pa) { REPSYNC(pa); moe_offsets(args, F, offs); pg8::Gemm g{F_h1q, F_WguT, DM, DM, DM, F_rtok}; MoeOrder S; S.init(offs + rnd * 33, 8, F.G, F.bid); EpiGU E{F_hb, F_b_gu};
            pg8::gemm_phase<EpiGU, MoeOrder, true, true>(F.lds, g, S, E, F.wave); } SEAMM(0);
        if (INM(1)) REPS(pa + 1) { REPSYNC(pa + 1); moe_offsets(args, F, offs); pg8::Gemm g{F_hb, F_WdT, DM, DM, DM, nullptr}; MoeOrder S; S.init(offs + rnd * 33, 4, F.G, F.bid);
            EpiDown E{(unsigned char*)F_out, F_b_down, F_rtok, F_rgate};
            pg8::gemm_phase<EpiDown, MoeOrder, false, true>(F.lds, g, S, E, F.wave); } SEAMM(1);
    }
    if (IN(PH_FINAL)) { p9_final(args, F); }
    if (PROBE_T >= 0) {
        xcd_barrier(xbar, F.wave == 0 && F.lane == 0); STAMP(PH_FINAL);
        if (F.bid == 0 && F.tid == 0) { const unsigned long long t1 = ((unsigned long long)tstamp[2 * (PROBE_T + 1) + 1] << 32) | tstamp[2 * (PROBE_T + 1)], t0 = ((unsigned long long)tstamp[2 * PROBE_T0 + 1] << 32) | tstamp[2 * PROBE_T0];
            const unsigned long long d = t1 - t0, s0 = __builtin_amdgcn_s_memrealtime(); while (__builtin_amdgcn_s_memrealtime() - s0 < d) __builtin_amdgcn_s_sleep(8); }
    }
#undef IN
#undef SEAM
}

extern "C" void kernel_launch(void* const* d_in, const int* in_sizes, int n_in, void* d_out, int out_size, void* d_ws, size_t ws_size, hipStream_t stream) {
    static int grid = 0;
#if MK_ONE_LAUNCH
    void* kfn[1] = {(void*)mk_fwd<0x3ffu>};
    constexpr int NKFN = 1;
#else
    void* kfn[10] = {(void*)mk_fwd<1u << 0>, (void*)mk_fwd<1u << 1>, (void*)mk_fwd<1u << 2>, (void*)mk_fwd<1u << 3>, (void*)mk_fwd<1u << 4>, (void*)mk_fwd<1u << 5>,
                     (void*)mk_fwd<1u << 6>, (void*)mk_fwd<1u << 7>, (void*)mk_fwd<1u << 8>, (void*)mk_fwd<1u << 9>};
    constexpr int NKFN = 10;
#endif
    if (grid == 0) {
        if (n_in != 23 || out_size != T * DM || ws_size < WS_END) { fprintf(stderr, "kernel_launch: unexpected shapes (n_in %d, out %d, ws %zu, need %zu)\n", n_in, out_size, ws_size, (size_t)WS_END); grid = -1; return; }
        int dev = 0, cus = 0, per_cu = 0;
        hipGetDevice(&dev); hipDeviceGetAttribute(&cus, hipDeviceAttributeMultiprocessorCount, dev);
        for (int k = 0; k < NKFN; ++k) {
            if (hipFuncSetAttribute((const void*)kfn[k], hipFuncAttributeMaxDynamicSharedMemorySize, LDS_BYTES) != hipSuccess) { fprintf(stderr, "kernel_launch: hipFuncSetAttribute failed\n"); grid = -1; return; }
            int pc = 0;
            if (hipOccupancyMaxActiveBlocksPerMultiprocessor(&pc, (const void*)kfn[k], NTHR, LDS_BYTES) != hipSuccess || pc < 1) { fprintf(stderr, "kernel_launch: occupancy query says %d for kernel %d\n", pc, k); grid = -1; return; }
            per_cu = pc;
        }
        (void)hipGetLastError();
        grid = cus * 1;
        fprintf(stderr, "kernel_launch: cus %d per_cu %d grid %d\n", cus, per_cu, grid);
    }
    if (grid < 0) return;
    hipMemsetAsync((char*)d_ws + WS_CTL, 0, CTL_BYTES, stream);
    Args a{};
    for (int i = 0; i < 23; ++i) a.in[i] = (const float*)d_in[i];
    a.out = (float*)d_out; a.ws = (unsigned char*)d_ws;
#if MK_ONE_LAUNCH
    a.ph_lo = 0; a.ph_hi = N_PHASES;
    { void* kargs[] = {&a}; hipError_t e = hipLaunchCooperativeKernel((void*)mk_fwd<0x3ffu>, dim3(grid), dim3(NTHR), kargs, LDS_BYTES, stream);
      if (e != hipSuccess) fprintf(stderr, "cooperative launch failed: %s\n", hipGetErrorString(e)); }
#else
    for (int p = 0; p < N_PHASES; ++p) {
        a.ph_lo = p; a.ph_hi = p + 1;
        void* kargs[] = {&a}; hipError_t e = hipLaunchCooperativeKernel(kfn[PH_BIT(p)], dim3(grid), dim3(NTHR), kargs, LDS_BYTES, stream);
        if (e != hipSuccess) { fprintf(stderr, "cooperative launch %d failed: %s\n", p, hipGetErrorString(e)); break; }
    }
#endif
}
```

```cpp
#include <hip/hip_runtime.h>
#include <hip/hip_cooperative_groups.h>
#include <cstdio>
#include <cstdint>
namespace cg = cooperative_groups;

#ifndef MK_ONE_LAUNCH
#define MK_ONE_LAUNCH 1
#endif

#define GAS __attribute__((address_space(1)))
#define LAS __attribute__((address_space(3)))
typedef unsigned short bf16_t;
typedef short bf16x8 __attribute__((ext_vector_type(8)));
typedef float f32x4 __attribute__((ext_vector_type(4)));
typedef float f32x2 __attribute__((ext_vector_type(2)));
typedef unsigned u32x4 __attribute__((ext_vector_type(4)));
typedef unsigned u32x2 __attribute__((ext_vector_type(2)));

constexpr int T = 65536, DM = 1024, NB = 32, SEQ = 2048, CHK = 64, NCH = 32;
constexpr int NPROJ = 2816;
constexpr int C_QA = 0, C_CKV = 512, C_QI = 640, C_KI = 1152, C_U = 1216, C_V = 1728, C_Z = 2240, C_WI = 2752, C_IG = 2760, C_FG = 2764;
constexpr int IN_W = 2768;
constexpr int NEXP = 32, TOPE = 4, NROUND = 1, SPR = TOPE / NROUND;
constexpr int RCAP = SPR * T + NEXP * 256;
constexpr float LN_EPS = 1e-5f;
constexpr float DN_ALPHA = 1.189207115002721f;
constexpr int KSEL = 256;
constexpr float F8_ACT_S = 8.0f, F8_W_S = 128.0f;
constexpr int F8_ACT_E8 = 0x7c7c7c7c, F8_W_E8 = 0x78787878;
constexpr float F8_UNSCALE = 1.0f / (8.0f * 128.0f);

constexpr size_t MiB = 1u << 20;
constexpr size_t WS_CTL = 0, CTL_BYTES = 32 * 1024;
constexpr size_t WS_WIN = 1 * MiB;
constexpr size_t WS_WOUT = 7 * MiB;
constexpr size_t WS_WGU = 9 * MiB;
constexpr size_t WS_WD = 137 * MiB;
constexpr size_t WS_XB = 201 * MiB;
constexpr size_t WS_H1B = WS_XB;
constexpr size_t WS_PROJ = 329 * MiB;
constexpr size_t WS_PRE1 = WS_PROJ;
constexpr size_t WS_HB = WS_PROJ;
constexpr size_t WS_Y1 = 601 * MiB;
constexpr size_t WS_G32 = 681 * MiB;
constexpr size_t WS_CB = 685 * MiB;
constexpr size_t WS_MASK = 701 * MiB;
constexpr size_t WS_MIX = 717 * MiB;
constexpr size_t WS_TOPE = 857 * MiB;
constexpr size_t WS_GATE = 858 * MiB;
constexpr size_t WS_RANK = 859 * MiB;
constexpr size_t WS_RTOK = 933 * MiB;
constexpr size_t WS_RGATE = 941 * MiB;
constexpr int RT_STRIDE = T;
constexpr size_t WS_WRF = 868 * MiB + 512 * 1024;
constexpr size_t WS_WUKB = 864 * MiB;
constexpr size_t WS_WUVF = 865 * MiB;
constexpr size_t WS_WMQT = 866 * MiB;
constexpr size_t WS_WMKT = 867 * MiB;
constexpr size_t WS_BCNT = 868 * MiB;
constexpr size_t WS_H1Q = 869 * MiB;
constexpr size_t WS_END = 949 * MiB;
constexpr int CW_CNT = 64;
constexpr int CW_Q = 256;
constexpr int CW_BAR = 4096;

constexpr int RING_BYTES = 131072;
constexpr int LCTL_OFF = RING_BYTES;
constexpr int LDS_BYTES = 147456;
constexpr int NWAVES = 8, NTHR = 512;

__device__ __forceinline__ unsigned f2bf(float f) { unsigned u = __builtin_bit_cast(unsigned, f); return (u + 0x7fffu + ((u >> 16) & 1u)) >> 16; }
__device__ __forceinline__ unsigned pk2(float lo, float hi) { return f2bf(lo) | (f2bf(hi) << 16); }
typedef __bf16 bf16v2_t __attribute__((ext_vector_type(2)));
__device__ __forceinline__ unsigned cvtpk_c(float lo, float hi) { bf16v2_t v = {(__bf16)lo, (__bf16)hi}; return __builtin_bit_cast(unsigned, v); }
__device__ __forceinline__ unsigned f8x4(float a, float b, float c, float d) { int w = __builtin_amdgcn_cvt_pk_fp8_f32(a, b, 0, false); w = __builtin_amdgcn_cvt_pk_fp8_f32(c, d, w, true); return (unsigned)w; }
__device__ __forceinline__ float bf2f(unsigned h) { return __builtin_bit_cast(float, h << 16); }
__device__ __forceinline__ float relu_i(float x) { const int b = __builtin_bit_cast(int, x); return __builtin_bit_cast(float, b < 0 ? 0 : b); }
__device__ __forceinline__ float bflo(unsigned p) { return __builtin_bit_cast(float, p << 16); }
__device__ __forceinline__ float bfhi(unsigned p) { return __builtin_bit_cast(float, p & 0xffff0000u); }
template <int CTRL, int RM = 0xF> __device__ __forceinline__ float dppf(float old, float v) { return __builtin_bit_cast(float, __builtin_amdgcn_update_dpp(__builtin_bit_cast(int, old), __builtin_bit_cast(int, v), CTRL, RM, 0xF, false)); }
template <int CTRL, int RM = 0xF> __device__ __forceinline__ int dppi(int old, int v) { return __builtin_amdgcn_update_dpp(old, v, CTRL, RM, 0xF, false); }
__device__ __forceinline__ float rl(float v, int l) { return __builtin_bit_cast(float, __builtin_amdgcn_readlane(__builtin_bit_cast(int, v), l)); }
__device__ __forceinline__ float row_sum(float v) { v += dppf<0xB1>(v, v); v += dppf<0x4E>(v, v); v += dppf<0x141>(v, v); v += dppf<0x140>(v, v); return v; }
__device__ __forceinline__ float wave_sum(float v) { v = row_sum(v); return (rl(v, 0) + rl(v, 16)) + (rl(v, 32) + rl(v, 48)); }
__device__ __forceinline__ float wave_max(float v) {
    v = fmaxf(v, dppf<0xB1>(v, v)); v = fmaxf(v, dppf<0x4E>(v, v)); v = fmaxf(v, dppf<0x141>(v, v)); v = fmaxf(v, dppf<0x140>(v, v));
    return fmaxf(fmaxf(rl(v, 0), rl(v, 16)), fmaxf(rl(v, 32), rl(v, 48))); }
__device__ __forceinline__ int wave_min_i(int v) {
    v = min(v, dppi<0xB1>(v, v)); v = min(v, dppi<0x4E>(v, v)); v = min(v, dppi<0x141>(v, v)); v = min(v, dppi<0x140>(v, v));
    return min(min(__builtin_amdgcn_readlane(v, 0), __builtin_amdgcn_readlane(v, 16)), min(__builtin_amdgcn_readlane(v, 32), __builtin_amdgcn_readlane(v, 48))); }
__device__ __forceinline__ int half_sum_i(int v, int lane) { v += dppi<0xB1>(v, v); v += dppi<0x4E>(v, v); v += dppi<0x141>(v, v); v += dppi<0x140>(v, v);
    const int lo = __builtin_amdgcn_readlane(v, 0) + __builtin_amdgcn_readlane(v, 16), hi = __builtin_amdgcn_readlane(v, 32) + __builtin_amdgcn_readlane(v, 48); return (lane & 32) ? hi : lo; }
__device__ __forceinline__ unsigned half_max_u(unsigned v, int lane) { v = max(v, (unsigned)dppi<0xB1>((int)v, (int)v)); v = max(v, (unsigned)dppi<0x4E>((int)v, (int)v)); v = max(v, (unsigned)dppi<0x141>((int)v, (int)v)); v = max(v, (unsigned)dppi<0x140>((int)v, (int)v));
    const unsigned lo = max((unsigned)__builtin_amdgcn_readlane((int)v, 0), (unsigned)__builtin_amdgcn_readlane((int)v, 16)), hi = max((unsigned)__builtin_amdgcn_readlane((int)v, 32), (unsigned)__builtin_amdgcn_readlane((int)v, 48)); return (lane & 32) ? hi : lo; }
#ifndef DPP_SCAN
#define DPP_SCAN 1
#endif
#ifndef DPP_XCHG
#define DPP_XCHG 1
#endif
#if !DPP_SCAN
__device__ __forceinline__ float scan_add(float v) { const int ln = (int)__builtin_amdgcn_mbcnt_hi(~0u, __builtin_amdgcn_mbcnt_lo(~0u, 0u)); _Pragma("unroll") for (int o = 1; o < 64; o <<= 1) { const float t = __shfl_up(v, o); if (ln >= o) v += t; } return v; }
__device__ __forceinline__ float scan_max(float v) { const int ln = (int)__builtin_amdgcn_mbcnt_hi(~0u, __builtin_amdgcn_mbcnt_lo(~0u, 0u)); _Pragma("unroll") for (int o = 1; o < 64; o <<= 1) { const float t = __shfl_up(v, o); if (ln >= o) v = fmaxf(v, t); } return v; }
#else
__device__ __forceinline__ float scan_add(float v) { v += dppf<0x111>(0.f, v); v += dppf<0x112>(0.f, v); v += dppf<0x114>(0.f, v); v += dppf<0x118>(0.f, v); v += dppf<0x142, 0xA>(0.f, v); v += dppf<0x143, 0xC>(0.f, v); return v; }
__device__ __forceinline__ float scan_max(float v) { const float ni = -INFINITY;
    v = fmaxf(v, dppf<0x111>(ni, v)); v = fmaxf(v, dppf<0x112>(ni, v)); v = fmaxf(v, dppf<0x114>(ni, v)); v = fmaxf(v, dppf<0x118>(ni, v)); v = fmaxf(v, dppf<0x142, 0xA>(ni, v)); v = fmaxf(v, dppf<0x143, 0xC>(ni, v)); return v; }
#endif
template <int M> __device__ __forceinline__ float xchg(float v, int lane) {
#if !DPP_XCHG
    return __shfl_xor(v, M);
#endif
    if (M == 1) return dppf<0xB1>(v, v); if (M == 2) return dppf<0x4E>(v, v); if (M == 8) return dppf<0x128>(v, v);
    const float a = dppf<0x114>(v, v), b = dppf<0x104>(v, v); return (lane & 4) ? a : b; }
__device__ __forceinline__ int my_lane() { return (int)__builtin_amdgcn_mbcnt_hi(~0u, __builtin_amdgcn_mbcnt_lo(~0u, 0u)); }
__device__ __forceinline__ int launder(int v) { asm volatile("" : "+v"(v)); return v; }
__device__ __forceinline__ float sigmoidf_(float x) { return __builtin_amdgcn_rcpf(1.0f + __expf(-x)); }

namespace pg8 {
typedef int v4i_t __attribute__((ext_vector_type(4)));
typedef int v8i_t __attribute__((ext_vector_type(8)));
constexpr int BM = 256, BK = 64, HALF = 128, HTB = HALF * BK * 2, STAGE_BYTES = 8 * HTB, NXCD = 8, WGM = 8;
__host__ __device__ __forceinline__ int lds_byte(int r, int c) { const int st = (r >> 4) * 2 + (c >> 5), rr = r & 15, cc = c & 31, ob = rr * 64 + cc * 2; return st * 1024 + (ob ^ (((ob >> 9) & 1) << 5)); }
__host__ __device__ __forceinline__ void stage_rc(int b, int& R, int& C) { const int st = b / 1024, sb = b % 1024, swz = sb ^ (((sb >> 9) & 1) << 5); R = (st >> 1) * 16 + swz / 64; C = (st & 1) * 32 + (swz % 64) / 2; }
__host__ __device__ __forceinline__ int perm32(int rho) { const int n = rho >> 4, i = rho & 15; return 8 * (i >> 2) + 4 * n + (i & 3); }

struct Unit { int pm, pn, po, pe, pr; };
struct Gemm { const void* A; const void* Bt; int pa, pb, kb; const int* rtok; };

struct StaticOrder {
    int nM, nN, nwg, G, c;
    __device__ void init(int M, int N, int G_, int c_) { nM = M / BM; nN = N / BM; nwg = nM * nN; G = G_; c = c_; }
    __device__ bool next(int i, Unit& u) const {
        const long L = (long)i * G + c; if (L >= nwg) return false;
        int wgid = (int)L; { const int q = nwg / NXCD, r = nwg % NXCD, xcd = wgid % NXCD, off = wgid / NXCD; wgid = (xcd < r ? xcd * (q + 1) : r * (q + 1) + (xcd - r) * q) + off; }
        const int nig = WGM * nN, gid = wgid / nig, fm = gid * WGM, gsz = (nM - fm) < WGM ? (nM - fm) : WGM;
        u.pm = fm + ((wgid % nig) % gsz); u.pn = (wgid % nig) / gsz; u.po = u.pn; u.pe = 0; return true;
    }
};

__device__ __forceinline__ unsigned cvt_pk_bf16(float lo, float hi) { return cvtpk_c(lo, hi); }

template <class Epi, class Sched, bool GATHER = false, bool FP8 = false>
__device__ __forceinline__ void gemm_phase(LAS unsigned char* lds, const Gemm g, const Sched& S, const Epi& E, int wave_id) {
    int lane_ = my_lane(); asm volatile("" : "+v"(lane_));
    const int wid = wave_id, lane = lane_, tid = wid * 64 + lane;
    const int wr = wid >> 2, wc = wid & 3, fr = lane & 15, fq = lane >> 4;
    const int nt = g.kb / (BK * 2);
    unsigned voffB[2]; int RA[2], CA[2];
#pragma unroll
    for (int i = 0; i < 2; ++i) { int R, C; stage_rc(tid * 16 + i * 8192, R, C); const int Rb = Epi::PERM == 2 ? (64 * (R >> 5) + 16 * ((R >> 2) & 3) + 4 * ((R >> 4) & 1) + (R & 3)) : Epi::PERM ? ((R & ~31) + perm32(R & 31)) : R;
        RA[i] = R; CA[i] = C; voffB[i] = (unsigned)(Rb * g.pb + C * 2); }
    unsigned cvo[2][2], nvo[2][2];
#define PG8_SETVO(vo, u) do { _Pragma("unroll") for (int h_ = 0; h_ < 2; ++h_) _Pragma("unroll") for (int i_ = 0; i_ < 2; ++i_) { \
        if (GATHER) { int tk_ = g.rtok[(u).pr + h_ * 128 + RA[i_]]; tk_ = tk_ < 0 ? 0 : (tk_ & 0xffff); vo[h_][i_] = (unsigned)(tk_ * g.pa + CA[i_] * 2); } \
        else vo[h_][i_] = (unsigned)((h_ * 128 + RA[i_]) * g.pa + CA[i_] * 2); } } while (0)
    const unsigned kstep = (unsigned)(BK * 2);
    const unsigned hstepB = (Epi::PERM == 2 ? 8u : (unsigned)HALF) * g.pb;
    const unsigned tstepA = GATHER ? 0u : 2u * HALF * g.pa, tstepB = 2u * HALF * g.pb;
    const auto rsA = __builtin_amdgcn_make_buffer_rsrc((void*)g.A, 0, -1, 0x00020000);
    const auto rsB = __builtin_amdgcn_make_buffer_rsrc((void*)g.Bt, 0, -1, 0x00020000);
    const unsigned ldsw = (unsigned)wid * 1024u;
    const int aoff = lds_byte(wr * 64 + fr, fq * 8), boff = lds_byte(wc * 32 + fr, fq * 8);
#define PG8_SA(b, h) (((b) * 2 + (h)) * HTB)
#define PG8_SB(b, h) ((4 + (b) * 2 + (h)) * HTB)
#define PG8_STAGEA(bufoff, soff, voff) do { _Pragma("unroll") for (int _i = 0; _i < 2; ++_i) \
        __builtin_amdgcn_raw_ptr_buffer_load_lds(rsA, (LAS unsigned*)(lds + (bufoff) + ldsw + _i * 8192), 16, (voff)[_i], (soff), 0, 0); } while (0)
#define PG8_STAGEB(bufoff, soff, voff) do { _Pragma("unroll") for (int _i = 0; _i < 2; ++_i) \
        __builtin_amdgcn_raw_ptr_buffer_load_lds(rsB, (LAS unsigned*)(lds + (bufoff) + ldsw + _i * 8192), 16, (voff)[_i], (soff), 0, 0); } while (0)
#define PG8_LD8(p) __builtin_shufflevector(*(const LAS v4i_t*)(p), *(const LAS v4i_t*)((p) + 1024), 0, 1, 2, 3, 4, 5, 6, 7)
#define PG8_LDA(dst, b, h) do { _Pragma("unroll") for (int m = 0; m < 4; ++m) dst[m] = PG8_LD8(lds + PG8_SA(b, h) + aoff + m * 2048); } while (0)
#define PG8_LDB(dst, b, h) do { _Pragma("unroll") for (int n = 0; n < 2; ++n) dst[n] = PG8_LD8(lds + PG8_SB(b, h) + boff + n * 2048); } while (0)
#define PG8_LO(X) __builtin_bit_cast(bf16x8, __builtin_shufflevector(X, X, 0, 1, 2, 3))
#define PG8_HI(X) __builtin_bit_cast(bf16x8, __builtin_shufflevector(X, X, 4, 5, 6, 7))
#define PG8_MMA(ai, bj, At, Bt) do { __builtin_amdgcn_s_setprio(1); _Pragma("unroll") for (int m = 0; m < 4; ++m) _Pragma("unroll") for (int n = 0; n < 2; ++n) { \
        if (FP8) acc[ai][bj][m][n] = __builtin_amdgcn_mfma_scale_f32_16x16x128_f8f6f4(Bt[n], At[m], acc[ai][bj][m][n], 0, 0, 0, 0, 0, 0);     \
        else { acc[ai][bj][m][n] = __builtin_amdgcn_mfma_f32_16x16x32_bf16(PG8_LO(Bt[n]), PG8_LO(At[m]), acc[ai][bj][m][n], 0, 0, 0); \
               acc[ai][bj][m][n] = __builtin_amdgcn_mfma_f32_16x16x32_bf16(PG8_HI(Bt[n]), PG8_HI(At[m]), acc[ai][bj][m][n], 0, 0, 0); } } \
        __builtin_amdgcn_s_setprio(0); } while (0)
#define PG8_WAIT_V(n) asm volatile("s_waitcnt vmcnt(" #n ")" ::: "memory")
#define PG8_WAIT_L(n) asm volatile("s_waitcnt lgkmcnt(" #n ")" ::: "memory")
#define PG8_BAR __builtin_amdgcn_s_barrier()
#define PG8_SCHED __builtin_amdgcn_sched_barrier(0)
    Unit cur, nxt; int ui = 0;
    if (!S.next(0, cur)) return;
    f32x4 acc[2][2][4][2];
#pragma unroll
    for (int a = 0; a < 2; ++a)
#pragma unroll
        for (int b = 0; b < 2; ++b)
#pragma unroll
            for (int m = 0; m < 4; ++m)
#pragma unroll
                for (int n = 0; n < 2; ++n) acc[a][b][m][n] = (f32x4){0.f, 0.f, 0.f, 0.f};
    v8i_t At[4], B0[2], B1[2];
    unsigned cA = (unsigned)cur.pm * tstepA, cB = (unsigned)cur.pn * tstepB;
    PG8_SETVO(cvo, cur);
    PG8_STAGEB(PG8_SB(0, 0), cB, voffB); PG8_STAGEB(PG8_SB(0, 1), cB + hstepB, voffB); PG8_STAGEA(PG8_SA(0, 0), cA, cvo[0]); PG8_STAGEA(PG8_SA(0, 1), cA, cvo[1]);
    if (wr == 1) PG8_BAR;
    PG8_WAIT_V(2); PG8_BAR;
    PG8_STAGEB(PG8_SB(1, 0), cB + kstep, voffB); PG8_STAGEA(PG8_SA(1, 0), cA + kstep, cvo[0]); PG8_STAGEB(PG8_SB(1, 1), cB + hstepB + kstep, voffB);
    PG8_WAIT_V(6); PG8_BAR;
    for (;;) {
        const bool has_next = S.next(ui + 1, nxt);
        const unsigned nA = has_next ? (unsigned)nxt.pm * tstepA : cA, nB = has_next ? (unsigned)nxt.pn * tstepB : cB;
        if (GATHER) { if (has_next) PG8_SETVO(nvo, nxt); else { _Pragma("unroll") for (int h_ = 0; h_ < 2; ++h_) _Pragma("unroll") for (int i_ = 0; i_ < 2; ++i_) nvo[h_][i_] = cvo[h_][i_]; } }
#pragma unroll 1
        for (int t = 0; t < nt; t += 2) {
            const bool last = (t == nt - 2);
            unsigned v2[2][2];
#pragma unroll
            for (int h_ = 0; h_ < 2; ++h_)
#pragma unroll
                for (int i_ = 0; i_ < 2; ++i_) v2[h_][i_] = (GATHER && last) ? nvo[h_][i_] : cvo[h_][i_];
            const unsigned a1 = cA + (unsigned)(t + 1) * kstep;
            const unsigned a2 = last ? nA : cA + (unsigned)(t + 2) * kstep, b2 = last ? nB : cB + (unsigned)(t + 2) * kstep;
            const unsigned a3 = a2 + kstep, b3 = b2 + kstep;
            PG8_LDB(B0, 0, 0); PG8_LDB(B1, 0, 1); PG8_SCHED; PG8_LDA(At, 0, 0); PG8_STAGEA(PG8_SA(1, 1), a1, cvo[1]);
            PG8_WAIT_V(8); PG8_WAIT_L(0); PG8_BAR; PG8_MMA(0, 0, At, B0); PG8_MMA(0, 1, At, B1); PG8_BAR; PG8_SCHED;
            PG8_LDA(At, 0, 1); PG8_STAGEB(PG8_SB(0, 0), b2, voffB); PG8_STAGEB(PG8_SB(0, 1), b2 + hstepB, voffB); PG8_STAGEA(PG8_SA(0, 0), a2, v2[0]);
            PG8_WAIT_V(8); PG8_WAIT_L(0); PG8_BAR; PG8_MMA(1, 0, At, B0); PG8_MMA(1, 1, At, B1); PG8_BAR; PG8_SCHED;
            PG8_LDB(B0, 1, 0); PG8_LDB(B1, 1, 1); PG8_SCHED; PG8_LDA(At, 1, 0); PG8_STAGEA(PG8_SA(0, 1), a2, v2[1]);
            PG8_WAIT_V(8); PG8_WAIT_L(0); PG8_BAR; PG8_MMA(0, 0, At, B0); PG8_MMA(0, 1, At, B1); PG8_BAR; PG8_SCHED;
            PG8_LDA(At, 1, 1); PG8_STAGEB(PG8_SB(1, 0), b3, voffB); PG8_STAGEB(PG8_SB(1, 1), b3 + hstepB, voffB); PG8_STAGEA(PG8_SA(1, 0), a3, v2[0]);
            PG8_WAIT_V(8); PG8_WAIT_L(0); PG8_BAR; PG8_MMA(1, 0, At, B0); PG8_MMA(1, 1, At, B1); PG8_BAR; PG8_SCHED;
        }
        if (wr == 0) PG8_BAR;
        E(acc, cur, wr, wc, fr, fq);
        if (!has_next) break;
#pragma unroll
        for (int a = 0; a < 2; ++a)
#pragma unroll
            for (int b = 0; b < 2; ++b)
#pragma unroll
                for (int m = 0; m < 4; ++m)
#pragma unroll
                    for (int n = 0; n < 2; ++n) acc[a][b][m][n] = (f32x4){0.f, 0.f, 0.f, 0.f};
        cur = nxt; cA = nA; cB = nB; ++ui;
        if (GATHER) { _Pragma("unroll") for (int h_ = 0; h_ < 2; ++h_) _Pragma("unroll") for (int i_ = 0; i_ < 2; ++i_) cvo[h_][i_] = nvo[h_][i_]; }
        if (wr == 1) PG8_BAR;
    }
    PG8_WAIT_V(0);
    PG8_BAR;
#undef PG8_SETVO
#undef PG8_LD8
#undef PG8_LO
#undef PG8_HI
#undef PG8_SA
#undef PG8_SB
#undef PG8_STAGEA
#undef PG8_STAGEB
#undef PG8_LDA
#undef PG8_LDB
#undef PG8_MMA
#undef PG8_WAIT_V
#undef PG8_WAIT_L
#undef PG8_BAR
#undef PG8_SCHED
}
}

struct Args {
    const float* in[23];
    float* out; unsigned char* ws;
    int ph_lo, ph_hi;
};
struct Frame {
    LAS unsigned char* lds;
    int tid, lane, wave, G, bid;
};
#define F_in(k) (args.in[k])
#define F_x F_in(0)
#define F_w_in F_in(1)
#define F_kv_norm_g F_in(2)
#define F_w_uk F_in(3)
#define F_w_uv F_in(4)
#define F_m_conv_w F_in(5)
#define F_m_conv_b F_in(6)
#define F_w_mq F_in(7)
#define F_w_mk F_in(8)
#define F_b_i F_in(9)
#define F_b_f F_in(10)
#define F_m_norm_g F_in(11)
#define F_w_out F_in(12)
#define F_ln1_g F_in(13)
#define F_ln1_b F_in(14)
#define F_w_router F_in(15)
#define F_b_router F_in(16)
#define F_w_gu F_in(17)
#define F_b_gu F_in(18)
#define F_w_down F_in(19)
#define F_b_down F_in(20)
#define F_ln2_g F_in(21)
#define F_ln2_b F_in(22)
#define F_out (args.out)
#define F_ctl ((unsigned*)(args.ws + WS_CTL))
#define F_WinT ((bf16_t*)(args.ws + WS_WIN))
#define F_WoutT ((bf16_t*)(args.ws + WS_WOUT))
#define F_WguT ((bf16_t*)(args.ws + WS_WGU))
#define F_WdT ((bf16_t*)(args.ws + WS_WD))
#define F_xb ((bf16_t*)(args.ws + WS_XB))
#define F_h1b ((bf16_t*)(args.ws + WS_H1B))
#define F_projb ((bf16_t*)(args.ws + WS_PROJ))
#define F_cb ((bf16_t*)(args.ws + WS_CB))
#define F_mix ((bf16_t*)(args.ws + WS_MIX))
#define F_y1 ((float*)(args.ws + WS_Y1))
#define F_hb ((unsigned char*)(args.ws + WS_HB))
#define F_g32 ((float*)(args.ws + WS_G32))
#define F_pre1 ((float*)(args.ws + WS_PRE1))
#define F_gate ((float*)(args.ws + WS_GATE))
#define F_rgate ((float*)(args.ws + WS_RGATE))
#define F_mask ((unsigned*)(args.ws + WS_MASK))
#define F_tope ((int*)(args.ws + WS_TOPE))
#define F_rank ((int*)(args.ws + WS_RANK))
#define F_rtok ((int*)(args.ws + WS_RTOK))
#define F_wukb ((bf16_t*)(args.ws + WS_WUKB))
#define F_wuvf ((bf16_t*)(args.ws + WS_WUVF))
#define F_wmqT ((bf16_t*)(args.ws + WS_WMQT))
#define F_wmkT ((bf16_t*)(args.ws + WS_WMKT))
#define F_bcnt ((int*)(args.ws + WS_BCNT))
#define F_wrf ((bf16_t*)(args.ws + WS_WRF))
#define F_h1q ((unsigned char*)(args.ws + WS_H1Q))

__device__ __forceinline__ int in_map(int n) {
    if (n < 1216) return n;
    if (n < 2752) return n + 8;
    if (n < 2760) return n - 2752 + 1216;
    if (n < 2768) return n;
    return -1;
}
template <int MODE>
__device__ __forceinline__ void ti_load(float (&r)[32], const float* W, int Norig, int kb, int nb, int lane) {
    const int k0 = 64 * kb, nn = 32 * nb + (lane & 31);
    int oc;
    if (MODE == 0) oc = nn;
    else if (MODE == 1) oc = in_map(nn);
    else { const int pn = nn >> 8, half = (nn >> 7) & 1, i = nn & 127; oc = half * 1024 + pn * 128 + i; }
    const float* src = W + (size_t)(k0 + (lane >> 5)) * Norig + (oc >= 0 ? oc : 0);
#pragma unroll
    for (int i = 0; i < 32; ++i) { const float v = src[(size_t)(2 * i) * Norig]; r[i] = (MODE == 1 && oc < 0) ? 0.f : v; }
}
template <bool OUT8>
__device__ __forceinline__ void ti_store(const float (&r)[32], int K, bf16_t* WT, LAS float* scr, int kb, int nb, int lane) {
    const int k0 = 64 * kb, n0 = 32 * nb;
#pragma unroll
    for (int i = 0; i < 32; ++i) { const int kk = 2 * i + (lane >> 5); scr[kk * 33 + (lane & 31)] = r[i]; }
    asm volatile("s_waitcnt lgkmcnt(0)" ::: "memory");
    const int c = lane & 7;
#pragma unroll
    for (int j = 0; j < 4; ++j) { const int n = (lane >> 3) + 8 * j; const LAS float* s = scr + (8 * c) * 33 + n;
        if (OUT8) { u32x2 o; o.x = f8x4(s[0 * 33] * F8_W_S, s[1 * 33] * F8_W_S, s[2 * 33] * F8_W_S, s[3 * 33] * F8_W_S); o.y = f8x4(s[4 * 33] * F8_W_S, s[5 * 33] * F8_W_S, s[6 * 33] * F8_W_S, s[7 * 33] * F8_W_S);
            *(u32x2*)((unsigned char*)WT + (size_t)(n0 + n) * K + k0 + 8 * c) = o; }
        else { u32x4 o; o.x = pk2(s[0 * 33], s[1 * 33]); o.y = pk2(s[2 * 33], s[3 * 33]); o.z = pk2(s[4 * 33], s[5 * 33]); o.w = pk2(s[6 * 33], s[7 * 33]);
            *(u32x4*)(WT + (size_t)(n0 + n) * K + k0 + 8 * c) = o; } }
    asm volatile("s_waitcnt lgkmcnt(0)" ::: "memory");
}
template <int MODE>
__device__ __forceinline__ void ti8_load(float (&r)[64], const float* W, int Norig, int kb, int nb, int lane) {
    const int k0 = 128 * kb, nn = 32 * nb + (lane & 31);
    int oc;
    if (MODE == 0) oc = nn;
    else { const int pn = nn >> 8, half = (nn >> 7) & 1, i = nn & 127; oc = half * 1024 + pn * 128 + i; }
    const auto rs = __builtin_amdgcn_make_buffer_rsrc((void*)W, 0, -1, 0x00020000);
    const unsigned vo = (unsigned)(((k0 + (lane >> 5)) * Norig + oc) * 4);
#pragma unroll
    for (int i = 0; i < 64; ++i) r[i] = __builtin_bit_cast(float, __builtin_amdgcn_raw_buffer_load_b32(rs, vo, (unsigned)(2 * i * Norig * 4), 2));
}
__device__ __forceinline__ void ti8_store(const float (&r)[64], int K, unsigned char* WT, LAS float* scr, int kb, int nb, int lane) {
    const int k0 = 128 * kb, n0 = 32 * nb;
#pragma unroll
    for (int i = 0; i < 64; ++i) { const int kk = 2 * i + (lane >> 5); scr[kk * 32 + ((lane & 31) ^ (((kk >> 3) & 7) << 2))] = r[i]; }
    asm volatile("s_waitcnt lgkmcnt(0)" ::: "memory");
    const int c = lane & 15;
#pragma unroll
    for (int j = 0; j < 8; ++j) { const int n = (lane >> 4) + 4 * j; const LAS float* s = scr + (8 * c) * 32 + (n ^ ((c & 7) << 2));
        u32x2 o; o.x = f8x4(s[0 * 32] * F8_W_S, s[1 * 32] * F8_W_S, s[2 * 32] * F8_W_S, s[3 * 32] * F8_W_S); o.y = f8x4(s[4 * 32] * F8_W_S, s[5 * 32] * F8_W_S, s[6 * 32] * F8_W_S, s[7 * 32] * F8_W_S);
        __builtin_nontemporal_store(o, (u32x2*)(WT + (size_t)(n0 + n) * K + k0 + 8 * c)); }
    asm volatile("s_waitcnt lgkmcnt(0)" ::: "memory");
}
constexpr int XC_GU = NEXP * 8 * 64, XC_D = NEXP * 8 * 32, XC_ITEMS = (XC_GU + XC_D) / 32;
template <bool GU>
__device__ __forceinline__ void expert_convert_quad(const Args& args, const Frame& F0, int w0) {
    struct { LAS unsigned char* lds; int lane, wave; } F; F.lds = F0.lds; F.wave = F0.wave; F.lane = launder(F0.lane);
    LAS float* scr = (LAS float*)(F.lds + F.wave * 16896);
#define XC_LOAD(R, WI) do { if (GU) { const int e_ = (WI) / (8 * 64), q_ = (WI) % (8 * 64); ti8_load<2>(R, F_w_gu + (size_t)e_ * DM * 2048, 2048, q_ / 64, q_ % 64, F.lane); } \
        else { const int e_ = (WI) / (8 * 32), q_ = (WI) % (8 * 32); ti8_load<0>(R, F_w_down + (size_t)e_ * DM * DM, DM, q_ / 32, q_ % 32, F.lane); } } while (0)
#define XC_STORE(R, WI) do { if (GU) { const int e_ = (WI) / (8 * 64), q_ = (WI) % (8 * 64); ti8_store(R, DM, (unsigned char*)F_WguT + (size_t)e_ * 2048 * DM, scr, q_ / 64, q_ % 64, F.lane); } \
        else { const int e_ = (WI) / (8 * 32), q_ = (WI) % (8 * 32); ti8_store(R, DM, (unsigned char*)F_WdT + (size_t)e_ * DM * DM, scr, q_ / 32, q_ % 32, F.lane); } } while (0)
    float va[64], vb[64];
    XC_LOAD(va, w0); XC_LOAD(vb, w0 + 8); __builtin_amdgcn_sched_barrier(0);
    XC_STORE(va, w0); __builtin_amdgcn_sched_barrier(0); XC_LOAD(va, w0 + 16); __builtin_amdgcn_sched_barrier(0);
    XC_STORE(vb, w0 + 8); __builtin_amdgcn_sched_barrier(0); XC_LOAD(vb, w0 + 24); __builtin_amdgcn_sched_barrier(0);
    XC_STORE(va, w0 + 16); __builtin_amdgcn_sched_barrier(0); XC_STORE(vb, w0 + 24);
#undef XC_LOAD
#undef XC_STORE
}
__device__ __forceinline__ void expert_convert_item(const Args& args, Frame& F, int item) {
    const int w0 = (item * 4) * 8 + F.wave;
    if (w0 < XC_GU) expert_convert_quad<true>(args, F, w0); else expert_convert_quad<false>(args, F, w0 - XC_GU);
}
__device__ __forceinline__ void p0_prologue(const Args& args, Frame& F) {
    LAS float* scr = (LAS float*)(F.lds + F.wave * 16896);
    const int gw = F.bid * NWAVES + F.wave, NGW = F.G * NWAVES;
    constexpr int I_IN = 16 * (NPROJ / 32), I_OUT = 16 * 32;
    for (int r = gw; r < I_IN + I_OUT; r += NGW) { float v[32];
        if (r < I_IN) { const int nbk = NPROJ / 32; ti_load<1>(v, F_w_in, IN_W, r / nbk, r % nbk, F.lane); ti_store<false>(v, DM, F_WinT, scr, r / nbk, r % nbk, F.lane); }
        else { const int q = r - I_IN; ti_load<0>(v, F_w_out, DM, q / 32, q % 32, F.lane); ti_store<false>(v, DM, F_WoutT, scr, q / 32, q % 32, F.lane); } }
    { const int gtid = F.bid * NTHR + F.tid, NT_ = F.G * NTHR;
      for (int i = gtid; i < 8 * 128 * 64; i += NT_) F_wukb[i] = (bf16_t)f2bf(F_w_uk[i] * 0.125f);
      for (int i = gtid; i < 4 * 128 * 128; i += NT_) { const int d = i & 127, e = (i >> 7) & 127, h = i >> 14;
          F_wmqT[i] = (bf16_t)f2bf(F_w_mq[((size_t)h * 128 + d) * 128 + e]); F_wmkT[i] = (bf16_t)f2bf(F_w_mk[((size_t)h * 128 + d) * 128 + e] * 0.08838834764831845f); }
      for (int i = gtid; i < 8 * 2 * 4 * 2 * 64 * 8; i += NT_) { const int j = i & 7, ln = (i >> 3) & 63, sx = (i >> 9) & 1, d0 = (i >> 10) & 3, dt = (i >> 12) & 1, h = i >> 13;
          const int hi = ln >> 5, r32 = ln & 31; const int lat = 32 * d0 + 16 * sx + 8 * (j >> 2) + 4 * hi + (j & 3), dd = 32 * dt + r32;
          F_wuvf[i] = (bf16_t)f2bf(F_w_uv[((size_t)h * 128 + lat) * 64 + dd]); }
      for (int i = gtid; i < 64 * 64 * 8; i += NT_) { const int j = i & 7, ln = (i >> 3) & 63, ks = i >> 9; const int e = ln & 31, hi = ln >> 5;
          const int d = 64 * (ks >> 2) + 32 * hi + 8 * (ks & 3) + j; const float w = F_w_router[d * NEXP + e]; const unsigned h = f2bf(w);
          F_wrf[i] = (bf16_t)h; F_wrf[32768 + i] = (bf16_t)f2bf(w - __builtin_bit_cast(float, h << 16)); } }
    for (int m = gw; m < T; m += 2 * NGW) {
        const int m2 = (m + NGW < T) ? m + NGW : m;
        const f32x4* xr = (const f32x4*)(F_x + (size_t)m * DM) + F.lane; const f32x4* xr2 = (const f32x4*)(F_x + (size_t)m2 * DM) + F.lane;
        f32x4 v[4], w2[4];
#pragma unroll
        for (int j = 0; j < 4; ++j) { v[j] = __builtin_nontemporal_load(&xr[64 * j]); w2[j] = __builtin_nontemporal_load(&xr2[64 * j]); }
        u32x2* o = (u32x2*)(F_xb + (size_t)m * DM) + F.lane; u32x2* o2 = (u32x2*)(F_xb + (size_t)m2 * DM) + F.lane;
#pragma unroll
        for (int j = 0; j < 4; ++j) { u32x2 w; w.x = pk2(v[j].x, v[j].y); w.y = pk2(v[j].z, v[j].w); o[64 * j] = w; }
#pragma unroll
        for (int j = 0; j < 4; ++j) { u32x2 w; w.x = pk2(w2[j].x, w2[j].y); w.y = pk2(w2[j].z, w2[j].w); o2[64 * j] = w; }
    }
}

struct EpiProj {
    static constexpr int PERM = 2;
    bf16_t* O; float* g32;
    __device__ __forceinline__ void operator()(const f32x4 (&acc)[2][2][4][2], const pg8::Unit& u, int wr, int wc, int fr, int fq) const {
        const int row0 = u.pm * 256 + wr * 64 + fr, col0 = u.po * 256 + wc * 64 + 16 * fq;
#pragma unroll
        for (int ai = 0; ai < 2; ++ai)
#pragma unroll
            for (int m = 0; m < 4; ++m) { const int row = row0 + ai * 128 + m * 16;
#pragma unroll
                for (int bj = 0; bj < 2; ++bj) { const f32x4 v0 = acc[ai][bj][m][0], v1 = acc[ai][bj][m][1];
                    u32x4 w; w.x = pg8::cvt_pk_bf16(v0[0], v0[1]); w.y = pg8::cvt_pk_bf16(v0[2], v0[3]); w.z = pg8::cvt_pk_bf16(v1[0], v1[1]); w.w = pg8::cvt_pk_bf16(v1[2], v1[3]);
                    *(u32x4*)(O + (size_t)row * NPROJ + col0 + 8 * bj) = w;
                    if (col0 == C_WI) { float* gp = g32 + (size_t)row * 16 + 8 * bj; *(f32x4*)gp = v0; *(f32x4*)(gp + 4) = v1; } } }
    }
};
struct EpiOut {
    static constexpr int PERM = 2;
    bf16_t* O;
    __device__ __forceinline__ void operator()(const f32x4 (&acc)[2][2][4][2], const pg8::Unit& u, int wr, int wc, int fr, int fq) const {
        const int row0 = u.pm * 256 + wr * 64 + fr, col0 = u.po * 256 + wc * 64 + 16 * fq;
#pragma unroll
        for (int ai = 0; ai < 2; ++ai)
#pragma unroll
            for (int m = 0; m < 4; ++m) { const int row = row0 + ai * 128 + m * 16;
#pragma unroll
                for (int bj = 0; bj < 2; ++bj) { const f32x4 v0 = acc[ai][bj][m][0], v1 = acc[ai][bj][m][1];
                    u32x4 w; w.x = cvtpk_c(v0[0], v0[1]); w.y = cvtpk_c(v0[2], v0[3]); w.z = cvtpk_c(v1[0], v1[1]); w.w = cvtpk_c(v1[2], v1[3]);
                    *(u32x4*)(O + (size_t)row * DM + col0 + 8 * bj) = w; } }
    }
};
struct EpiGU {
    static constexpr int PERM = 1;
    unsigned char* H; const float* b_gu;
    __device__ __forceinline__ u32x2 one(const f32x4 (&acc)[2][2][4][2], int ai, int m, const f32x4 (&bgv)[2], const f32x4 (&buv)[2]) const {
        f32x2 hv[4];
#pragma unroll
        for (int n = 0; n < 2; ++n)
#pragma unroll
            for (int i = 0; i < 2; ++i) {
                f32x2 gt = __builtin_elementwise_fma(f32x2{acc[ai][0][m][n][2 * i], acc[ai][0][m][n][2 * i + 1]}, f32x2{F8_UNSCALE, F8_UNSCALE}, f32x2{bgv[n][2 * i], bgv[n][2 * i + 1]});
                f32x2 up = __builtin_elementwise_fma(f32x2{acc[ai][1][m][n][2 * i], acc[ai][1][m][n][2 * i + 1]}, f32x2{F8_UNSCALE, F8_UNSCALE}, f32x2{buv[n][2 * i], buv[n][2 * i + 1]});
                gt.x = fminf(gt.x, 7.0f); gt.y = fminf(gt.y, 7.0f);
                up.x = __builtin_amdgcn_fmed3f(up.x, -7.0f, 7.0f); up.y = __builtin_amdgcn_fmed3f(up.y, -7.0f, 7.0f);
                const f32x2 ea = gt * f32x2{-1.702f * 1.4426950408889634f, -1.702f * 1.4426950408889634f};
                f32x2 den = f32x2{__builtin_amdgcn_exp2f(ea.x), __builtin_amdgcn_exp2f(ea.y)} + f32x2{1.0f, 1.0f};
                const f32x2 rc = {__builtin_amdgcn_rcpf(den.x), __builtin_amdgcn_rcpf(den.y)};
                const f32x2 u8 = __builtin_elementwise_fma(up, f32x2{F8_ACT_S, F8_ACT_S}, f32x2{F8_ACT_S, F8_ACT_S});
                hv[n * 2 + i] = u8 * (gt * rc); }
        u32x2 w; w.x = f8x4(hv[0].x, hv[0].y, hv[1].x, hv[1].y); w.y = f8x4(hv[2].x, hv[2].y, hv[3].x, hv[3].y);
        return w;
    }
    __device__ __forceinline__ void operator()(const f32x4 (&acc)[2][2][4][2], const pg8::Unit& u, int wr, int wc, int fr, int fq) const {
        const int hc = u.po * 128 + wc * 32 + 8 * fq;
        const float* bg = b_gu + (size_t)u.pe * 2048 + hc;
        f32x4 bgv[2], buv[2];
#pragma unroll
        for (int n = 0; n < 2; ++n) { bgv[n] = *(const f32x4*)(bg + 4 * n); buv[n] = *(const f32x4*)(bg + 1024 + 4 * n); }
        unsigned char* base = H + (size_t)(u.pm * 256 + wr * 64 + fr + 16 * (fq & 1)) * DM + u.po * 128 + wc * 32 + 8 * (fq & 2);
#pragma unroll
        for (int ai = 0; ai < 2; ++ai)
#pragma unroll
            for (int mp = 0; mp < 2; ++mp) { u32x2 a = one(acc, ai, 2 * mp, bgv, buv), b = one(acc, ai, 2 * mp + 1, bgv, buv);
                asm volatile("s_nop 1\n\tv_permlane16_swap_b32 %0, %1" : "+v"(a.x), "+v"(b.x));
                asm volatile("s_nop 1\n\tv_permlane16_swap_b32 %0, %1" : "+v"(a.y), "+v"(b.y));
                *(u32x4*)(base + (size_t)(ai * 128 + mp * 32) * DM) = (u32x4){a.x, a.y, b.x, b.y}; }
    }
};
constexpr float F8_Y_S = 64.0f;
struct EpiDown {
    static constexpr int PERM = 2;
    unsigned char* Y; const float* b_down; const int* rtok; const float* rgate;
    __device__ __forceinline__ void operator()(const f32x4 (&acc)[2][2][4][2], const pg8::Unit& u, int wr, int wc, int fr, int fq) const {
        const int row0 = u.pr + wr * 64 + fr, col0 = u.po * 256 + wc * 64 + 16 * fq;
        const float* bd = b_down + (size_t)u.pe * DM + col0;
        f32x4 bv[2][2];
#pragma unroll
        for (int bj = 0; bj < 2; ++bj)
#pragma unroll
            for (int n = 0; n < 2; ++n) bv[bj][n] = *(const f32x4*)(bd + bj * 8 + 4 * n);
        int tvs[2][4]; float gts[2][4];
#pragma unroll
        for (int ai = 0; ai < 2; ++ai)
#pragma unroll
            for (int m = 0; m < 4; ++m) { tvs[ai][m] = rtok[row0 + ai * 128 + m * 16]; gts[ai][m] = rgate[row0 + ai * 128 + m * 16]; }
#pragma unroll
        for (int ai = 0; ai < 2; ++ai)
#pragma unroll
            for (int m = 0; m < 4; ++m) { const int tv = tvs[ai][m]; const float gt = gts[ai][m] * F8_Y_S;
                if (tv >= 0) { unsigned char* yp = Y + (size_t)(tv & 0xffff) * 4096 + ((tv >> 16) & 3) * 1024 + col0;
                    const f32x4 v0 = (acc[ai][0][m][0] * F8_UNSCALE + bv[0][0]) * gt, v1 = (acc[ai][0][m][1] * F8_UNSCALE + bv[0][1]) * gt, v2 = (acc[ai][1][m][0] * F8_UNSCALE + bv[1][0]) * gt, v3 = (acc[ai][1][m][1] * F8_UNSCALE + bv[1][1]) * gt;
                    u32x4 w; w.x = f8x4(v0[0], v0[1], v0[2], v0[3]); w.y = f8x4(v1[0], v1[1], v1[2], v1[3]); w.z = f8x4(v2[0], v2[1], v2[2], v2[3]); w.w = f8x4(v3[0], v3[1], v3[2], v3[3]);
                    *(u32x4*)yp = w; } }
    }
};
struct MoeOrder {
    const LAS int* offs; int npn, G, c, ntiles, xc, cb, bpx;
    __device__ void init(const LAS int* offs_, int npn_, int G_, int c_) { offs = offs_; npn = npn_; G = G_; c = c_; ntiles = offs_[NEXP] >> 8;
        if ((G_ & 7) == 0) { xc = c_ & 7; cb = c_ >> 3; bpx = G_ >> 3; } else { xc = 0; cb = c_; bpx = G_; } }
    __device__ bool next(int i, pg8::Unit& u) const {
        const int k = i * bpx + cb; const int nx = ((G & 7) == 0) ? 8 : 1;
        const int pm = nx * (k / npn) + xc, pnl = k % npn; if (pm >= ntiles) return false;
        int e = 0;
        for (int q = 1; q < NEXP; ++q) e += (offs[q] <= pm * 256) ? 1 : 0;
        u.pm = pm; u.pn = e * npn + pnl; u.po = pnl; u.pe = e; u.pr = e * RT_STRIDE + pm * 256 - offs[e]; return true;
    }
};

__device__ __forceinline__ void p2_cb(const Args& args, Frame& F) {
    const int gw = F.bid * NWAVES + F.wave, NGW = F.G * NWAVES;
    const float g0 = F_kv_norm_g[2 * F.lane], g1 = F_kv_norm_g[2 * F.lane + 1];
    for (int tok = gw; tok < T; tok += 8 * NGW) {
        unsigned pv[8];
#pragma unroll
        for (int j = 0; j < 8; ++j) { const int tj = tok + j * NGW; pv[j] = *(const unsigned*)(F_projb + (size_t)(tj < T ? tj : tok) * NPROJ + C_CKV + 2 * F.lane); }
#pragma unroll
        for (int j = 0; j < 8; ++j) { const int tj = tok + j * NGW;
            const float a = bflo(pv[j]), b = bfhi(pv[j]);
            const float ss = wave_sum(a * a + b * b);
            const float r = __builtin_amdgcn_rsqf(ss * (1.0f / 128.0f) + LN_EPS);
            if (tj < T) *(unsigned*)(F_cb + (size_t)tj * 128 + 2 * F.lane) = pk2(a * r * g0, b * r * g1); }
    }
}

__device__ __forceinline__ void p2_indexer_mfma(const Args& args, Frame& F, int qsel) {
    const int lane = F.lane, wave = F.wave, tid = F.tid;
    {
        const int gw = F.bid * NWAVES + wave, NGW = F.G * NWAVES;
        for (int i = gw; i < NB * 256; i += NGW) { const int b = i >> 8, t = i & 255, ci = t >> 6; const int tok = b * SEQ + t;
            F_mask[(size_t)tok * 64 + lane] = (lane < 2 * (ci + 1)) ? 0xffffffffu : 0u; }
    }
    LAS unsigned char* kbuf = F.lds;
    const int c16 = lane & 15, q4 = lane >> 4, half = lane >> 5;
    const int nitems = NB * 28 * 4;
    LAS int* qslot = (LAS int*)(F.lds + 65536);
    const int srow = tid >> 3, sp = tid & 7;
    const unsigned svoff = (unsigned)(srow * NPROJ * 2 + ((sp ^ (srow & 7)) << 4));
    int tk = 0;
    if (tid == 0) tk = (int)atomicAdd(F_ctl + CW_Q + 64 * qsel, 1u);
    for (;;) {
        __syncthreads();
        if (tid == 0) qslot[0] = tk;
        __syncthreads();
        const int item = qslot[0];
        if (item >= nitems) break;
        if (tid == 0) tk = (int)atomicAdd(F_ctl + CW_Q + 64 * qsel, 1u);
        const int r = item >> 7, q = item & 127; const int ci = 31 - r, b = q >> 2, g = q & 3; const int nch = ci + 1, nst = (nch + 1) >> 1;
        const int tok0 = b * SEQ + ci * 64 + g * 16 + wave * 2;
        const auto rsK = __builtin_amdgcn_make_buffer_rsrc((void*)(F_projb + (size_t)(b * SEQ) * NPROJ + C_KI), 0, -1, 0x00020000);
#define IDX_ISSUE(cc) do { __builtin_amdgcn_raw_ptr_buffer_load_lds(rsK, (LAS unsigned*)(kbuf + ((cc) & 3) * 16384 + wave * 1024), 16, svoff, (unsigned)((cc) * 128 * NPROJ * 2), 0, 0); \
        __builtin_amdgcn_raw_ptr_buffer_load_lds(rsK, (LAS unsigned*)(kbuf + ((cc) & 3) * 16384 + 8192 + wave * 1024), 16, svoff, (unsigned)(((cc) * 128 + 64) * NPROJ * 2), 0, 0); } while (0)
        IDX_ISSUE(0); if (1 < nst) IDX_ISSUE(1); if (2 < nst) IDX_ISSUE(2);
        const bf16_t* qp = F_projb + (size_t)(tok0 + (c16 >> 3)) * NPROJ + C_QI + (c16 & 7) * 64 + q4 * 8;
        const bf16x8 a0 = *(const bf16x8*)qp, a1 = *(const bf16x8*)(qp + 32);
        float wv[4];
#pragma unroll
        for (int i = 0; i < 4; ++i) wv[i] = F_g32[(size_t)(tok0 + (q4 >> 1)) * 16 + 4 * (q4 & 1) + i];
        asm volatile("s_waitcnt vmcnt(0)" ::: "memory");
        unsigned u[64];
#pragma unroll
        for (int c = 0; c < 16; ++c) {
            u[4 * c] = 0u; u[4 * c + 1] = 0u; u[4 * c + 2] = 0u; u[4 * c + 3] = 0u;
            if (c < nst) {
                if (c + 2 < nst) asm volatile("s_waitcnt vmcnt(4)" ::: "memory"); else if (c + 1 < nst) asm volatile("s_waitcnt vmcnt(2)" ::: "memory"); else asm volatile("s_waitcnt vmcnt(0)" ::: "memory");
                __builtin_amdgcn_s_barrier();
                if (c + 3 < nst) IDX_ISSUE(c + 3);
                const LAS unsigned char* kb = kbuf + (c & 3) * 16384;
                const bool full = (2 * c + 1 < nch);
                f32x4 acs0[4], acs1[4];
#pragma unroll
                for (int pr = 0; pr < 4; ++pr) {
                    f32x4 acc0 = {0.f, 0.f, 0.f, 0.f}, acc1 = {0.f, 0.f, 0.f, 0.f};
                    const int r0 = (2 * pr) * 16 + c16, r1 = (2 * pr + 1) * 16 + c16;
                    const LAS unsigned char* k0p = kb + r0 * 128; const LAS unsigned char* k1p = kb + r1 * 128;
                    const int x0 = (r0 & 7), x1 = (r1 & 7);
                    acc0 = __builtin_amdgcn_mfma_f32_16x16x32_bf16(a0, *(const LAS bf16x8*)(k0p + ((q4 ^ x0) << 4)), acc0, 0, 0, 0);
                    acc0 = __builtin_amdgcn_mfma_f32_16x16x32_bf16(a1, *(const LAS bf16x8*)(k0p + (((q4 + 4) ^ x0) << 4)), acc0, 0, 0, 0);
                    acc1 = __builtin_amdgcn_mfma_f32_16x16x32_bf16(a0, *(const LAS bf16x8*)(k1p + ((q4 ^ x1) << 4)), acc1, 0, 0, 0);
                    acc1 = __builtin_amdgcn_mfma_f32_16x16x32_bf16(a1, *(const LAS bf16x8*)(k1p + (((q4 + 4) ^ x1) << 4)), acc1, 0, 0, 0);
                    acs0[pr] = acc0; acs1[pr] = acc1;
                }
#pragma unroll
                for (int pr = 0; pr < 4; ++pr) {
                    f32x2 pp = {0.f, 0.f};
#pragma unroll
                    for (int i = 0; i < 4; ++i) { const f32x2 w2 = {wv[i], wv[i]}, r2 = {relu_i(acs0[pr][i]), relu_i(acs1[pr][i])}; pp = __builtin_elementwise_fma(w2, r2, pp); }
                    float p0 = pp.x, p1 = pp.y;
                    asm volatile("s_nop 1\n\tv_permlane16_swap_b32 %0, %1" : "+v"(p0), "+v"(p1));
                    const float sc = p0 + p1 + 0.0f;
                    const unsigned bts = __builtin_bit_cast(unsigned, sc);
                    const unsigned key = (bts & 0x80000000u) ? ~bts : (bts | 0x80000000u);
                    u[4 * c + pr] = (pr < 2 || full) ? key : 0u;
                }
            }
        }
#undef IDX_ISSUE
#define IDX_CHAIN(OP) do { OP(0) if (nst <= 1) break; OP(1) if (nst <= 2) break; OP(2) if (nst <= 3) break; OP(3) if (nst <= 4) break; OP(4) if (nst <= 5) break; OP(5) if (nst <= 6) break; \
        OP(6) if (nst <= 7) break; OP(7) if (nst <= 8) break; OP(8) if (nst <= 9) break; OP(9) if (nst <= 10) break; OP(10) if (nst <= 11) break; OP(11) if (nst <= 12) break; \
        OP(12) if (nst <= 13) break; OP(13) if (nst <= 14) break; OP(14) if (nst <= 15) break; OP(15) } while (0)
        unsigned km = 0u;
#define IDX_MAX(c) km = max(max(km, u[4 * (c)]), max(max(u[4 * (c) + 1], u[4 * (c) + 2]), u[4 * (c) + 3]));
        IDX_CHAIN(IDX_MAX);
#undef IDX_MAX
        km = half_max_u(km, lane);
        unsigned thr = 0u; bool done = false;
        for (int bit = 31; bit >= 0; --bit) {
            const unsigned cand = thr | (1u << bit); int cl = 0;
            if (__all(cand > km)) continue;
#define IDX_CNT(c) cl += ((u[4 * (c)] >= cand) ? 1 : 0) + ((u[4 * (c) + 1] >= cand) ? 1 : 0) + ((u[4 * (c) + 2] >= cand) ? 1 : 0) + ((u[4 * (c) + 3] >= cand) ? 1 : 0);
            IDX_CHAIN(IDX_CNT);
#undef IDX_CNT
            cl = half_sum_i(cl, lane);
            if (cl >= KSEL) { thr = cand; done = done || (cl == KSEL); }
            if (__all(done)) break;
        }
        int cge = 0, cgt = 0;
#define IDX_CNT2(c) _Pragma("unroll") for (int j_ = 4 * (c); j_ < 4 * (c) + 4; ++j_) { cge += (u[j_] >= thr) ? 1 : 0; cgt += (u[j_] > thr) ? 1 : 0; }
        IDX_CHAIN(IDX_CNT2);
#undef IDX_CNT2
        cge = half_sum_i(cge, lane); cgt = half_sum_i(cgt, lane);
        int w0 = 0, w1 = 0;
        if (__all(cge == KSEL)) {
#define IDX_SEL(c) _Pragma("unroll") for (int j_ = 4 * (c); j_ < 4 * (c) + 4; ++j_) { const unsigned long long sm = __ballot(u[j_] >= thr); \
            { const bool me_ = (lane == j_); w0 = me_ ? (int)(unsigned)sm : w0; w1 = me_ ? (int)(unsigned)(sm >> 32) : w1; } }
            IDX_CHAIN(IDX_SEL);
#undef IDX_SEL
        } else {
            const int need = KSEL - cgt;
            int e0 = 0, e1 = 0;
            const unsigned lt32 = (1u << (lane & 31)) - 1u;
#pragma unroll
            for (int j = 0; j < 64; ++j) {
                const unsigned long long eqm = __ballot(u[j] == thr);
                const unsigned myeq = half ? (unsigned)(eqm >> 32) : (unsigned)eqm;
                const int rk = (half ? e1 : e0) + __popc(myeq & lt32);
                const bool sel = (u[j] > thr) || (u[j] == thr && rk < need);
                const unsigned long long sm = __ballot(sel);
                e0 += __popc((unsigned)eqm); e1 += __popc((unsigned)(eqm >> 32));
                { const bool me_ = (lane == j); w0 = me_ ? (int)(unsigned)sm : w0; w1 = me_ ? (int)(unsigned)(sm >> 32) : w1; }
            }
        }
        F_mask[(size_t)tok0 * 64 + lane] = (unsigned)w0; F_mask[(size_t)(tok0 + 1) * 64 + lane] = (unsigned)w1;
#undef IDX_CHAIN
    }
}

namespace at {
typedef short s16x4 __attribute__((ext_vector_type(4)));
typedef float f32x16 __attribute__((ext_vector_type(16)));
constexpr int SHM_V = 64 * 128 * 2, SHM_K = SHM_V;
constexpr float THRN = 20.0f;
#define AT_KSWZ(row, colB) ((row) * 256 + ((colB) ^ (((row) & 7) << 4)))
#define AT_SBAR() __builtin_amdgcn_sched_barrier(0)
__device__ __forceinline__ unsigned cvtpk(float lo, float hi) { return cvtpk_c(lo, hi); }
#define AT_PK4(P, BASE, OUT) do { unsigned a0_ = cvtpk_c(P[BASE + 0], P[BASE + 1]), a1_ = cvtpk_c(P[BASE + 2], P[BASE + 3]);   \
    unsigned b0_ = cvtpk_c(P[BASE + 4], P[BASE + 5]), b1_ = cvtpk_c(P[BASE + 6], P[BASE + 7]);                              \
    auto r0_ = __builtin_amdgcn_permlane32_swap(a0_, b0_, false, false); auto r1_ = __builtin_amdgcn_permlane32_swap(a1_, b1_, false, false); \
    u32x4 w_ = {r0_[0], r1_[0], r0_[1], r1_[1]}; OUT = *reinterpret_cast<bf16x8*>(&w_); } while (0)
__device__ __forceinline__ float sel_mask(float v, unsigned ws, int kb) {
    const int mk = __builtin_amdgcn_sbfe((int)ws, kb, 1); return __builtin_bit_cast(float, (__builtin_bit_cast(int, v) & mk) | (~mk & (int)0xff800000)); }
__device__ __forceinline__ void mask_bias(f32x16& p0, f32x16& p1, unsigned w0, unsigned w1, float dq, float nslope, int hi) {
    const unsigned w0s = w0 >> (4 * hi), w1s = w1 >> (4 * hi);
#pragma unroll
    for (int r = 0; r < 16; ++r) { const int kb = (r & 3) + 8 * (r >> 2);
        const float v0 = fmaf(nslope, fabsf(dq - (float)kb), p0[r]), v1 = fmaf(nslope, fabsf(dq - (float)(32 + kb)), p1[r]);
        p0[r] = sel_mask(v0, w0s, kb); p1[r] = sel_mask(v1, w1s, kb); }
}
__device__ __forceinline__ void partialSM(f32x16& p0, f32x16& p1, float& m_reg, float& mn, float& alpha) {
    constexpr float C = 1.4426950408889634f;
    float pmax = p0[0];
#pragma unroll
    for (int r = 1; r < 16; ++r) pmax = fmaxf(pmax, p0[r]);
#pragma unroll
    for (int r = 0; r < 16; ++r) pmax = fmaxf(pmax, p1[r]);
    { auto rr = __builtin_amdgcn_permlane32_swap(__float_as_uint(pmax), __float_as_uint(pmax), false, false); pmax = fmaxf(__uint_as_float(rr[0]), __uint_as_float(rr[1])); }
    if (__builtin_expect(__all(pmax - m_reg <= THRN), 1)) { mn = m_reg; alpha = 1.f; }
    else { mn = fmaxf(m_reg, pmax); alpha = __builtin_amdgcn_exp2f((m_reg - mn) * C); m_reg = mn; }
    const float mnC = -mn * C;
#pragma unroll
    for (int r = 0; r < 16; ++r) p0[r] = fmaf(p0[r], C, mnC);
#pragma unroll
    for (int r = 0; r < 16; ++r) p1[r] = fmaf(p1[r], C, mnC);
#pragma unroll
    for (int r = 0; r < 16; ++r) p0[r] = __builtin_amdgcn_exp2f(p0[r]);
}
__device__ __forceinline__ void finishSM(f32x16& p0, f32x16& p1, float alpha, float& l_reg, bf16x8& pa0, bf16x8& pa1, bf16x8& pa2, bf16x8& pa3) {
#pragma unroll
    for (int r = 0; r < 16; ++r) p1[r] = __builtin_amdgcn_exp2f(p1[r]);
    float ps = 0;
#pragma unroll
    for (int r = 0; r < 16; ++r) ps += p0[r];
#pragma unroll
    for (int r = 0; r < 16; ++r) ps += p1[r];
    { auto rr = __builtin_amdgcn_permlane32_swap(__float_as_uint(ps), __float_as_uint(ps), false, false); ps = __uint_as_float(rr[0]) + __uint_as_float(rr[1]); }
    l_reg = l_reg * alpha + ps;
    AT_PK4(p0, 0, pa0); AT_PK4(p0, 8, pa1); AT_PK4(p1, 0, pa2); AT_PK4(p1, 8, pa3);
}
__device__ __forceinline__ void qkt(f32x16& p0, f32x16& p1, const LAS unsigned char* Ks, const bf16x8* qr, int r32, int hi) {
    p0 = f32x16{}; p1 = f32x16{};
#pragma unroll
    for (int d0 = 0; d0 < 8; ++d0) { const int cb = (d0 * 16 + hi * 8) * 2;
        const bf16x8 b0 = *(const LAS bf16x8*)(Ks + AT_KSWZ(r32, cb));
        const bf16x8 b1 = *(const LAS bf16x8*)(Ks + AT_KSWZ(32 + r32, cb));
        p0 = __builtin_amdgcn_mfma_f32_32x32x16_bf16(b0, qr[d0], p0, 0, 0, 0);
        p1 = __builtin_amdgcn_mfma_f32_32x32x16_bf16(b1, qr[d0], p1, 0, 0, 0); }
}
__device__ __forceinline__ int v_st(int k, int c) { const int kk = (k & ~0xC) | ((k & 4) << 1) | ((k & 8) >> 1); return ((kk >> 3) * 4 + (c >> 5)) * 512 + ((kk & 7) * 32 + (c & 31)) * 2; }
__device__ __forceinline__ int v_rd_base(int lane) { return ((lane & 3) << 3) | (((lane >> 2) & 3) << 6) | (((lane >> 4) & 1) << 5) | (((lane >> 5) & 1) << 8); }
constexpr int v_rd_off(int d0, int ks, int half) { return d0 * 512 + ks * 4096 + half * 2048; }
template <int OFF> __device__ __forceinline__ s16x4 tr_read(int vb) { s16x4 r; asm volatile("ds_read_b64_tr_b16 %0, %1 offset:%2" : "=&v"(r) : "v"(vb), "i"(OFF) : "memory"); return r; }
#define AT_PK(L, H) (bf16x8){L[0], L[1], L[2], L[3], H[0], H[1], H[2], H[3]}
#define AT_VRD(D0, S) const s16x4 S##l0 = tr_read<v_rd_off(D0, 0, 0)>(vb), S##h0 = tr_read<v_rd_off(D0, 0, 1)>(vb), S##l1 = tr_read<v_rd_off(D0, 1, 0)>(vb), S##h1 = tr_read<v_rd_off(D0, 1, 1)>(vb), \
    S##l2 = tr_read<v_rd_off(D0, 2, 0)>(vb), S##h2 = tr_read<v_rd_off(D0, 2, 1)>(vb), S##l3 = tr_read<v_rd_off(D0, 3, 0)>(vb), S##h3 = tr_read<v_rd_off(D0, 3, 1)>(vb)
#define AT_VMM(OD, S) do { OD = __builtin_amdgcn_mfma_f32_32x32x16_bf16(AT_PK(S##l0, S##h0), pa0, OD, 0, 0, 0); OD = __builtin_amdgcn_mfma_f32_32x32x16_bf16(AT_PK(S##l1, S##h1), pa1, OD, 0, 0, 0); \
    OD = __builtin_amdgcn_mfma_f32_32x32x16_bf16(AT_PK(S##l2, S##h2), pa2, OD, 0, 0, 0); OD = __builtin_amdgcn_mfma_f32_32x32x16_bf16(AT_PK(S##l3, S##h3), pa3, OD, 0, 0, 0); } while (0)
__device__ __forceinline__ void pv_d0(f32x16* o, int vb, bf16x8 pa0, bf16x8 pa1, bf16x8 pa2, bf16x8 pa3) {
    AT_VRD(0, a); AT_VRD(1, b);
    asm volatile("s_waitcnt lgkmcnt(8)" ::: "memory"); AT_SBAR();
    AT_VMM(o[0], a);
    AT_VRD(2, c);
    asm volatile("s_waitcnt lgkmcnt(8)" ::: "memory"); AT_SBAR();
    AT_VMM(o[1], b);
    AT_VRD(3, d);
    asm volatile("s_waitcnt lgkmcnt(8)" ::: "memory"); AT_SBAR();
    AT_VMM(o[2], c);
    asm volatile("s_waitcnt lgkmcnt(0)" ::: "memory"); AT_SBAR();
    AT_VMM(o[3], d);
}
#undef AT_VRD
#undef AT_VMM
#undef AT_PK

__device__ __forceinline__ void unit(const bf16_t* __restrict__ projb, const bf16_t* __restrict__ cbp, const unsigned* __restrict__ maskp, const bf16_t* __restrict__ wukb,
                                     const bf16_t* __restrict__ wuvf, bf16_t* __restrict__ mix, int b, int ci, int hf, LAS unsigned char* lds, int wave_id) {
    int lane_ = my_lane(); asm volatile("" : "+v"(lane_));
    const int wid = wave_id, lane = lane_, tid = wid * 64 + lane;
    const int r32 = lane & 31, hi = lane >> 5;
    LAS unsigned char* V_lds = lds; LAS unsigned char* K_lds = lds + 3 * SHM_V;
    const int NT = ci + 1, NTp = (NT + 1) & ~1;
    const int tq = ci * 64 + hf * 32 + r32;
    const int tokq = b * SEQ + tq;
    const bf16_t* Kg = cbp + (size_t)b * SEQ * 128;
    const unsigned* mrow = maskp + (size_t)tokq * 64;
    const float nslope = -__builtin_amdgcn_exp2f(-(float)(wid + 1));
    bf16x8 qr[8];
    { bf16x8 qa[4];
      const bf16_t* qap = projb + (size_t)tokq * NPROJ + C_QA + wid * 64 + hi * 8;
#pragma unroll
      for (int ks = 0; ks < 4; ++ks) qa[ks] = *(const bf16x8*)(qap + 16 * ks);
      const bf16_t* wp = wukb + (size_t)wid * 128 * 64 + (size_t)r32 * 64 + hi * 8;
#pragma unroll
      for (int rt = 0; rt < 4; ++rt) { f32x16 x = f32x16{};
#pragma unroll
          for (int ks = 0; ks < 4; ++ks) { const bf16x8 wf = *(const bf16x8*)(wp + (size_t)rt * 32 * 64 + 16 * ks); x = __builtin_amdgcn_mfma_f32_32x32x16_bf16(wf, qa[ks], x, 0, 0, 0); }
          AT_PK4(x, 0, qr[2 * rt]); AT_PK4(x, 8, qr[2 * rt + 1]); } }
    float m_reg = -1e30f, l_reg = 0.f; f32x16 o[4] = {};
    const int sr = tid >> 4, sc = (tid & 15) * 8, vst0 = v_st(sr, sc), vst1 = v_st(32 + sr, sc);
    const int vb0 = (int)(uintptr_t)V_lds + v_rd_base(lane);
    struct { bf16x8 ks0, ks1; u32x2 mw; } sr1;
#define AT_TILE(t) ((t) < NT ? NT - 1 - (t) : 0)
#define AT_SLOAD(t) do { const int k0_ = AT_TILE(t) * 64; sr1.ks0 = *(const bf16x8*)(Kg + (size_t)(k0_ + sr) * 128 + sc); sr1.ks1 = *(const bf16x8*)(Kg + (size_t)(k0_ + 32 + sr) * 128 + sc); \
    sr1.mw = ((t) < NT) ? *(const u32x2*)(mrow + 2 * AT_TILE(t)) : (u32x2){0u, 0u}; } while (0)
#define AT_SWRITE(boff) do { *(LAS bf16x8*)(V_lds + (boff) + vst0) = sr1.ks0; *(LAS bf16x8*)(V_lds + (boff) + vst1) = sr1.ks1; const int kc_ = sc * 2; \
    *(LAS bf16x8*)(K_lds + (boff) + AT_KSWZ(sr, kc_)) = sr1.ks0; *(LAS bf16x8*)(K_lds + (boff) + AT_KSWZ(32 + sr, kc_)) = sr1.ks1; } while (0)
#define AT_LANDED() asm volatile("s_waitcnt vmcnt(0)" ::: "memory")
#define AT_RESC(a) do { if (__any((a) < 1.f)) { _Pragma("unroll") for (int d = 0; d < 4; ++d) _Pragma("unroll") for (int r = 0; r < 16; ++r) o[d][r] *= (a); } } while (0)
#define AT_DQ(t) ((float)(tq - 64 * AT_TILE(t) - 4 * hi))
#define AT_ROT() do { const int t_ = bprev; bprev = bcur; bcur = bnext; bnext = t_; } while (0)
    f32x16 pA0, pA1, pB0, pB1; float mnA, mnB, alA, alB; bf16x8 pa0, pa1, pa2, pa3;
    u32x2 mwc, mwn;
    int bprev = 0, bcur = SHM_V, bnext = 2 * SHM_V;
    __syncthreads();
    AT_SLOAD(0); AT_LANDED(); AT_SWRITE(0); mwc = sr1.mw; AT_SLOAD(1); __syncthreads();
    qkt(pA0, pA1, K_lds, qr, r32, hi); mask_bias(pA0, pA1, mwc.x, mwc.y, AT_DQ(0), nslope, hi); partialSM(pA0, pA1, m_reg, mnA, alA);
    AT_LANDED(); AT_SWRITE(SHM_V); mwn = sr1.mw; if (2 < NTp) AT_SLOAD(2);
    for (int j = 1; j + 1 < NTp; j += 2) {
        __syncthreads();
        AT_LANDED(); mwc = mwn; mwn = sr1.mw; AT_SWRITE(bnext); AT_SLOAD(j + 2);
        AT_SBAR(); qkt(pB0, pB1, K_lds + bcur, qr, r32, hi); mask_bias(pB0, pB1, mwc.x, mwc.y, AT_DQ(j), nslope, hi);
        finishSM(pA0, pA1, alA, l_reg, pa0, pa1, pa2, pa3); AT_SBAR();
        pv_d0(o, vb0 + bprev, pa0, pa1, pa2, pa3); partialSM(pB0, pB1, m_reg, mnB, alB);
        AT_RESC(alB); AT_ROT();
        __syncthreads();
        if (j + 2 < NTp) { AT_LANDED(); mwc = mwn; mwn = sr1.mw; AT_SWRITE(bnext); if (j + 3 < NTp) AT_SLOAD(j + 3); } else mwc = mwn;
        AT_SBAR(); qkt(pA0, pA1, K_lds + bcur, qr, r32, hi); mask_bias(pA0, pA1, mwc.x, mwc.y, AT_DQ(j + 1), nslope, hi);
        finishSM(pB0, pB1, alB, l_reg, pa0, pa1, pa2, pa3); AT_SBAR();
        pv_d0(o, vb0 + bprev, pa0, pa1, pa2, pa3); partialSM(pA0, pA1, m_reg, mnA, alA);
        AT_RESC(alA); AT_ROT();
    }
    __syncthreads();
    mwc = mwn;
    AT_SBAR(); qkt(pB0, pB1, K_lds + bcur, qr, r32, hi); mask_bias(pB0, pB1, mwc.x, mwc.y, AT_DQ(NTp - 1), nslope, hi);
    finishSM(pA0, pA1, alA, l_reg, pa0, pa1, pa2, pa3); AT_SBAR();
    pv_d0(o, vb0 + bprev, pa0, pa1, pa2, pa3); partialSM(pB0, pB1, m_reg, mnB, alB);
    AT_RESC(alB);
    finishSM(pB0, pB1, alB, l_reg, pa0, pa1, pa2, pa3); AT_SBAR();
    pv_d0(o, vb0 + bcur, pa0, pa1, pa2, pa3);
    const float inv = __builtin_amdgcn_rcpf(l_reg);
    f32x16 oa[2] = {f32x16{}, f32x16{}};
    const bf16_t* wf = wuvf + (size_t)wid * 8192 + (size_t)lane * 8;
#pragma unroll
    for (int d0 = 0; d0 < 4; ++d0)
#pragma unroll
        for (int sx = 0; sx < 2; ++sx) { u32x4 w; w.x = cvtpk(o[d0][8 * sx + 0] * inv, o[d0][8 * sx + 1] * inv); w.y = cvtpk(o[d0][8 * sx + 2] * inv, o[d0][8 * sx + 3] * inv);
            w.z = cvtpk(o[d0][8 * sx + 4] * inv, o[d0][8 * sx + 5] * inv); w.w = cvtpk(o[d0][8 * sx + 6] * inv, o[d0][8 * sx + 7] * inv);
            const bf16x8 bfrag = *reinterpret_cast<bf16x8*>(&w);
#pragma unroll
            for (int dt = 0; dt < 2; ++dt) { const bf16x8 af = *(const bf16x8*)(wf + (size_t)((dt * 4 + d0) * 2 + sx) * 512); oa[dt] = __builtin_amdgcn_mfma_f32_32x32x16_bf16(af, bfrag, oa[dt], 0, 0, 0); } }
    bf16_t* op = mix + (size_t)tokq * DM + wid * 64 + 4 * hi;
#pragma unroll
    for (int dt = 0; dt < 2; ++dt)
#pragma unroll
        for (int g = 0; g < 4; ++g) { u32x2 w; w.x = cvtpk(oa[dt][4 * g], oa[dt][4 * g + 1]); w.y = cvtpk(oa[dt][4 * g + 2], oa[dt][4 * g + 3]); *(u32x2*)(op + 32 * dt + 8 * g) = w; }
#undef AT_TILE
#undef AT_SLOAD
#undef AT_SWRITE
#undef AT_SWAIT
#undef AT_RESC
#undef AT_DQ
#undef AT_ROT
#undef AT_LANDED
}
}
__device__ __forceinline__ void p3_attn_mfma(const Args& args, Frame& F) {
    LAS int* qslot = (LAS int*)(F.lds + LCTL_OFF + 2048);
    int tk = 0;
    if (F.tid == 0) tk = (int)atomicAdd(F_ctl + CW_Q + 32, 1u);
    for (;;) {
        __syncthreads();
        if (F.tid == 0) qslot[0] = tk;
        __syncthreads();
        const int tq_ = qslot[0];
        if (tq_ >= 2048 + XC_ITEMS) break;
        if (F.tid == 0) tk = (int)atomicAdd(F_ctl + CW_Q + 32, 1u);
        int u;
        if (tq_ < 1792) { const int grp = tq_ / 7, sub = tq_ % 7;
            if (sub >= 4) { expert_convert_item(args, F, grp * 3 + (sub - 4)); continue; }
            u = grp * 4 + sub; }
        else u = 1024 + (tq_ - 1792);
        const int ci = 31 - (u >> 6), b = (u & 63) >> 1, hf = u & 1;
        at::unit(F_projb, F_cb, F_mask, F_wukb, F_wuvf, F_mix, b, ci, hf, F.lds, F.wave);
    }
    __syncthreads();
}

namespace ml {
using at::f32x16; using at::s16x4;
constexpr int L_UC = 0, L_Q = 16384, L_K = 32768, L_WK = 49152, L_V = 65536, L_CB = 81920, L_HC2 = 114688, L_SM = 131072, L_NV = L_SM + 2 * 5 * 256;
__device__ __forceinline__ int hc_off(int t, int col) { return L_HC2 + t * 256 + (((col + 4 * t) & 127) << 1); }
static_assert(L_NV + 512 <= LDS_BYTES, "mLSTM LDS map");
#define ML_PK(L, H) (bf16x8){L[0], L[1], L[2], L[3], H[0], H[1], H[2], H[3]}
__device__ __forceinline__ void stream(const Args& args, int b, int h, LAS unsigned char* lds, int wave_id) {
    int lane_ = my_lane(); asm volatile("" : "+v"(lane_));
    const int wid = wave_id, lane = lane_, tid = wid * 64 + lane;
    const int r32 = lane & 31, hi = lane >> 5;
    const int tt = wid >> 2, vt = wid & 3, mat = wid >> 2, et = wid & 3, kt0 = 2 * (wid >> 2);
    f32x16 C0 = f32x16{}, C1 = f32x16{};
    bf16x8 wf[8];
    { const bf16_t* WT = (mat ? F_wmkT : F_wmqT) + (size_t)h * 128 * 128 + (size_t)(32 * et + r32) * 128 + hi * 8;
#pragma unroll
      for (int ks = 0; ks < 8; ++ks) wf[ks] = *(const bf16x8*)(WT + 16 * ks); }
    LAS float* NV = (LAS float*)(lds + L_NV);
    __syncthreads();
    for (int i = tid; i < 32768 / 16; i += NTHR) *(LAS u32x4*)(lds + L_CB + 16 * i) = (u32x4){0u, 0u, 0u, 0u};
    if (tid < 128) NV[tid] = 0.f;
    float m_prev = -1e30f;
    const float bi = F_b_i[h], bfv = F_b_f[h];
    u32x4 upre[8]; float gpre[2];
#define ML_PREFETCH(cn) do { const int t_ld_ = tid >> 3, ch_ld_ = h * 128 + (tid & 7) * 16; \
        _Pragma("unroll") for (int j_ = 0; j_ < 4; ++j_) { const int tg_ = (cn) * CHK + t_ld_ - 3 + j_; const u32x4* up_ = (const u32x4*)(F_projb + (size_t)(b * SEQ + (tg_ < 0 ? 0 : tg_)) * NPROJ + C_U + ch_ld_); upre[2 * j_] = up_[0]; upre[2 * j_ + 1] = up_[1]; } \
        gpre[0] = F_g32[(size_t)(b * SEQ + (cn) * CHK + lane) * 16 + 8 + h]; gpre[1] = F_g32[(size_t)(b * SEQ + (cn) * CHK + lane) * 16 + 12 + h]; } while (0)
    ML_PREFETCH(0);
    for (int c = 0; c < NCH; ++c) {
        const int tok0 = b * SEQ + c * CHK;
        int lx = lane; asm volatile("" : "+v"(lx));
        const int r32 = lx & 31, hi = lx >> 5, tid = wid * 64 + lx;
        const int t_ld = tid >> 3, d0_ld = (tid & 7) * 16, ch_ld = h * 128 + d0_ld;
        const int vbV = (int)(uintptr_t)(lds + L_V) + at::v_rd_base(lx) + vt * 512;
        const int vbW = (int)(uintptr_t)(lds + L_WK) + at::v_rd_base(lx) + kt0 * 512;
        LAS float* SM = (LAS float*)(lds + L_SM + (c & 1) * 1280);
        const int nt_ = wid + 8 * (lx >> 3), ncg = lx & 7;
        u32x4 zpre[2];
        { const u32x4* zp_ = (const u32x4*)(F_projb + (size_t)(tok0 + nt_) * NPROJ + C_Z + h * 128 + 16 * ncg); zpre[0] = zp_[0]; zpre[1] = zp_[1]; }
        u32x4 vpre[2];
        { const u32x4* vp_ = (const u32x4*)(F_projb + (size_t)(tok0 + t_ld) * NPROJ + C_V + ch_ld); vpre[0] = vp_[0]; vpre[1] = vp_[1]; }
        { const float ip = gpre[0] + bi, fp = gpre[1] + bfv;
          const float bc = scan_add(fminf(fp, 0.f) - 0.6931471805599453f * __builtin_amdgcn_logf(1.0f + __builtin_amdgcn_exp2f(-1.4426950408889634f * fabsf(fp))));
          const float u = ip - bc; const float pm = scan_max(u);
          const float mm = fmaxf(m_prev, pm); const float mm63 = __builtin_bit_cast(float, __builtin_amdgcn_readlane(__builtin_bit_cast(int, mm), 63)), b63 = __builtin_bit_cast(float, __builtin_amdgcn_readlane(__builtin_bit_cast(int, bc), 63));
          if (wid == 0) { SM[lane] = u; SM[64 + lane] = mm; SM[128 + lane] = __expf(m_prev - mm); SM[192 + lane] = __expf(u - mm63); SM[256 + lane] = __expf(-bc - mm); }
          m_prev = b63 + mm63; }
#ifndef ML_NO_A
        { float a[16];
#pragma unroll
          for (int q = 0; q < 4; ++q) { const f32x4 bv = *(const f32x4*)(F_m_conv_b + ch_ld + 4 * q); a[4 * q] = bv.x; a[4 * q + 1] = bv.y; a[4 * q + 2] = bv.z; a[4 * q + 3] = bv.w; }
#pragma unroll
          for (int j = 0; j < 4; ++j) { const int tg = c * CHK + t_ld - 3 + j;
              if (tg >= 0) { const u32x4 p0 = upre[2 * j], p1 = upre[2 * j + 1];
                  const float uv[16] = {bflo(p0.x), bfhi(p0.x), bflo(p0.y), bfhi(p0.y), bflo(p0.z), bfhi(p0.z), bflo(p0.w), bfhi(p0.w), bflo(p1.x), bfhi(p1.x), bflo(p1.y), bfhi(p1.y), bflo(p1.z), bfhi(p1.z), bflo(p1.w), bfhi(p1.w)};
                  const float* wp = F_m_conv_w + j * 512 + ch_ld;
#pragma unroll
                  for (int q = 0; q < 4; ++q) { const f32x4 wv = *(const f32x4*)(wp + 4 * q); a[4 * q] += wv.x * uv[4 * q]; a[4 * q + 1] += wv.y * uv[4 * q + 1]; a[4 * q + 2] += wv.z * uv[4 * q + 2]; a[4 * q + 3] += wv.w * uv[4 * q + 3]; } } }
#pragma unroll
          for (int i = 0; i < 16; ++i) a[i] = a[i] * sigmoidf_(a[i]);
          u32x4 w0, w1; w0.x = cvtpk_c(a[0], a[1]); w0.y = cvtpk_c(a[2], a[3]); w0.z = cvtpk_c(a[4], a[5]); w0.w = cvtpk_c(a[6], a[7]);
          w1.x = cvtpk_c(a[8], a[9]); w1.y = cvtpk_c(a[10], a[11]); w1.z = cvtpk_c(a[12], a[13]); w1.w = cvtpk_c(a[14], a[15]);
          *(LAS u32x4*)(lds + L_UC + AT_KSWZ(t_ld, d0_ld * 2)) = w0; *(LAS u32x4*)(lds + L_UC + AT_KSWZ(t_ld, d0_ld * 2 + 16)) = w1;
        }
#endif
        __syncthreads();
#ifndef ML_NO_B
#pragma unroll
        for (int t2 = 0; t2 < 2; ++t2) { f32x16 x = f32x16{};
#pragma unroll
            for (int ks = 0; ks < 8; ++ks) { const bf16x8 uf = *(const LAS bf16x8*)(lds + L_UC + AT_KSWZ(32 * t2 + r32, (16 * ks + 8 * hi) * 2)); x = __builtin_amdgcn_mfma_f32_32x32x16_bf16(wf[ks], uf, x, 0, 0, 0); }
            const int t = 32 * t2 + r32;
            if (mat == 0) {
#pragma unroll
                for (int g = 0; g < 4; ++g) { const int e = 32 * et + 8 * g + 4 * hi; u32x2 w; w.x = cvtpk_c(x[4 * g], x[4 * g + 1]); w.y = cvtpk_c(x[4 * g + 2], x[4 * g + 3]);
                    *(LAS u32x2*)(lds + L_Q + t * 256 + ((e * 2) ^ ((t & 7) << 4))) = w; }
            } else { const float wu = SM[192 + t];
#pragma unroll
                for (int g = 0; g < 4; ++g) { const int e = 32 * et + 8 * g + 4 * hi; u32x2 w; w.x = cvtpk_c(x[4 * g], x[4 * g + 1]); w.y = cvtpk_c(x[4 * g + 2], x[4 * g + 3]);
                    *(LAS u32x2*)(lds + L_K + t * 256 + ((e * 2) ^ ((t & 7) << 4))) = w;
                    u32x2 w2; w2.x = cvtpk_c(x[4 * g] * wu, x[4 * g + 1] * wu); w2.y = cvtpk_c(x[4 * g + 2] * wu, x[4 * g + 3] * wu);
                    *(LAS u32x2*)(lds + L_WK + at::v_st(t, e)) = w2; }
            } }
#endif
        *(LAS u32x4*)(lds + L_V + at::v_st(t_ld, d0_ld)) = vpre[0]; *(LAS u32x4*)(lds + L_V + at::v_st(t_ld, d0_ld + 8)) = vpre[1];
        __syncthreads();
#ifndef ML_NO_C
        {
            const int t = 32 * tt + r32;
            const float mmt = SM[64 + t], wst = SM[128 + t], em = SM[256 + t], decay = SM[128 + 63];
            f32x16 nA = f32x16{}, p0 = f32x16{}, p1 = f32x16{};
            float dS = 0.f;
#pragma unroll
            for (int kh = 0; kh < 2; ++kh) {
                bf16x8 qf[4];
#pragma unroll
                for (int k4 = 0; k4 < 4; ++k4) qf[k4] = *(const LAS bf16x8*)(lds + L_Q + AT_KSWZ(t, (16 * (4 * kh + k4) + 8 * hi) * 2));
#pragma unroll
                for (int k4 = 0; k4 < 4; ++k4) { const int ks = 4 * kh + k4, cb = (16 * ks + 8 * hi) * 2;
                    nA = __builtin_amdgcn_mfma_f32_32x32x16_bf16(*(const LAS bf16x8*)(lds + L_CB + AT_KSWZ(32 * vt + r32, cb)), qf[k4], nA, 0, 0, 0);
                    p0 = __builtin_amdgcn_mfma_f32_32x32x16_bf16(*(const LAS bf16x8*)(lds + L_K + AT_KSWZ(r32, cb)), qf[k4], p0, 0, 0, 0);
                    p1 = __builtin_amdgcn_mfma_f32_32x32x16_bf16(*(const LAS bf16x8*)(lds + L_K + AT_KSWZ(32 + r32, cb)), qf[k4], p1, 0, 0, 0);
                    const f32x4 n0 = *(const LAS f32x4*)(NV + 16 * ks + 8 * hi), n1 = *(const LAS f32x4*)(NV + 16 * ks + 8 * hi + 4); const u32x4 qq = *reinterpret_cast<const u32x4*>(&qf[k4]);
                    dS += n0.x * bflo(qq.x) + n0.y * bfhi(qq.x) + n0.z * bflo(qq.y) + n0.w * bfhi(qq.y) + n1.x * bflo(qq.z) + n1.y * bfhi(qq.z) + n1.z * bflo(qq.w) + n1.w * bfhi(qq.w); }
                AT_SBAR();
            }
            { auto rr = __builtin_amdgcn_permlane32_swap(__float_as_uint(dS), __float_as_uint(dS), false, false); dS = __uint_as_float(rr[0]) + __uint_as_float(rr[1]); }
            float ps = 0.f;
#pragma unroll
            for (int g = 0; g < 4; ++g) { const f32x4 u0 = *(const LAS f32x4*)(SM + 8 * g + 4 * hi), u1 = *(const LAS f32x4*)(SM + 32 + 8 * g + 4 * hi);
#pragma unroll
                for (int i = 0; i < 4; ++i) { const int s0 = 8 * g + 4 * hi + i, r = 4 * g + i;
                    const float w0 = (s0 <= t) ? __expf(u0[i] - mmt) : 0.f, w1 = (32 + s0 <= t) ? __expf(u1[i] - mmt) : 0.f;
                    p0[r] *= w0; p1[r] *= w1; ps += p0[r] + p1[r]; } }
            { auto rr = __builtin_amdgcn_permlane32_swap(__float_as_uint(ps), __float_as_uint(ps), false, false); ps = __uint_as_float(rr[0]) + __uint_as_float(rr[1]); }
            bf16x8 pa0, pa1, pa2, pa3;
            AT_PK4(p0, 0, pa0); AT_PK4(p0, 8, pa1); AT_PK4(p1, 0, pa2); AT_PK4(p1, 8, pa3);
#pragma unroll
            for (int r = 0; r < 16; ++r) nA[r] *= wst;
            const s16x4 l0 = at::tr_read<0>(vbV), h0 = at::tr_read<2048>(vbV), l1 = at::tr_read<4096>(vbV), h1 = at::tr_read<4096 + 2048>(vbV);
            const s16x4 l2 = at::tr_read<8192>(vbV), h2 = at::tr_read<8192 + 2048>(vbV), l3 = at::tr_read<12288>(vbV), h3 = at::tr_read<12288 + 2048>(vbV);
            asm volatile("s_waitcnt lgkmcnt(0)" ::: "memory"); AT_SBAR();
            const bf16x8 vf0 = ML_PK(l0, h0), vf1 = ML_PK(l1, h1), vf2 = ML_PK(l2, h2), vf3 = ML_PK(l3, h3);
            nA = __builtin_amdgcn_mfma_f32_32x32x16_bf16(vf0, pa0, nA, 0, 0, 0); nA = __builtin_amdgcn_mfma_f32_32x32x16_bf16(vf1, pa1, nA, 0, 0, 0);
            nA = __builtin_amdgcn_mfma_f32_32x32x16_bf16(vf2, pa2, nA, 0, 0, 0); nA = __builtin_amdgcn_mfma_f32_32x32x16_bf16(vf3, pa3, nA, 0, 0, 0);
            const float den = ps + wst * dS; const float inv = __builtin_amdgcn_rcpf(fmaxf(fabsf(den), em));
#pragma unroll
            for (int g = 0; g < 4; ++g) { u32x2 o; o.x = cvtpk_c(nA[4 * g] * inv, nA[4 * g + 1] * inv); o.y = cvtpk_c(nA[4 * g + 2] * inv, nA[4 * g + 3] * inv); *(LAS u32x2*)(lds + hc_off(t, 32 * vt + 8 * g + 4 * hi)) = o; }
#pragma unroll
            for (int r = 0; r < 16; ++r) { C0[r] *= decay; C1[r] *= decay; }
            { const s16x4 a0 = at::tr_read<0>(vbW), b0 = at::tr_read<2048>(vbW), a1 = at::tr_read<4096>(vbW), b1 = at::tr_read<4096 + 2048>(vbW);
              const s16x4 a2 = at::tr_read<8192>(vbW), b2 = at::tr_read<8192 + 2048>(vbW), a3 = at::tr_read<12288>(vbW), b3 = at::tr_read<12288 + 2048>(vbW);
              asm volatile("s_waitcnt lgkmcnt(0)" ::: "memory"); AT_SBAR();
              C0 = __builtin_amdgcn_mfma_f32_32x32x16_bf16(vf0, ML_PK(a0, b0), C0, 0, 0, 0); C0 = __builtin_amdgcn_mfma_f32_32x32x16_bf16(vf1, ML_PK(a1, b1), C0, 0, 0, 0);
              C0 = __builtin_amdgcn_mfma_f32_32x32x16_bf16(vf2, ML_PK(a2, b2), C0, 0, 0, 0); C0 = __builtin_amdgcn_mfma_f32_32x32x16_bf16(vf3, ML_PK(a3, b3), C0, 0, 0, 0); }
            { const s16x4 a0 = at::tr_read<512>(vbW), b0 = at::tr_read<512 + 2048>(vbW), a1 = at::tr_read<512 + 4096>(vbW), b1 = at::tr_read<512 + 4096 + 2048>(vbW);
              const s16x4 a2 = at::tr_read<512 + 8192>(vbW), b2 = at::tr_read<512 + 8192 + 2048>(vbW), a3 = at::tr_read<512 + 12288>(vbW), b3 = at::tr_read<512 + 12288 + 2048>(vbW);
              asm volatile("s_waitcnt lgkmcnt(0)" ::: "memory"); AT_SBAR();
              C1 = __builtin_amdgcn_mfma_f32_32x32x16_bf16(vf0, ML_PK(a0, b0), C1, 0, 0, 0); C1 = __builtin_amdgcn_mfma_f32_32x32x16_bf16(vf1, ML_PK(a1, b1), C1, 0, 0, 0);
              C1 = __builtin_amdgcn_mfma_f32_32x32x16_bf16(vf2, ML_PK(a2, b2), C1, 0, 0, 0); C1 = __builtin_amdgcn_mfma_f32_32x32x16_bf16(vf3, ML_PK(a3, b3), C1, 0, 0, 0); }
        }
#endif
        __syncthreads();
        if (c + 1 < NCH) ML_PREFETCH(c + 1);
        {
#pragma unroll
            for (int r = 0; r < 16; ++r) { const int vv = 32 * vt + (r & 3) + 8 * (r >> 2) + 4 * hi;
                *(LAS bf16_t*)(lds + L_CB + AT_KSWZ(vv, (32 * kt0 + r32) * 2)) = (bf16_t)f2bf(C0[r]); *(LAS bf16_t*)(lds + L_CB + AT_KSWZ(vv, (32 * (kt0 + 1) + r32) * 2)) = (bf16_t)f2bf(C1[r]); }
            { const int kk = 16 * wid + (lx & 15), sg = lx >> 4; float a = 0.f;
#pragma unroll
              for (int s2 = 0; s2 < 16; ++s2) { const int sx = 16 * sg + s2; a += SM[192 + sx] * bf2f(*(const LAS bf16_t*)(lds + L_K + AT_KSWZ(sx, kk * 2))); }
              a += __shfl_xor(a, 16); a += __shfl_xor(a, 32);
              if (sg == 0) NV[kk] = SM[128 + 63] * NV[kk] + a; }
            {
                float hv[16];
#pragma unroll
                for (int i = 0; i < 4; ++i) { const u32x2 p = *(const LAS u32x2*)(lds + hc_off(nt_, 16 * ncg + 4 * i)); hv[4 * i] = bflo(p.x); hv[4 * i + 1] = bfhi(p.x); hv[4 * i + 2] = bflo(p.y); hv[4 * i + 3] = bfhi(p.y); }
                float s1 = 0.f;
#pragma unroll
                for (int i = 0; i < 16; ++i) s1 += hv[i];
                s1 += dppf<0xB1>(s1, s1); s1 += dppf<0x4E>(s1, s1); s1 += dppf<0x141>(s1, s1);
                const float mu = s1 * (1.0f / 128.0f); float s2 = 0.f;
#pragma unroll
                for (int i = 0; i < 16; ++i) { hv[i] -= mu; s2 += hv[i] * hv[i]; }
                s2 += dppf<0xB1>(s2, s2); s2 += dppf<0x4E>(s2, s2); s2 += dppf<0x141>(s2, s2);
                const float rs = __builtin_amdgcn_rsqf(s2 * (1.0f / 128.0f) + LN_EPS);
                const float* gp = F_m_norm_g + h * 128 + 16 * ncg;
                const unsigned zw[8] = {zpre[0].x, zpre[0].y, zpre[0].z, zpre[0].w, zpre[1].x, zpre[1].y, zpre[1].z, zpre[1].w};
                unsigned ow[8];
#pragma unroll
                for (int i = 0; i < 8; ++i) { const f32x2 g2 = *(const f32x2*)(gp + 2 * i);
                    ow[i] = cvtpk_c(sigmoidf_(bflo(zw[i])) * hv[2 * i] * rs * g2.x, sigmoidf_(bfhi(zw[i])) * hv[2 * i + 1] * rs * g2.y); }
                u32x4* op = (u32x4*)(F_mix + (size_t)(tok0 + nt_) * DM + 512 + h * 128 + 16 * ncg);
                op[0] = (u32x4){ow[0], ow[1], ow[2], ow[3]}; op[1] = (u32x4){ow[4], ow[5], ow[6], ow[7]};
            }
        }
    }
    __syncthreads();
}
#undef ML_PK
#undef ML_PREFETCH
}

__device__ __forceinline__ void p5_ln1(const Args& args, Frame& F) {
    const int lane = F.lane;
    const int gtid = F.bid * NTHR + F.tid, NT = F.G * NTHR;
    for (int i = gtid; i < NEXP * RT_STRIDE / 4; i += NT) ((u32x4*)F_rtok)[i] = u32x4{0xffffffffu, 0xffffffffu, 0xffffffffu, 0xffffffffu};
    const int gw = F.bid * NWAVES + F.wave, NGW = F.G * NWAVES;
    f32x4 gv[4], bv[4];
#pragma unroll
    for (int j = 0; j < 4; ++j) { gv[j] = *((const f32x4*)F_ln1_g + lane + 64 * j); bv[j] = *((const f32x4*)F_ln1_b + lane + 64 * j); }
    u32x2 xn_[4], mn_[4];
    { const u32x2* pr = (const u32x2*)(F_xb + (size_t)gw * DM) + lane; const u32x2* mr = (const u32x2*)((const bf16_t*)F_pre1 + (size_t)gw * DM) + lane;
#pragma unroll
      for (int j = 0; j < 4; ++j) { xn_[j] = __builtin_nontemporal_load(&pr[64 * j]); mn_[j] = __builtin_nontemporal_load(&mr[64 * j]); } }
    for (int tok = gw; tok < T; tok += NGW) {
        f32x4 v[4]; float s = 0.f;
#pragma unroll
        for (int j = 0; j < 4; ++j) { v[j].x = DN_ALPHA * bflo(xn_[j].x) + bflo(mn_[j].x); v[j].y = DN_ALPHA * bfhi(xn_[j].x) + bfhi(mn_[j].x); v[j].z = DN_ALPHA * bflo(xn_[j].y) + bflo(mn_[j].y); v[j].w = DN_ALPHA * bfhi(xn_[j].y) + bfhi(mn_[j].y);
            s += (v[j].x + v[j].y) + (v[j].z + v[j].w); }
        if (tok + NGW < T) { const u32x2* pr = (const u32x2*)(F_xb + (size_t)(tok + NGW) * DM) + lane; const u32x2* mr = (const u32x2*)((const bf16_t*)F_pre1 + (size_t)(tok + NGW) * DM) + lane;
#pragma unroll
            for (int j = 0; j < 4; ++j) { xn_[j] = __builtin_nontemporal_load(&pr[64 * j]); mn_[j] = __builtin_nontemporal_load(&mr[64 * j]); } }
        const float mean = wave_sum(s) * (1.0f / DM); float s2 = 0.f;
#pragma unroll
        for (int j = 0; j < 4; ++j) { v[j] = v[j] - mean; s2 += (v[j].x * v[j].x + v[j].y * v[j].y) + (v[j].z * v[j].z + v[j].w * v[j].w); }
        const float rstd = __builtin_amdgcn_rsqf(wave_sum(s2) * (1.0f / DM) + LN_EPS);
        u32x2* o = (u32x2*)(F_h1b + (size_t)tok * DM) + lane;
#pragma unroll
        for (int j = 0; j < 4; ++j) { v[j] = v[j] * rstd * gv[j] + bv[j]; u32x2 w; w.x = cvtpk_c(v[j].x, v[j].y); w.y = cvtpk_c(v[j].z, v[j].w); o[64 * j] = w; }
        { unsigned* q8 = (unsigned*)(F_h1q + (size_t)tok * DM) + lane;
#pragma unroll
          for (int j = 0; j < 4; ++j) q8[64 * j] = f8x4(v[j].x * F8_ACT_S, v[j].y * F8_ACT_S, v[j].z * F8_ACT_S, v[j].w * F8_ACT_S); }
    }
}
#define P6_INS(GT, V, E) { const bool g0_ = GT(V, E, t0, i0), g1_ = GT(V, E, t1, i1), g2_ = GT(V, E, t2, i2), g3_ = GT(V, E, t3, i3); \
        t3 = g2_ ? t2 : (g3_ ? (V) : t3); i3 = g2_ ? i2 : (g3_ ? (E) : i3); t2 = g1_ ? t1 : (g2_ ? (V) : t2); i2 = g1_ ? i1 : (g2_ ? (E) : i2); \
        t1 = g0_ ? t0 : (g1_ ? (V) : t1); i1 = g0_ ? i0 : (g1_ ? (E) : i1); t0 = g0_ ? (V) : t0; i0 = g0_ ? (E) : i0; }
#define P6_GT1(V, E, TT, II) ((V) > (TT))
#define P6_GT2(V, E, TT, II) ((V) > (TT) || ((V) == (TT) && (E) < (II)))
__device__ __forceinline__ void p6_router_fill(const Args& args, Frame& F) {
    const int lane = F.lane, r32 = lane & 31, hi = lane >> 5;
    LAS unsigned char* WL = F.lds;
    LAS int* lc = (LAS int*)(F.lds + 131072);
    LAS int* lbase = lc + 32;
    __syncthreads();
    for (int i = F.tid; i < 8192; i += NTHR) *(LAS u32x4*)(WL + i * 16) = *((const u32x4*)F_wrf + i);
    float bias[16];
#pragma unroll
    for (int r = 0; r < 16; ++r) bias[r] = F_b_router[8 * (r >> 2) + 4 * hi + (r & 3)];
    constexpr int NGRP = T / 32;
    const int rounds = (NGRP + F.G * NWAVES - 1) / (F.G * NWAVES);
    for (int rd = 0; rd < rounds; ++rd) {
        const int grp = (rd * F.G + F.bid) * NWAVES + F.wave; const bool act = grp < NGRP;
        __syncthreads();
        if (F.tid < 32) lc[F.tid] = 0;
        __syncthreads();
        const int tok = grp * 32 + r32;
        float t0 = -INFINITY, t1 = -INFINITY, t2 = -INFINITY, t3 = -INFINITY; int i0 = 0, i1 = 0, i2 = 0, i3 = 0, k0 = 0, k1 = 0, k2 = 0, k3 = 0;
        if (act) {
            const bf16_t* hrow = F_h1b + (size_t)tok * DM + 32 * hi;
            at::f32x16 acc;
#pragma unroll
            for (int r = 0; r < 16; ++r) acc[r] = 0.f;
#pragma unroll 1
            for (int qh = 0; qh < 2; ++qh) {
                bf16x8 b[32];
#pragma unroll
                for (int q = 0; q < 8; ++q)
#pragma unroll
                    for (int i = 0; i < 4; ++i) b[q * 4 + i] = *(const bf16x8*)(hrow + 64 * (qh * 8 + q) + 8 * i);
#pragma unroll
                for (int k = 0; k < 32; ++k) { const int ks = qh * 32 + k;
                    const bf16x8 ah = *(const LAS bf16x8*)(WL + (ks * 64 + lane) * 16), al = *(const LAS bf16x8*)(WL + 65536 + (ks * 64 + lane) * 16);
                    acc = __builtin_amdgcn_mfma_f32_32x32x16_bf16(ah, b[k], acc, 0, 0, 0); acc = __builtin_amdgcn_mfma_f32_32x32x16_bf16(al, b[k], acc, 0, 0, 0); }
            }
#pragma unroll
            for (int r = 0; r < 16; ++r) { const float v = acc[r] + bias[r]; const int e = 8 * (r >> 2) + 4 * hi + (r & 3); P6_INS(P6_GT1, v, e) }
            const float p0 = __shfl_xor(t0, 32), p1 = __shfl_xor(t1, 32), p2 = __shfl_xor(t2, 32), p3 = __shfl_xor(t3, 32);
            const int q0 = __shfl_xor(i0, 32), q1 = __shfl_xor(i1, 32), q2 = __shfl_xor(i2, 32), q3 = __shfl_xor(i3, 32);
            P6_INS(P6_GT2, p0, q0) P6_INS(P6_GT2, p1, q1) P6_INS(P6_GT2, p2, q2) P6_INS(P6_GT2, p3, q3)
            if (hi == 0) { k0 = __hip_atomic_fetch_add(lc + i0, 1, __ATOMIC_RELAXED, __HIP_MEMORY_SCOPE_WORKGROUP); k1 = __hip_atomic_fetch_add(lc + i1, 1, __ATOMIC_RELAXED, __HIP_MEMORY_SCOPE_WORKGROUP);
                k2 = __hip_atomic_fetch_add(lc + i2, 1, __ATOMIC_RELAXED, __HIP_MEMORY_SCOPE_WORKGROUP); k3 = __hip_atomic_fetch_add(lc + i3, 1, __ATOMIC_RELAXED, __HIP_MEMORY_SCOPE_WORKGROUP); }
        }
        __syncthreads();
        if (F.tid < 32) { const int c = lc[F.tid]; lbase[F.tid] = c ? (int)__hip_atomic_fetch_add(F_ctl + CW_CNT + F.tid, (unsigned)c, __ATOMIC_RELAXED, __HIP_MEMORY_SCOPE_AGENT) : 0; }
        __syncthreads();
        if (act && hi == 0) {
            const float e1 = __expf(t1 - t0), e2 = __expf(t2 - t0), e3 = __expf(t3 - t0); const float isum = 1.0f / (1.0f + e1 + e2 + e3);
            int row;
            row = i0 * RT_STRIDE + lbase[i0] + k0; F_rtok[row] = tok;             F_rgate[row] = isum;
            row = i1 * RT_STRIDE + lbase[i1] + k1; F_rtok[row] = tok | (1 << 16); F_rgate[row] = e1 * isum;
            row = i2 * RT_STRIDE + lbase[i2] + k2; F_rtok[row] = tok | (2 << 16); F_rgate[row] = e2 * isum;
            row = i3 * RT_STRIDE + lbase[i3] + k3; F_rtok[row] = tok | (3 << 16); F_rgate[row] = e3 * isum;
        }
    }
    __syncthreads();
}
#undef P6_INS
#undef P6_GT1
#undef P6_GT2
__device__ __forceinline__ void moe_offsets(const Args& args, Frame& F, LAS int* offs) {
    LAS int* pc = offs + 4 * 33;
    __syncthreads();
    if (F.tid < NEXP) { const int c = (int)__hip_atomic_load(F_ctl + CW_CNT + F.tid, __ATOMIC_RELAXED, __HIP_MEMORY_SCOPE_AGENT); pc[F.tid] = (c + 255) & ~255; }
    __syncthreads();
    if (F.tid <= NEXP) { int acc = 0; for (int e = 0; e < F.tid; ++e) acc += pc[e]; offs[F.tid] = acc; }
    __syncthreads();
}
template <int I> __device__ __forceinline__ float f8dec(unsigned w) { return __builtin_amdgcn_cvt_f32_fp8((int)w, I); }
__device__ __forceinline__ void p9_final(const Args& args, Frame& F) {
    const int lane = F.lane; const int gw = F.bid * NWAVES + F.wave, NGW = F.G * NWAVES;
    f32x4 gv[4], bv[4];
#pragma unroll
    for (int j = 0; j < 4; ++j) { gv[j] = *((const f32x4*)F_ln2_g + lane + 64 * j); bv[j] = *((const f32x4*)F_ln2_b + lane + 64 * j); }
    unsigned yn[4][4]; u32x2 hn[4];
#define P9_LOAD(TK) do { const unsigned* ys_ = (const unsigned*)((const unsigned char*)F_out + (size_t)(TK) * 4096) + lane; const u32x2* hr_ = (const u32x2*)(F_h1b + (size_t)(TK) * DM) + lane; \
        _Pragma("unroll") for (int q = 0; q < 4; ++q) _Pragma("unroll") for (int j = 0; j < 4; ++j) yn[q][j] = ys_[256 * q + 64 * j];     \
        _Pragma("unroll") for (int j = 0; j < 4; ++j) hn[j] = hr_[64 * j]; } while (0)
    if (gw < T) P9_LOAD(gw);
    for (int tok = gw; tok < T; tok += NGW) {
        f32x4* yr = (f32x4*)(F_out + (size_t)tok * DM) + lane;
        unsigned yw[4][4]; u32x2 hp[4];
#pragma unroll
        for (int q = 0; q < 4; ++q)
#pragma unroll
            for (int j = 0; j < 4; ++j) yw[q][j] = yn[q][j];
#pragma unroll
        for (int j = 0; j < 4; ++j) hp[j] = hn[j];
        if (tok + NGW < T) P9_LOAD(tok + NGW);
        f32x4 v[4]; float s = 0.f;
#pragma unroll
        for (int j = 0; j < 4; ++j) {
            const float y0 = (f8dec<0>(yw[0][j]) + f8dec<0>(yw[1][j])) + (f8dec<0>(yw[2][j]) + f8dec<0>(yw[3][j])), y1 = (f8dec<1>(yw[0][j]) + f8dec<1>(yw[1][j])) + (f8dec<1>(yw[2][j]) + f8dec<1>(yw[3][j]));
            const float y2 = (f8dec<2>(yw[0][j]) + f8dec<2>(yw[1][j])) + (f8dec<2>(yw[2][j]) + f8dec<2>(yw[3][j])), y3 = (f8dec<3>(yw[0][j]) + f8dec<3>(yw[1][j])) + (f8dec<3>(yw[2][j]) + f8dec<3>(yw[3][j]));
            v[j].x = DN_ALPHA * bflo(hp[j].x) + y0 * (1.0f / F8_Y_S); v[j].y = DN_ALPHA * bfhi(hp[j].x) + y1 * (1.0f / F8_Y_S);
            v[j].z = DN_ALPHA * bflo(hp[j].y) + y2 * (1.0f / F8_Y_S); v[j].w = DN_ALPHA * bfhi(hp[j].y) + y3 * (1.0f / F8_Y_S);
            s += (v[j].x + v[j].y) + (v[j].z + v[j].w); }
        const float mean = wave_sum(s) * (1.0f / DM); float s2 = 0.f;
#pragma unroll
        for (int j = 0; j < 4; ++j) { v[j] = v[j] - mean; s2 += (v[j].x * v[j].x + v[j].y * v[j].y) + (v[j].z * v[j].z + v[j].w * v[j].w); }
        const float rstd = 1.0f / sqrtf(wave_sum(s2) * (1.0f / DM) + LN_EPS);
#pragma unroll
        for (int j = 0; j < 4; ++j) yr[64 * j] = v[j] * rstd * gv[j] + bv[j];
    }
#undef P9_LOAD
}

#define XB_TMO      128
#define XB_XCNT(j)  (256  + 64 * (j))
#define XB_XSUB(j)  (1280 + 64 * (j))
#define XB_XGEN(j)  (2304 + 64 * (j))
#define XB_TOP      3328
#define XB_TOPGEN   3392
#define XCD_BAR_WORDS 3456
#define XB_SPIN_CAP (1u << 22)
__device__ __forceinline__ unsigned xb_ld(unsigned* p)              { return __hip_atomic_load(p, __ATOMIC_RELAXED, __HIP_MEMORY_SCOPE_AGENT); }
__device__ __forceinline__ unsigned xb_add(unsigned* p, unsigned v) { return __hip_atomic_fetch_add(p, v, __ATOMIC_RELAXED, __HIP_MEMORY_SCOPE_AGENT); }
__device__ __forceinline__ unsigned xb_xcc_id() { return (unsigned)__builtin_amdgcn_s_getreg((3 << 11) | 20) & 0xFu; }
#define XB_SPIN(cond, bar) do { unsigned _sp = 0; while (cond) { __builtin_amdgcn_s_sleep(1); \
    if ((++_sp & 255u) == 0u) { if (xb_ld(&(bar)[XB_TMO])) break; if (_sp > XB_SPIN_CAP) { atomicAdd(&(bar)[XB_TMO], 1u); break; } } } } while (0)
struct XcdBarrier { unsigned* bar; unsigned x; volatile LAS unsigned* st; };
__device__ __forceinline__ XcdBarrier xcd_barrier_post(unsigned* bar, volatile LAS unsigned* st, bool leader) {
    XcdBarrier b; b.bar = bar; b.x = xb_xcc_id(); b.st = st;
    if (leader) { st[2] = xb_add(&bar[XB_XCNT(b.x)], 1u); st[3] = 0u; }
    return b;
}
__device__ __forceinline__ void xcd_barrier_complete(unsigned* bar, unsigned x, unsigned& nloc, unsigned& nx, unsigned& uni) {
    const unsigned G = gridDim.x * gridDim.y * gridDim.z;
    unsigned sum, cnt, mine, sp = 0u;
    for (;;) {
        sum = 0u; cnt = 0u; mine = 0u; uni = 1u;
#pragma unroll
        for (unsigned j = 0; j < 16; ++j) { const unsigned c = xb_ld(&bar[XB_XCNT(j)]); sum += c; cnt += (c > 0u) ? 1u : 0u; mine = (j == x) ? c : mine;
            if (j < 8u ? (c * 8u != G) : (c != 0u)) uni = 0u; }
        if (sum == G) break;
        __builtin_amdgcn_s_sleep(1);
        if ((++sp & 255u) == 0u) { if (xb_ld(&bar[XB_TMO])) break; if (sp > XB_SPIN_CAP) { atomicAdd(&bar[XB_TMO], 1u); break; } }
    }
    nloc = mine > 0u ? mine : 1u; nx = cnt > 0u ? cnt : 1u;
}
__device__ __forceinline__ void xcd_barrier(const XcdBarrier& b, bool leader) {
    asm volatile("s_waitcnt vmcnt(0)" ::: "memory");
    __syncthreads();
    if (leader) {
        unsigned* bar = b.bar;
        __builtin_amdgcn_s_waitcnt(0);
        unsigned nloc = b.st[0], nx = b.st[1];
        if (nloc == 0u) { unsigned uni; xcd_barrier_complete(bar, b.x, nloc, nx, uni); b.st[0] = nloc; b.st[1] = nx; b.st[3] = uni; }
        const unsigned old = xb_add(&bar[XB_XSUB(b.x)], 1u);
        const unsigned gen = old / nloc;
        if (old + 1u == (gen + 1u) * nloc) {
            __builtin_amdgcn_fence(__ATOMIC_RELEASE, "agent");
            asm volatile("s_waitcnt vmcnt(0)" ::: "memory");
            const unsigned og = xb_add(&bar[XB_TOP], 1u);
            const unsigned tg = og / nx;
            if (og + 1u == (tg + 1u) * nx) xb_add(&bar[XB_TOPGEN], 1u);
            else XB_SPIN(xb_ld(&bar[XB_TOPGEN]) == tg, bar);
            __builtin_amdgcn_fence(__ATOMIC_ACQUIRE, "agent");
            xb_add(&bar[XB_XGEN(b.x)], 1u);
            asm volatile("s_waitcnt vmcnt(0)" ::: "memory");
        } else {
            XB_SPIN(xb_ld(&bar[XB_XGEN(b.x)]) == gen, bar);
            __builtin_amdgcn_fence(__ATOMIC_ACQUIRE, "agent");
            asm volatile("s_waitcnt vmcnt(0)" ::: "memory");
        }
    }
    __syncthreads();
}

constexpr int PH_P0 = 0, PH_P1 = 1, PH_P2 = 2, PH_P3 = 3, PH_P4 = 4, PH_P5 = 5, PH_P6 = 6, PH_MOE = 7, PH_FINAL = PH_MOE + 2 * NROUND, N_PHASES = PH_FINAL + 1;

#ifndef PROBE_T
#define PROBE_T -1
#endif
#ifndef PROBE_MUL
#define PROBE_MUL 1
#endif
#ifndef PROBE_T0
#define PROBE_T0 PROBE_T
#endif
#define STAMP(k) do { if (PROBE_T >= 0 && F.tid == 0) { const unsigned long long t_ = __builtin_amdgcn_s_memrealtime(); tstamp[2 * ((k) + 1)] = (unsigned)t_; tstamp[2 * ((k) + 1) + 1] = (unsigned)(t_ >> 32); } } while (0)
template <unsigned MASK>
__global__ void __launch_bounds__(NTHR, 2) mk_fwd(Args args) {
    extern __shared__ __attribute__((aligned(16))) unsigned char lds_raw[];
    cg::grid_group grid = cg::this_grid();
    Frame F;
    F.lds = (LAS unsigned char*)lds_raw;
    F.wave = __builtin_amdgcn_readfirstlane((int)threadIdx.x >> 6); F.lane = my_lane(); F.tid = F.wave * 64 + F.lane; F.G = gridDim.x; F.bid = blockIdx.x;
    LAS int* offs = (LAS int*)(F.lds + LCTL_OFF);
    volatile LAS unsigned* bst = (volatile LAS unsigned*)(F.lds + LDS_BYTES - 16);
    volatile LAS unsigned* tstamp = (volatile LAS unsigned*)(F.lds + LDS_BYTES - 512);
    STAMP(-1);
    const bool multi = (args.ph_hi - args.ph_lo) > 1;
    XcdBarrier xbar; xbar.bar = F_ctl + CW_BAR; xbar.x = 0; xbar.st = bst;
    if (multi) { if (F.tid == 0) { bst[0] = 0u; bst[1] = 0u; } __syncthreads(); xbar = xcd_barrier_post(F_ctl + CW_BAR, bst, F.tid == 0); }
    const int lo = args.ph_lo, hi = args.ph_hi;
#define PH_BIT(k) ((k) < PH_MOE ? (k) : ((k) == PH_FINAL ? 9 : 7 + (((k) - PH_MOE) % 2)))
#define IN(k) (((MASK >> PH_BIT(k)) & 1u) && lo <= (k) && (k) < hi)
#ifndef PROBE_PH
#define PROBE_PH -1
#endif
#ifndef PROBE_REP
#define PROBE_REP 1
#endif
#define REPS(k) for (int rep_ = 0; rep_ < (((k) == PROBE_PH) ? PROBE_REP : 1); ++rep_)
#define REPSYNC(k) do { if (rep_ > 0) { xcd_barrier(xbar, F.wave == 0 && F.lane == 0); if ((k) == PH_P2) { if (F.bid == 0 && F.tid == 0) __hip_atomic_store(F_ctl + CW_Q, 0u, __ATOMIC_RELAXED, __HIP_MEMORY_SCOPE_AGENT); xcd_barrier(xbar, F.wave == 0 && F.lane == 0); } } } while (0)
#define SEAM(k) do { if (IN(k) && IN((k) + 1)) { if (args.ph_lo < 0) grid.sync(); else xcd_barrier(xbar, F.wave == 0 && F.lane == 0); }     F.lane = launder(my_lane()); F.tid = F.wave * 64 + F.lane; STAMP(k); } while (0)

    if (IN(PH_P0)) REPS(PH_P0) { REPSYNC(PH_P0); p0_prologue(args, F); } SEAM(PH_P0);
    int vbid = F.bid;
    if (multi) { const unsigned uni_ = bst[3], rk_ = bst[2]; if (uni_ != 0u && rk_ * 8u < (unsigned)F.G) vbid = (int)(rk_ * 8u + xbar.x); }
    vbid = __builtin_amdgcn_readfirstlane(vbid);
    if (IN(PH_P1)) REPS(PH_P1) { REPSYNC(PH_P1); pg8::Gemm g{F_xb, F_WinT, DM * 2, DM * 2, DM * 2, nullptr}; pg8::StaticOrder S; S.init(T, NPROJ, F.G, vbid); EpiProj E{F_projb, F_g32};
        pg8::gemm_phase<EpiProj, pg8::StaticOrder>(F.lds, g, S, E, F.wave); } SEAM(PH_P1);
    if (IN(PH_P2)) REPS(PH_P2) { REPSYNC(PH_P2); p2_cb(args, F);
#ifndef PROBE_ML
#define PROBE_ML 1
#endif
#ifndef PROBE_IDX
#define PROBE_IDX 1
#endif
        __syncthreads();
#pragma unroll 1
        for (int ridx = 0; ridx < PROBE_IDX; ++ridx) p2_indexer_mfma(args, F, ridx);
 } SEAM(PH_P2);
    if (IN(PH_P3)) REPS(PH_P3) { REPSYNC(PH_P3);
#pragma unroll 1
        for (int rml = 0; rml < PROBE_ML; ++rml)
        for (int sidx = F.bid; sidx < NB * 4; sidx += F.G) ml::stream(args, sidx >> 2, sidx & 3, F.lds, F.wave);
        p3_attn_mfma(args, F); } SEAM(PH_P3);
    if (IN(PH_P4)) REPS(PH_P4) { REPSYNC(PH_P4); pg8::Gemm g{F_mix, F_WoutT, DM * 2, DM * 2, DM * 2, nullptr}; pg8::StaticOrder S; S.init(T, DM, F.G, vbid); EpiOut E{(bf16_t*)F_pre1};
        pg8::gemm_phase<EpiOut, pg8::StaticOrder>(F.lds, g, S, E, F.wave); } SEAM(PH_P4);
    if (IN(PH_P5)) { p5_ln1(args, F); } SEAM(PH_P5);
    if (IN(PH_P6)) { p6_router_fill(args, F); } SEAM(PH_P6);
#define INM(j) (((MASK >> (7 + (j))) & 1u) && lo <= pa + (j) && pa + (j) < hi)
#define SEAMM(j) do { if (lo <= pa + (j) && pa + (j) + 1 < hi) xcd_barrier(xbar, F.wave == 0 && F.lane == 0); F.lane = launder(my_lane()); F.tid = F.wave * 64 + F.lane; STAMP(pa + (j)); } while (0)
#pragma unroll 1
    for (int rnd = 0; rnd < NROUND; ++rnd) {
        const int pa = PH_MOE + 2 * rnd;
        if (INM(0)) REPS(pa) { REPSYNC(pa); moe_offsets(args, F, offs); pg8::Gemm g{F_h1q, F_WguT, DM, DM, DM, F_rtok}; MoeOrder S; S.init(offs + rnd * 33, 8, F.G, vbid); EpiGU E{F_hb, F_b_gu};
            pg8::gemm_phase<EpiGU, MoeOrder, true, true>(F.lds, g, S, E, F.wave); } SEAMM(0);
        if (INM(1)) REPS(pa + 1) { REPSYNC(pa + 1); moe_offsets(args, F, offs); pg8::Gemm g{F_hb, F_WdT, DM, DM, DM, nullptr}; MoeOrder S; S.init(offs + rnd * 33, 4, F.G, vbid);
            EpiDown E{(unsigned char*)F_out, F_b_down, F_rtok, F_rgate};
            pg8::gemm_phase<EpiDown, MoeOrder, false, true>(F.lds, g, S, E, F.wave); } SEAMM(1);
    }
    if (IN(PH_FINAL)) { p9_final(args, F); }
    if (PROBE_T >= 0) {
        xcd_barrier(xbar, F.wave == 0 && F.lane == 0); STAMP(PH_FINAL);
        if (F.bid == 0 && F.tid == 0) { const unsigned long long t1 = ((unsigned long long)tstamp[2 * (PROBE_T + 1) + 1] << 32) | tstamp[2 * (PROBE_T + 1)], t0 = ((unsigned long long)tstamp[2 * PROBE_T0 + 1] << 32) | tstamp[2 * PROBE_T0];
            const unsigned long long d = (t1 - t0) * PROBE_MUL, s0 = __builtin_amdgcn_s_memrealtime(); while (__builtin_amdgcn_s_memrealtime() - s0 < d) __builtin_amdgcn_s_sleep(8); }
    }
#undef IN
#undef SEAM
}

extern "C" void kernel_launch(void* const* d_in, const int* in_sizes, int n_in, void* d_out, int out_size, void* d_ws, size_t ws_size, hipStream_t stream) {
    static int grid = 0;
#if MK_ONE_LAUNCH
    void* kfn[1] = {(void*)mk_fwd<0x3ffu>};
    constexpr int NKFN = 1;
#else
    void* kfn[10] = {(void*)mk_fwd<1u << 0>, (void*)mk_fwd<1u << 1>, (void*)mk_fwd<1u << 2>, (void*)mk_fwd<1u << 3>, (void*)mk_fwd<1u << 4>, (void*)mk_fwd<1u << 5>,
                     (void*)mk_fwd<1u << 6>, (void*)mk_fwd<1u << 7>, (void*)mk_fwd<1u << 8>, (void*)mk_fwd<1u << 9>};
    constexpr int NKFN = 10;
#endif
    if (grid == 0) {
        if (n_in != 23 || out_size != T * DM || ws_size < WS_END) { fprintf(stderr, "kernel_launch: unexpected shapes (n_in %d, out %d, ws %zu, need %zu)\n", n_in, out_size, ws_size, (size_t)WS_END); grid = -1; return; }
        int dev = 0, cus = 0, per_cu = 0;
        hipGetDevice(&dev); hipDeviceGetAttribute(&cus, hipDeviceAttributeMultiprocessorCount, dev);
        for (int k = 0; k < NKFN; ++k) {
            if (hipFuncSetAttribute((const void*)kfn[k], hipFuncAttributeMaxDynamicSharedMemorySize, LDS_BYTES) != hipSuccess) { fprintf(stderr, "kernel_launch: hipFuncSetAttribute failed\n"); grid = -1; return; }
            int pc = 0;
            if (hipOccupancyMaxActiveBlocksPerMultiprocessor(&pc, (const void*)kfn[k], NTHR, LDS_BYTES) != hipSuccess || pc < 1) { fprintf(stderr, "kernel_launch: occupancy query says %d for kernel %d\n", pc, k); grid = -1; return; }
            per_cu = pc;
        }
        (void)hipGetLastError();
        grid = cus * 1;
        fprintf(stderr, "kernel_launch: cus %d per_cu %d grid %d\n", cus, per_cu, grid);
    }
    if (grid < 0) return;
    hipMemsetAsync((char*)d_ws + WS_CTL, 0, CTL_BYTES, stream);
    Args a{};
    for (int i = 0; i < 23; ++i) a.in[i] = (const float*)d_in[i];
    a.out = (float*)d_out; a.ws = (unsigned char*)d_ws;
#if MK_ONE_LAUNCH
    a.ph_lo = 0; a.ph_hi = N_PHASES;
    { void* kargs[] = {&a}; hipError_t e = hipLaunchCooperativeKernel((void*)mk_fwd<0x3ffu>, dim3(grid), dim3(NTHR), kargs, LDS_BYTES, stream);
      if (e != hipSuccess) fprintf(stderr, "cooperative launch failed: %s\n", hipGetErrorString(e)); }
#else
    for (int p = 0; p < N_PHASES; ++p) {
        a.ph_lo = p; a.ph_hi = p + 1;
        void* kargs[] = {&a}; hipError_t e = hipLaunchCooperativeKernel(kfn[PH_BIT(p)], dim3(grid), dim3(NTHR), kargs, LDS_BYTES, stream);
        if (e != hipSuccess) { fprintf(stderr, "cooperative launch %d failed: %s\n", p, hipGetErrorString(e)); break; }
    }
#endif
}
```
